# Optimizing an MI355X kernel written in HIP

```python
import jax, jax.numpy as jnp
from jax import lax
import numpy as np

D_MODEL = 2048
BATCH = 4
SEQ = 4096
DEPTH = 2

GRID_W = 64
CTX_LEN = 256
EPS = 1e-6
N_BRANCH = 4
BRANCH_W = D_MODEL // 2
ATT_HEAD_DIM = 128
ATT_HEADS = BRANCH_W // ATT_HEAD_DIM
ATT_KV_HEADS = ATT_HEADS // 4
ATT_GROUP = ATT_HEADS // ATT_KV_HEADS
ATT_SCALE = ATT_HEAD_DIM ** -0.5
ROPE_THETA = 10000.0
Q_BLOCK = 128
MLSTM_HEADS = 4
MLSTM_HEAD_DIM = BRANCH_W // MLSTM_HEADS
MLSTM_CHUNK = 64
M_INIT = -1e30
CONV_WIDTH = 3
POOL_WINDOWS = (2, 4, 8, 16)
POOL_GROUP = BRANCH_W // len(POOL_WINDOWS)

SPLITS = (
    ATT_HEADS * ATT_HEAD_DIM, ATT_KV_HEADS * ATT_HEAD_DIM, ATT_KV_HEADS * ATT_HEAD_DIM, BRANCH_W,
    BRANCH_W, BRANCH_W, BRANCH_W, BRANCH_W, BRANCH_W, 4 * MLSTM_HEADS,
    BRANCH_W, BRANCH_W, BRANCH_W, BRANCH_W,
    BRANCH_W, BRANCH_W,
    N_BRANCH * D_MODEL,
)
N_IN = sum(SPLITS)

kernel_name = "hybrid_parallel_gated_dit_block"


def split_cols(y):
    idx = np.cumsum(SPLITS)[:-1].tolist()
    return jnp.split(y, idx, axis=-1)


def rms_norm(x, gain):
    xf = x.astype(jnp.float32)
    y = xf * lax.rsqrt(jnp.mean(xf * xf, axis=-1, keepdims=True) + EPS)
    return (y * gain.astype(jnp.float32)).astype(x.dtype)


def heads(a, n, d):
    return a.reshape(a.shape[:2] + (n, d))


def axial_rope(x):
    T = x.shape[1]
    n_rows = T // GRID_W
    row = jnp.broadcast_to(jnp.arange(n_rows, dtype=jnp.float32)[:, None], (n_rows, GRID_W)).reshape(-1)
    col = jnp.broadcast_to(jnp.arange(GRID_W, dtype=jnp.float32)[None, :], (n_rows, GRID_W)).reshape(-1)
    half = ATT_HEAD_DIM // 2
    quarter = half // 2
    freq = ROPE_THETA ** (-jnp.arange(quarter, dtype=jnp.float32) / quarter)

    def rot(xa, pos):
        ang = pos[:, None] * freq[None, :]
        cos = jnp.cos(ang)[None, :, None, :]
        sin = jnp.sin(ang)[None, :, None, :]
        x1, x2 = xa[..., :quarter], xa[..., quarter:]
        return jnp.concatenate([x1 * cos - x2 * sin, x2 * cos + x1 * sin], axis=-1)

    xf = x.astype(jnp.float32)
    out = jnp.concatenate([rot(xf[..., :half], row), rot(xf[..., half:], col)], axis=-1)
    return out.astype(x.dtype)


def gqa_attend(q, k, v):
    s = jnp.einsum('bqhgd,bkhd->bhgqk', q, k).astype(jnp.float32) * ATT_SCALE
    p = jax.nn.softmax(s, axis=-1).astype(v.dtype)
    return jnp.einsum('bhgqk,bkhd->bqhgd', p, v)


def latent_attention(q, k, v, k_ctx, v_ctx):
    B, T = q.shape[:2]
    k_all = jnp.concatenate([k, k_ctx], axis=1)
    v_all = jnp.concatenate([v, v_ctx], axis=1)
    nb = T // Q_BLOCK
    qb = q.reshape(B, nb, Q_BLOCK, ATT_KV_HEADS, ATT_GROUP, ATT_HEAD_DIM).swapaxes(0, 1)
    ob = lax.map(lambda qblk: gqa_attend(qblk, k_all, v_all), qb)
    return ob.swapaxes(0, 1).reshape(B, T, ATT_HEADS * ATT_HEAD_DIM)


def context_attention(q, k, v):
    B, L = q.shape[:2]
    o = gqa_attend(q.reshape(B, L, ATT_KV_HEADS, ATT_GROUP, ATT_HEAD_DIM), k, v)
    return o.reshape(B, L, ATT_HEADS * ATT_HEAD_DIM)


def attn_qk(q, k, q_gain, k_gain):
    q = rms_norm(heads(q, ATT_HEADS, ATT_HEAD_DIM), q_gain)
    k = rms_norm(heads(k, ATT_KV_HEADS, ATT_HEAD_DIM), k_gain)
    return q, k


def mlstm_scan(q, k, v, log_i, log_f, state):
    B, H, T, _ = q.shape
    L = MLSTM_CHUNK
    nc = T // L

    def to_chunks(a):
        return jnp.moveaxis(a.reshape(a.shape[:2] + (nc, L) + a.shape[3:]), 2, 0)

    xs = tuple(to_chunks(a) for a in (q, k, v, log_i, log_f))
    lower = jnp.tril(jnp.ones((L, L), dtype=bool))

    def step(carry, inp):
        C, n, m = carry
        qc, kc, vc, ic, fc = inp
        b = jnp.cumsum(fc, axis=-1)
        log_d = jnp.where(lower, b[..., :, None] - b[..., None, :] + ic[..., None, :], -jnp.inf)
        log_inter = b + m[..., None]
        m_t = jnp.maximum(log_inter, jnp.max(log_d, axis=-1))
        d = jnp.exp(log_d - m_t[..., None])
        inter = jnp.exp(log_inter - m_t)
        s = jnp.einsum('bhtd,bhsd->bhts', qc, kc) * d
        num = inter[..., None] * jnp.einsum('bhtd,bhde->bhte', qc, C) + jnp.einsum('bhts,bhse->bhte', s, vc)
        den = inter * jnp.einsum('bhtd,bhd->bht', qc, n) + jnp.sum(s, axis=-1)
        h = num / jnp.maximum(jnp.abs(den), jnp.exp(-m_t))[..., None]
        b_last = b[..., -1]
        log_w = b_last[..., None] - b + ic
        m_new = jnp.maximum(b_last + m, jnp.max(log_w, axis=-1))
        w = jnp.exp(log_w - m_new[..., None])
        decay = jnp.exp(b_last + m - m_new)
        C_new = decay[..., None, None] * C + jnp.einsum('bhs,bhsd,bhse->bhde', w, kc, vc)
        n_new = decay[..., None] * n + jnp.einsum('bhs,bhsd->bhd', w, kc)
        return (C_new, n_new, m_new), h

    state, hs = lax.scan(step, state, xs)
    h = jnp.moveaxis(hs, 0, 2).reshape(B, H, T, -1)
    return h, state


def mlstm_inputs(q, k, v, g, gate_bias):
    B, T = q.shape[:2]
    def hd(a):
        return heads(a, MLSTM_HEADS, MLSTM_HEAD_DIM).transpose(0, 2, 1, 3).astype(jnp.float32)
    qh, kh, vh = hd(q), hd(k) * (MLSTM_HEAD_DIM ** -0.5), hd(v)
    gates = (g + gate_bias.reshape(-1)).astype(jnp.float32).reshape(B, T, 4, MLSTM_HEADS).transpose(2, 0, 3, 1)
    return qh, kh, vh, gates


def flip_t(a):
    return jnp.flip(a, axis=2)


def mlstm_bidir(qh, kh, vh, gates, state_f, state_b):
    h_f, st_f = mlstm_scan(qh, kh, vh, gates[0], jax.nn.log_sigmoid(gates[1]), state_f)
    h_b, st_b = mlstm_scan(flip_t(qh), flip_t(kh), flip_t(vh), flip_t(gates[2]),
                           flip_t(jax.nn.log_sigmoid(gates[3])), state_b)
    return h_f + flip_t(h_b), st_f, st_b


def mlstm_empty_state(B):
    return (jnp.zeros((B, MLSTM_HEADS, MLSTM_HEAD_DIM, MLSTM_HEAD_DIM), jnp.float32),
            jnp.zeros((B, MLSTM_HEADS, MLSTM_HEAD_DIM), jnp.float32),
            jnp.full((B, MLSTM_HEADS), M_INIT, jnp.float32))


def mlstm_out(h, o, gain):
    B, _, T, _ = h.shape
    hn = rms_norm(h.transpose(0, 2, 1, 3), jnp.ones((MLSTM_HEAD_DIM,), jnp.float32)).reshape(B, T, BRANCH_W)
    return (hn * gain.astype(jnp.float32) * jax.nn.sigmoid(o.astype(jnp.float32))).astype(o.dtype)


def short_conv(u, bg, cg, w):
    a = jnp.pad(cg * u, ((0, 0), (1, 1), (0, 0)))
    y = w[0] * a[:, :-2] + w[1] * a[:, 1:-1] + w[2] * a[:, 2:]
    return bg * y


def multiscale_pool(u, pool_w, pool_scale):
    B, T, _ = u.shape
    uf = u.astype(jnp.float32)
    csum = jnp.concatenate([jnp.zeros((B, 1, BRANCH_W), jnp.float32), jnp.cumsum(uf, axis=1)], axis=1)
    t = jnp.arange(T)
    outs = []
    for g, w in enumerate(POOL_WINDOWS):
        lo = jnp.clip(t - w // 2, 0, T)
        hi = jnp.clip(t + w - w // 2, 0, T)
        sl = slice(g * POOL_GROUP, (g + 1) * POOL_GROUP)
        cs = csum[..., sl]
        mean = (cs[:, hi] - cs[:, lo]) / (hi - lo).astype(jnp.float32)[None, :, None]
        outs.append((mean - uf[..., sl]).astype(u.dtype) @ pool_w[g])
    return jnp.concatenate(outs, axis=-1) * pool_scale


def merge_branches(branches, gate_cols, w_branch, w_out):
    gates = jnp.split(jax.nn.sigmoid(gate_cols.astype(jnp.float32)).astype(gate_cols.dtype), N_BRANCH, axis=-1)
    acc = gates[0] * (branches[0] @ w_branch[0])
    for i in range(1, N_BRANCH):
        acc = acc + gates[i] * (branches[i] @ w_branch[i])
    return acc @ w_out


def hybrid_layer(x, xc, c, c_ctx, norm_gain, w_mod, b_mod, w_in, q_gain, k_gain, gate_bias, m_gain,
                 conv_w, pool_w, pool_scale, w_branch, w_out, update_ctx):
    B = x.shape[0]
    mod_l = jax.nn.silu(c) @ w_mod + b_mod
    mod_c = jax.nn.silu(c_ctx) @ w_mod + b_mod
    sh_l, sc_l, gt_l = jnp.split(mod_l[:, None, :], 3, axis=-1)
    sh_c, sc_c, gt_c = jnp.split(mod_c, 3, axis=-1)
    h_l = rms_norm(x, norm_gain) * (1 + sc_l) + sh_l
    h_c = rms_norm(xc, norm_gain) * (1 + sc_c) + sh_c
    (aq_l, ak_l, av_l, az_l, mq_l, mk_l, mv_l, mo_l, mz_l, mg_l,
     cu_l, cb_l, cc_l, cz_l, pu_l, pz_l, gm_l) = split_cols(h_l @ w_in)
    (aq_c, ak_c, av_c, az_c, mq_c, mk_c, mv_c, mo_c, mz_c, mg_c,
     cu_c, cb_c, cc_c, cz_c, pu_c, pz_c, gm_c) = split_cols(h_c @ w_in)

    q_l, k_l = attn_qk(aq_l, ak_l, q_gain, k_gain)
    q_l, k_l = axial_rope(q_l), axial_rope(k_l)
    q_c, k_c = attn_qk(aq_c, ak_c, q_gain, k_gain)
    v_l = heads(av_l, ATT_KV_HEADS, ATT_HEAD_DIM)
    v_c = heads(av_c, ATT_KV_HEADS, ATT_HEAD_DIM)
    ya_l = latent_attention(q_l, k_l, v_l, k_c, v_c)

    mq, mk, mv, mg = mlstm_inputs(mq_c, mk_c, mv_c, mg_c, gate_bias)
    hm_c, st_f, st_b = mlstm_bidir(mq, mk, mv, mg, mlstm_empty_state(B), mlstm_empty_state(B))
    mq, mk, mv, mg = mlstm_inputs(mq_l, mk_l, mv_l, mg_l, gate_bias)
    hm_l, _, _ = mlstm_bidir(mq, mk, mv, mg, st_f, st_b)
    yb_l = mlstm_out(hm_l, mo_l, m_gain)

    yc_l = short_conv(cu_l, cb_l, cc_l, conv_w)
    yd_l = multiscale_pool(pu_l, pool_w, pool_scale)

    out_l = merge_branches([ya_l * jax.nn.silu(az_l), yb_l * jax.nn.silu(mz_l),
                            yc_l * jax.nn.silu(cz_l), yd_l * jax.nn.silu(pz_l)], gm_l, w_branch, w_out)
    x = x + gt_l * out_l

    if update_ctx:
        ya_c = context_attention(q_c, k_c, v_c)
        yb_c = mlstm_out(hm_c, mo_c, m_gain)
        yc_c = short_conv(cu_c, cb_c, cc_c, conv_w)
        yd_c = multiscale_pool(pu_c, pool_w, pool_scale)
        out_c = merge_branches([ya_c * jax.nn.silu(az_c), yb_c * jax.nn.silu(mz_c),
                                yc_c * jax.nn.silu(cz_c), yd_c * jax.nn.silu(pz_c)], gm_c, w_branch, w_out)
        xc = xc + gt_c * out_c
    return x, xc


def setup_inputs(seed: int = 0) -> dict:
    key = jax.random.key(seed)
    ks = jax.random.split(key, 20)
    f32 = jnp.float32

    def nrm(k, shape, scale):
        return jax.random.normal(k, shape, f32) * scale

    fbias = jnp.array([0.0, 1.0, 0.0, 1.0], f32)[:, None] * jnp.linspace(3.0, 6.0, MLSTM_HEADS, dtype=f32)[None, :]
    return {
        "x": nrm(ks[0], (BATCH, SEQ, D_MODEL), 1.0),
        "c": nrm(ks[1], (BATCH, D_MODEL), 1.0),
        "ctx": nrm(ks[2], (BATCH, CTX_LEN, D_MODEL), 1.0),
        "c_ctx": nrm(ks[3], (D_MODEL,), 1.0),
        "norm_gain": 1.0 + nrm(ks[4], (DEPTH, D_MODEL), 0.05),
        "w_mod": nrm(ks[5], (DEPTH, D_MODEL, 3 * D_MODEL), D_MODEL ** -0.5),
        "b_mod": nrm(ks[6], (DEPTH, 3 * D_MODEL), 0.02),
        "w_in": nrm(ks[7], (DEPTH, D_MODEL, N_IN), D_MODEL ** -0.5),
        "q_norm_gain": 1.0 + nrm(ks[8], (DEPTH, ATT_HEAD_DIM), 0.05),
        "k_norm_gain": 1.0 + nrm(ks[9], (DEPTH, ATT_HEAD_DIM), 0.05),
        "mlstm_gate_bias": fbias[None] + nrm(ks[10], (DEPTH, 4, MLSTM_HEADS), 0.1),
        "mlstm_norm_gain": 1.0 + nrm(ks[11], (DEPTH, BRANCH_W), 0.05),
        "conv_w": nrm(ks[12], (DEPTH, CONV_WIDTH, BRANCH_W), CONV_WIDTH ** -0.5),
        "pool_w": nrm(ks[13], (DEPTH, len(POOL_WINDOWS), POOL_GROUP, POOL_GROUP), POOL_GROUP ** -0.5),
        "pool_scale": 1.0 + nrm(ks[14], (DEPTH, BRANCH_W), 0.1),
        "w_branch": nrm(ks[15], (DEPTH, N_BRANCH, BRANCH_W, D_MODEL), BRANCH_W ** -0.5),
        "w_out": nrm(ks[16], (DEPTH, D_MODEL, D_MODEL), D_MODEL ** -0.5),
        "final_norm_gain": 1.0 + nrm(ks[17], (D_MODEL,), 0.05),
    }


def reference(x, c, ctx, c_ctx, norm_gain, w_mod, b_mod, w_in, q_norm_gain, k_norm_gain, mlstm_gate_bias,
              mlstm_norm_gain, conv_w, pool_w, pool_scale, w_branch, w_out, final_norm_gain):
    for l in range(DEPTH):
        x, ctx = hybrid_layer(x, ctx, c, c_ctx, norm_gain[l], w_mod[l], b_mod[l], w_in[l], q_norm_gain[l],
                              k_norm_gain[l], mlstm_gate_bias[l], mlstm_norm_gain[l], conv_w[l], pool_w[l],
                              pool_scale[l], w_branch[l], w_out[l], update_ctx=(l < DEPTH - 1))
    return rms_norm(x, final_norm_gain)
```

```cpp
#include <hip/hip_runtime.h>
#include <hip/hip_cooperative_groups.h>
#include <cstdio>
#include <cstdint>
namespace cg = cooperative_groups;

#ifndef MK_PER_PHASE
#define MK_PER_PHASE 0
#endif

#define LAS __attribute__((address_space(3)))
typedef unsigned short bf16_t;
typedef short bf16x8 __attribute__((ext_vector_type(8)));
typedef short s16x4 __attribute__((ext_vector_type(4)));
typedef float f32x4 __attribute__((ext_vector_type(4)));
typedef float f32x8 __attribute__((ext_vector_type(8)));
typedef float f32x16 __attribute__((ext_vector_type(16)));
typedef unsigned u32x4 __attribute__((ext_vector_type(4)));
typedef unsigned u32x2 __attribute__((ext_vector_type(2)));

constexpr int DM = 2048, NB = 4, TL = 4096, LC = 256, RPB = TL + LC  , MROWS = NB * RPB  ;
constexpr int NIN = 22032, NPAD = 22272, BRW = 1024;
constexpr int C_AQ = 0, C_AK = 1024, C_AV = 1280, C_AZ = 1536, C_MQ = 2560, C_MK = 3584, C_MV = 4608, C_MO = 5632, C_MZ = 6656,
              C_CU = 7680, C_CB = 8704, C_CC = 9728, C_CZ = 10752, C_PU = 11776, C_PZ = 12800, C_GM = 13824, C_MG = 22016;
constexpr int NCHUNK = RPB / 64;
constexpr float EPS = 1e-6f;

constexpr size_t WS_WIN = 0;
constexpr size_t WS_WBR = WS_WIN + (size_t)2 * NPAD * DM * 2;
constexpr size_t WS_WOUT = WS_WBR + (size_t)2 * 4 * DM * BRW * 2;
constexpr size_t WS_POOLW = WS_WOUT + (size_t)2 * DM * DM * 2;
constexpr size_t WS_MOD = WS_POOLW + (size_t)2 * 4 * 256 * 256 * 2;
constexpr size_t WS_H = WS_MOD + (size_t)2 * 5 * 6144 * 4;
constexpr size_t WS_Y = WS_H + (size_t)MROWS * DM * 2;
constexpr size_t WS_X1 = WS_Y + (size_t)MROWS * NPAD * 2;
constexpr size_t WS_HM = WS_X1 + (size_t)MROWS * DM * 4;
constexpr size_t WS_G32 = WS_HM + (size_t)2 * MROWS * BRW * 4;
constexpr size_t WS_GT4 = WS_G32 + (size_t)MROWS * 16 * 4;
constexpr size_t WS_GW = WS_GT4 + (size_t)32 * RPB * 16;
constexpr size_t WS_GD = WS_GW + (size_t)32 * RPB * 4;
constexpr size_t WS_BAR = WS_GD + (size_t)32 * 128 * 4;
constexpr size_t WS_END = WS_BAR + 16384;

constexpr int LDS_BYTES = 155648;

struct Params {
    const float* x; const float* c; const float* ctx; const float* c_ctx; const float* norm_gain; const float* w_mod; const float* b_mod; const float* w_in;
    const float* q_gain; const float* k_gain; const float* gate_bias; const float* m_gain; const float* conv_w; const float* pool_w; const float* pool_scale;
    const float* w_branch; const float* w_out; const float* final_gain;
    float* out; unsigned char* ws;
    int ph_lo, ph_hi;
};

__device__ __forceinline__ int otid() { int t = threadIdx.x; asm volatile("" : "+v"(t)); return t; }
__device__ __forceinline__ int obid() { int t = blockIdx.x; asm volatile("" : "+s"(t)); return t; }
typedef __bf16 bf16x2_t __attribute__((ext_vector_type(2)));
typedef float f32x2_t __attribute__((ext_vector_type(2)));
__device__ __forceinline__ unsigned cvt_pk_bf16(float lo, float hi) { f32x2_t v = {lo, hi}; bf16x2_t r = __builtin_convertvector(v, bf16x2_t); return *reinterpret_cast<unsigned*>(&r); }
__device__ __forceinline__ bf16_t f2bf(float f) { return (bf16_t)(cvt_pk_bf16(f, 0.f) & 0xffffu); }
__device__ __forceinline__ float bf2f(bf16_t b) { return __uint_as_float(((unsigned)b) << 16); }
__device__ __forceinline__ float bflo(unsigned w) { return __uint_as_float(w << 16); }
__device__ __forceinline__ float bfhi(unsigned w) { return __uint_as_float(w & 0xffff0000u); }
__device__ __forceinline__ float sigmoidf_(float x) { return __builtin_amdgcn_rcpf(1.0f + __builtin_amdgcn_exp2f(-1.4426950408889634f * x)); }
__device__ __forceinline__ float siluf_(float x) { return x * sigmoidf_(x); }
__device__ __forceinline__ float fexp(float x) { return __builtin_amdgcn_exp2f(1.4426950408889634f * x); }
__device__ __forceinline__ void unpack8(const u32x4 w, float (&f)[8]) { f[0] = bflo(w.x); f[1] = bfhi(w.x); f[2] = bflo(w.y); f[3] = bfhi(w.y); f[4] = bflo(w.z); f[5] = bfhi(w.z); f[6] = bflo(w.w); f[7] = bfhi(w.w); }
__device__ __forceinline__ u32x4 pack8(const float (&f)[8]) { u32x4 w; w.x = cvt_pk_bf16(f[0], f[1]); w.y = cvt_pk_bf16(f[2], f[3]); w.z = cvt_pk_bf16(f[4], f[5]); w.w = cvt_pk_bf16(f[6], f[7]); return w; }

namespace pg8 {
constexpr int BM = 256, BK = 64, HALF = 128, HTB = HALF * BK * 2, STAGE_BYTES = 8 * HTB, NXCD = 8, WGM = 8;
__host__ __device__ __forceinline__ int lds_byte(int r, int c) { const int st = (r >> 4) * 2 + (c >> 5), rr = r & 15, cc = c & 31, ob = rr * 64 + cc * 2; return st * 1024 + (ob ^ (((ob >> 9) & 1) << 5)); }
__host__ __device__ __forceinline__ void stage_rc(int b, int& R, int& C) { const int st = b / 1024, sb = b % 1024, swz = sb ^ (((sb >> 9) & 1) << 5); R = (st >> 1) * 16 + swz / 64; C = (st & 1) * 32 + (swz % 64) / 2; }
__host__ __device__ __forceinline__ int perm32(int rho) { const int n = rho >> 4, i = rho & 15; return 8 * (i >> 2) + 4 * n + (i & 3); }

struct Unit { const char* a; const char* b; int pm, pn, tag; };
struct Gemm { int lda, ldb, K; };

__device__ __forceinline__ bool static_tile(int nM, int nN, long L, int& pm, int& pn) {
    const int nwg = nM * nN; if (L >= nwg) return false;
    int wgid = (int)L; { const int q = nwg / NXCD, r = nwg % NXCD, xcd = wgid % NXCD, off = wgid / NXCD; wgid = (xcd < r ? xcd * (q + 1) : r * (q + 1) + (xcd - r) * q) + off; }
    const int nig = WGM * nN, gid = wgid / nig, fm = gid * WGM, gsz = (nM - fm) < WGM ? (nM - fm) : WGM;
    pm = fm + ((wgid % nig) % gsz); pn = (wgid % nig) / gsz; return true;
}

template <class Epi, class Sched>
__device__ __forceinline__ void gemm_phase(LAS unsigned char* lds, const Gemm g, const Sched& S, const Epi& E) {
    const int tid = otid(), wid = __builtin_amdgcn_readfirstlane(tid >> 6), lane = tid & 63, wr = wid >> 2, wc = wid & 3, fr = lane & 15, fq = lane >> 4;
    const int K = g.K, nt = K / BK;
    unsigned voffA[2], voffB[2];
#pragma unroll
    for (int i = 0; i < 2; ++i) { int R, C; stage_rc(tid * 16 + i * 8192, R, C); const int Rb = Epi::PERM ? ((R & ~31) + perm32(R & 31)) : R;
        voffA[i] = (unsigned)(R * g.lda + C) * 2u; voffB[i] = (unsigned)(Rb * g.ldb + C) * 2u; }
    const size_t kstep = (size_t)(BK * 2);
    const size_t hstepA = (size_t)HALF * g.lda * 2, hstepB = (size_t)HALF * g.ldb * 2;
    const unsigned ldsw = (unsigned)wid * 1024u;
    const int aoff = lds_byte(wr * 64 + fr, fq * 8), boff = lds_byte(wc * 32 + fr, fq * 8);
#define PG8_SA(b, h) (((b) * 2 + (h)) * HTB)
#define PG8_SB(b, h) ((4 + (b) * 2 + (h)) * HTB)
#define PG8_STAGE(bufoff, gbase, voff) do { _Pragma("unroll") for (int _i = 0; _i < 2; ++_i) \
        __builtin_amdgcn_global_load_lds((const unsigned*)((const char*)(gbase) + (voff)[_i]), (LAS unsigned*)(lds + (bufoff) + ldsw + _i * 8192), 16, 0, 0); } while (0)
#define PG8_LDA(dst, b, h) do { _Pragma("unroll") for (int m = 0; m < 4; ++m) _Pragma("unroll") for (int k = 0; k < 2; ++k) dst[m][k] = *(const LAS bf16x8*)(lds + PG8_SA(b, h) + aoff + m * 2048 + k * 1024); } while (0)
#define PG8_LDB(dst, b, h) do { _Pragma("unroll") for (int n = 0; n < 2; ++n) _Pragma("unroll") for (int k = 0; k < 2; ++k) dst[n][k] = *(const LAS bf16x8*)(lds + PG8_SB(b, h) + boff + n * 2048 + k * 1024); } while (0)
#define PG8_MMA(ai, bj, At, Bt) do { __builtin_amdgcn_s_setprio(1); _Pragma("unroll") for (int m = 0; m < 4; ++m) _Pragma("unroll") for (int n = 0; n < 2; ++n) _Pragma("unroll") for (int k = 0; k < 2; ++k) \
        acc[ai][bj][m][n] = __builtin_amdgcn_mfma_f32_16x16x32_bf16(Bt[n][k], At[m][k], acc[ai][bj][m][n], 0, 0, 0); __builtin_amdgcn_s_setprio(0); } while (0)
#define PG8_WAIT_V(n) asm volatile("s_waitcnt vmcnt(" #n ")" ::: "memory")
#define PG8_WAIT_L(n) asm volatile("s_waitcnt lgkmcnt(" #n ")" ::: "memory")
#define PG8_BAR __builtin_amdgcn_s_barrier()
#define PG8_SCHED __builtin_amdgcn_sched_barrier(0)
    Unit cur, nxt; int ui = 0;
    if (!S.next(0, cur)) return;
    f32x4 acc[2][2][4][2];
#pragma unroll
    for (int a = 0; a < 2; ++a)
#pragma unroll
        for (int b = 0; b < 2; ++b)
#pragma unroll
            for (int m = 0; m < 4; ++m)
#pragma unroll
                for (int n = 0; n < 2; ++n) acc[a][b][m][n] = (f32x4){0.f, 0.f, 0.f, 0.f};
    bf16x8 At[4][2], B0[2][2], B1[2][2];
    const char* cA = cur.a; const char* cB = cur.b;
    PG8_STAGE(PG8_SB(0, 0), cB, voffB); PG8_STAGE(PG8_SA(0, 0), cA, voffA); PG8_STAGE(PG8_SB(0, 1), cB + hstepB, voffB); PG8_STAGE(PG8_SA(0, 1), cA + hstepA, voffA);
    if (wr == 1) PG8_BAR;
    PG8_WAIT_V(4); PG8_BAR;
    PG8_STAGE(PG8_SB(1, 0), cB + kstep, voffB); PG8_STAGE(PG8_SA(1, 0), cA + kstep, voffA); PG8_STAGE(PG8_SB(1, 1), cB + hstepB + kstep, voffB);
    PG8_WAIT_V(6); PG8_BAR;
    for (;;) {
        const bool has_next = S.next(ui + 1, nxt);
        const char* nA = has_next ? nxt.a : cA; const char* nB = has_next ? nxt.b : cB;
        for (int t = 0; t < nt; t += 2) {
            const bool last = (t == nt - 2);
            const char* a1 = cA + (size_t)(t + 1) * kstep;
            const char* a2 = last ? nA : cA + (size_t)(t + 2) * kstep; const char* b2 = last ? nB : cB + (size_t)(t + 2) * kstep;
            const char* a3 = a2 + kstep; const char* b3 = b2 + kstep;
            PG8_LDB(B0, 0, 0); PG8_SCHED; PG8_LDA(At, 0, 0); PG8_STAGE(PG8_SA(1, 1), a1 + hstepA, voffA);
            PG8_WAIT_L(8); PG8_BAR; PG8_WAIT_L(0); PG8_MMA(0, 0, At, B0); PG8_BAR; PG8_SCHED;
            PG8_LDB(B1, 0, 1); PG8_STAGE(PG8_SB(0, 0), b2, voffB);
            PG8_BAR; PG8_WAIT_L(0); PG8_MMA(0, 1, At, B1); PG8_BAR;
            PG8_LDA(At, 0, 1); PG8_STAGE(PG8_SA(0, 0), a2, voffA);
            PG8_BAR; PG8_WAIT_L(0); PG8_MMA(1, 0, At, B0); PG8_BAR; PG8_SCHED;
            PG8_STAGE(PG8_SB(0, 1), b2 + hstepB, voffB);
            PG8_WAIT_V(6); PG8_BAR; PG8_MMA(1, 1, At, B1); PG8_BAR;
            PG8_LDB(B0, 1, 0); PG8_SCHED; PG8_LDA(At, 1, 0); PG8_STAGE(PG8_SA(0, 1), a2 + hstepA, voffA);
            PG8_WAIT_L(8); PG8_BAR; PG8_WAIT_L(0); PG8_MMA(0, 0, At, B0); PG8_BAR; PG8_SCHED;
            PG8_LDB(B1, 1, 1); PG8_STAGE(PG8_SB(1, 0), b3, voffB);
            PG8_BAR; PG8_WAIT_L(0); PG8_MMA(0, 1, At, B1); PG8_BAR;
            PG8_LDA(At, 1, 1); PG8_STAGE(PG8_SA(1, 0), a3, voffA);
            PG8_BAR; PG8_WAIT_L(0); PG8_MMA(1, 0, At, B0); PG8_BAR; PG8_SCHED;
            PG8_STAGE(PG8_SB(1, 1), b3 + hstepB, voffB);
            PG8_WAIT_V(6); PG8_BAR; PG8_MMA(1, 1, At, B1); PG8_BAR;
        }
        E(acc, cur, wr, wc, fr, fq);
        if (!has_next) break;
#pragma unroll
        for (int a = 0; a < 2; ++a)
#pragma unroll
            for (int b = 0; b < 2; ++b)
#pragma unroll
                for (int m = 0; m < 4; ++m)
#pragma unroll
                    for (int n = 0; n < 2; ++n) acc[a][b][m][n] = (f32x4){0.f, 0.f, 0.f, 0.f};
        cur = nxt; cA = nA; cB = nB; ++ui;
    }
    PG8_WAIT_V(0);
    if (wr == 0) PG8_BAR;
    PG8_BAR;
#undef PG8_SA
#undef PG8_SB
#undef PG8_STAGE
#undef PG8_LDA
#undef PG8_LDB
#undef PG8_MMA
#undef PG8_WAIT_V
#undef PG8_WAIT_L
#undef PG8_BAR
#undef PG8_SCHED
}
}


struct SchedIn {
    const char* A; const char* Bt; int G, c, trim;
    __device__ __forceinline__ bool next(int i, pg8::Unit& u) const {
        int pm, pn; const long L = (long)i * G + c;
        if (!trim) { if (!pg8::static_tile(MROWS / 256, NPAD / 256, L, pm, pn)) return false; }
        else if (L < 64 * 87) { pg8::static_tile(64, NPAD / 256, L, pm, pn); pm += pm / 16; }
        else { const int idx = (int)(L - 64 * 87); if (idx >= 4 * 15) return false; const int k = idx % 15; pm = 17 * (idx / 15) + 16; pn = k < 2 ? 4 + k : (k < 14 ? 10 + (k - 2) : 86); }
        u.pm = pm; u.pn = pn; u.tag = 0; u.a = A + (size_t)pm * 256 * DM * 2; u.b = Bt + (size_t)pn * 256 * DM * 2; return true; }
};
struct EpiIn {
    static constexpr bool PERM = true;
    bf16_t* Y; float* G32; bool dost;
    __device__ __forceinline__ void operator()(const f32x4 (&acc)[2][2][4][2], const pg8::Unit& u, int wr, int wc, int fr, int fq) const {
        if (!dost) return;
        const int pn = u.pn;
        int opq = 0; asm volatile("" : "+v"(opq));
        const int row0 = u.pm * 256 + wr * 64 + fr + opq;
        if (pn == 86) {
            if (wc == 0 && fq < 2) {
#pragma unroll
                for (int ai = 0; ai < 2; ++ai)
#pragma unroll
                    for (int m = 0; m < 4; ++m) { float* gp = G32 + (size_t)(row0 + ai * 128 + m * 16) * 16 + 8 * fq;
                        *(f32x4*)gp = acc[ai][0][m][0]; *(f32x4*)(gp + 4) = acc[ai][0][m][1]; }
            }
            return;
        }
        int act = 0;
        if ((pn >= 6 && pn < 10) || (pn >= 26 && pn < 30) || (pn >= 42 && pn < 46) || (pn >= 50 && pn < 54)) act = 1;
        else if ((pn >= 22 && pn < 26) || pn >= 54) act = 2;
        const int col0 = pn * 256 + wc * 32 + 8 * fq;
#pragma unroll
        for (int ai = 0; ai < 2; ++ai)
#pragma unroll
            for (int m = 0; m < 4; ++m) { bf16_t* rowp = Y + (size_t)(row0 + ai * 128 + m * 16) * NPAD + col0;
#pragma unroll
                for (int bj = 0; bj < 2; ++bj) { f32x4 v0 = acc[ai][bj][m][0], v1 = acc[ai][bj][m][1];
                    if (act == 1) {
#pragma unroll
                        for (int j = 0; j < 4; ++j) { v0[j] = siluf_(v0[j]); v1[j] = siluf_(v1[j]); } }
                    else if (act == 2) {
#pragma unroll
                        for (int j = 0; j < 4; ++j) { v0[j] = sigmoidf_(v0[j]); v1[j] = sigmoidf_(v1[j]); } }
                    u32x4 w; w.x = cvt_pk_bf16(v0[0], v0[1]); w.y = cvt_pk_bf16(v0[2], v0[3]); w.z = cvt_pk_bf16(v1[0], v1[1]); w.w = cvt_pk_bf16(v1[2], v1[3]);
                    *(u32x4*)(rowp + bj * 128) = w; } }
    }
};

struct SchedPool {
    const char* A; const char* Bt; int G, c, i0;
    __device__ __forceinline__ bool next(int i, pg8::Unit& u) const {
        const long L = (long)i * G + c; if (L >= (MROWS / 256) * 4) return false;
        const int pm = (int)(L >> 2), g = (int)(L & 3);
        u.pm = pm; u.pn = g; u.tag = 0; u.a = A + ((size_t)pm * 256 * BRW + g * 256) * 2; u.b = Bt + (size_t)g * 256 * 256 * 2; return true; }
};
struct EpiPool {
    static constexpr bool PERM = true;
    bf16_t* Y;
    __device__ __forceinline__ void operator()(const f32x4 (&acc)[2][2][4][2], const pg8::Unit& u, int wr, int wc, int fr, int fq) const {
        int opq = 0; asm volatile("" : "+v"(opq));
        const int row0 = u.pm * 256 + wr * 64 + fr + opq, colc = u.pn * 256 + wc * 32 + 8 * fq;
#pragma unroll
        for (int ai = 0; ai < 2; ++ai) {
            u32x4 zw[4][2];
#pragma unroll
            for (int m = 0; m < 4; ++m)
#pragma unroll
                for (int bj = 0; bj < 2; ++bj) zw[m][bj] = *(const u32x4*)(Y + (size_t)(row0 + ai * 128 + m * 16) * NPAD + C_PZ + colc + bj * 128);
#pragma unroll
            for (int m = 0; m < 4; ++m)
#pragma unroll
                for (int bj = 0; bj < 2; ++bj) { float z[8]; unpack8(zw[m][bj], z);
                    const f32x4 v0 = acc[ai][bj][m][0], v1 = acc[ai][bj][m][1]; float o[8];
#pragma unroll
                    for (int j = 0; j < 4; ++j) { o[j] = v0[j] * z[j]; o[4 + j] = v1[j] * z[4 + j]; }
                    *(u32x4*)(Y + (size_t)(row0 + ai * 128 + m * 16) * NPAD + C_PZ + colc + bj * 128) = pack8(o); }
            asm volatile("" ::: "memory"); }
    }
};

struct SchedMerge {
    const char* Y; const char* Wbr; int G, c, nM;
    __device__ __forceinline__ bool next(int i, pg8::Unit& u) const {
        const long L = (long)(i >> 2) * G + c; const int br = i & 3; if (L >= (long)nM * 8) return false;
        const int pm = (int)(L >> 3), pn = (int)(L & 7);
        const int pmr = (nM == 64) ? (pm + pm / 16) : pm;
        const int coff = br == 0 ? C_AQ : (br == 1 ? C_MO : (br == 2 ? C_CZ : C_PZ));
        u.pm = pmr; u.pn = pn; u.tag = br; u.a = Y + ((size_t)pmr * 256 * NPAD + coff) * 2; u.b = Wbr + ((size_t)br * DM * BRW + (size_t)pn * 256 * BRW) * 2; return true; }
};
struct EpiMerge {
    static constexpr bool PERM = true;
    const bf16_t* Y; bf16_t* accb;
    __device__ __forceinline__ void operator()(const f32x4 (&acc)[2][2][4][2], const pg8::Unit& u, int wr, int wc, int fr, int fq) const {
        int opq = 0; asm volatile("" : "+v"(opq));
        const int row0 = u.pm * 256 + wr * 64 + fr + opq, col0 = u.pn * 256 + wc * 32 + 8 * fq, tag = u.tag;
#pragma unroll
        for (int ai = 0; ai < 2; ++ai) {
            u32x4 gw[4][2], pw[4][2];
#pragma unroll
            for (int m = 0; m < 4; ++m) { const size_t row = (size_t)(row0 + ai * 128 + m * 16);
#pragma unroll
                for (int bj = 0; bj < 2; ++bj) { gw[m][bj] = *(const u32x4*)(Y + row * NPAD + C_GM + tag * DM + col0 + bj * 128);
                    pw[m][bj] = tag != 0 ? *(const u32x4*)(accb + row * DM + col0 + bj * 128) : (u32x4){0u, 0u, 0u, 0u}; } }
#pragma unroll
            for (int m = 0; m < 4; ++m) { const size_t row = (size_t)(row0 + ai * 128 + m * 16);
#pragma unroll
                for (int bj = 0; bj < 2; ++bj) { float gt[8], pv[8]; unpack8(gw[m][bj], gt); unpack8(pw[m][bj], pv);
                    const f32x4 v0 = acc[ai][bj][m][0], v1 = acc[ai][bj][m][1]; float o[8];
#pragma unroll
                    for (int j = 0; j < 4; ++j) { o[j] = v0[j] * gt[j] + pv[j]; o[4 + j] = v1[j] * gt[4 + j] + pv[4 + j]; }
                    *(u32x4*)(accb + row * DM + col0 + bj * 128) = pack8(o); } }
            asm volatile("" ::: "memory"); }
    }
};

struct SchedOut {
    const char* A; const char* Bt; int G, c, nM;
    __device__ __forceinline__ bool next(int i, pg8::Unit& u) const {
        const long L = (long)i * G + c; if (L >= (long)nM * 8) return false;
        const int pm = (int)(L >> 3), pn = (int)(L & 7);
        const int pmr = (nM == 64) ? (pm + pm / 16) : pm;
        u.pm = pmr; u.pn = pn; u.tag = 0; u.a = A + (size_t)pmr * 256 * DM * 2; u.b = Bt + (size_t)pn * 256 * DM * 2; return true; }
};
struct EpiOut {
    static constexpr bool PERM = false;
    const float* xin; const float* ctxin;
    const float* mod;
    bf16_t* X1; int first;
    __device__ __forceinline__ void operator()(const f32x4 (&acc)[2][2][4][2], const pg8::Unit& u, int wr, int wc, int fr, int fq) const {
        const int b = u.pm / 17, j = u.pm % 17; const bool isctx = (j == 16);
        int opq = 0; asm volatile("" : "+v"(opq));
        const int rin = wr * 64 + fr + opq;
        const int col0 = u.pn * 256 + wc * 32 + 4 * fq;
        const float* gtp = mod + (size_t)(isctx ? 4 : b) * 6144 + 4096 + col0;
        const float* resb = isctx ? ctxin + (size_t)b * LC * DM : xin + ((size_t)b * TL + (size_t)j * 256) * DM;
        bf16_t* xb = X1 + (size_t)u.pm * 256 * DM;
        f32x4 gv[2][2];
#pragma unroll
        for (int bj = 0; bj < 2; ++bj)
#pragma unroll
            for (int n = 0; n < 2; ++n) gv[bj][n] = *(const f32x4*)(gtp + bj * 128 + n * 16);
#pragma unroll
        for (int ai = 0; ai < 2; ++ai) {
            f32x4 rv[4][2][2];
#pragma unroll
            for (int m = 0; m < 4; ++m) { const size_t off = (size_t)(rin + ai * 128 + m * 16) * DM + col0;
#pragma unroll
                for (int bj = 0; bj < 2; ++bj)
#pragma unroll
                    for (int n = 0; n < 2; ++n) {
                        if (first) rv[m][bj][n] = *(const f32x4*)(resb + off + bj * 128 + n * 16);
                        else { const u32x2 w = *(const u32x2*)(xb + off + bj * 128 + n * 16); rv[m][bj][n] = (f32x4){bflo(w.x), bfhi(w.x), bflo(w.y), bfhi(w.y)}; } } }
#pragma unroll
            for (int m = 0; m < 4; ++m) { const size_t off = (size_t)(rin + ai * 128 + m * 16) * DM + col0;
#pragma unroll
                for (int bj = 0; bj < 2; ++bj)
#pragma unroll
                    for (int n = 0; n < 2; ++n) { const f32x4 o = rv[m][bj][n] + gv[bj][n] * acc[ai][bj][m][n];
                        u32x2 w; w.x = cvt_pk_bf16(o[0], o[1]); w.y = cvt_pk_bf16(o[2], o[3]); *(u32x2*)(xb + off + bj * 128 + n * 16) = w; } }
            asm volatile("" ::: "memory"); }
    }
};

namespace att {
constexpr int D = 128, NW = 8, QBLK = 32, KVBLK = 64;
constexpr float SCALE = 0.088388347648318440f;
constexpr float THR = 8.f;
constexpr int LDQ = NPAD, LDK = NPAD;
constexpr size_t SHM_V = KVBLK * D * 2, SHM_K = KVBLK * D * 2, SHM_ATTN = 2 * SHM_V + 2 * SHM_K + NW * 64 * 4;
#define KSWZ(row, colB) ((row) * 256 + ((colB) ^ (((row) & 7) << 4)))
#define SBAR() __builtin_amdgcn_sched_barrier(0)
__device__ __forceinline__ int crow(int r, int hi) { return (r & 3) + 8 * (r >> 2) + 4 * hi; }
__device__ __forceinline__ void partialSM(f32x16& p0, f32x16& p1, float& m_reg, float& mn, float& alpha) {
  constexpr float C = SCALE * 1.4426950408889634f;
  float pmax = p0[0]; for (int r = 1; r < 16; ++r) pmax = fmaxf(pmax, p0[r]); for (int r = 0; r < 16; ++r) pmax = fmaxf(pmax, p1[r]);
  { auto rr = __builtin_amdgcn_permlane32_swap(__float_as_uint(pmax), __float_as_uint(pmax), false, false);
    pmax = fmaxf(__uint_as_float(rr[0]), __uint_as_float(rr[1])); }
  if (__builtin_expect(__all(pmax - m_reg <= THR / SCALE), 1)) { mn = m_reg; alpha = 1.f; }
  else { mn = fmaxf(m_reg, pmax); alpha = __builtin_amdgcn_exp2f((m_reg - mn) * C); m_reg = mn; }
  float mnC = -mn * C;
  for (int r = 0; r < 16; ++r) p0[r] = fmaf(p0[r], C, mnC); for (int r = 0; r < 16; ++r) p1[r] = fmaf(p1[r], C, mnC);
  for (int r = 0; r < 16; ++r) p0[r] = __builtin_amdgcn_exp2f(p0[r]);
}
__device__ __forceinline__ void finishSM(f32x16& p0, f32x16& p1, float alpha, float& l_reg, bf16x8& pa0, bf16x8& pa1, bf16x8& pa2, bf16x8& pa3) {
  for (int r = 0; r < 16; ++r) p1[r] = __builtin_amdgcn_exp2f(p1[r]);
  float ps = 0; for (int r = 0; r < 16; ++r) ps += p0[r]; for (int r = 0; r < 16; ++r) ps += p1[r];
  { auto rr = __builtin_amdgcn_permlane32_swap(__float_as_uint(ps), __float_as_uint(ps), false, false);
    ps = __uint_as_float(rr[0]) + __uint_as_float(rr[1]); }
  l_reg = l_reg * alpha + ps;
#define PK4(P, BASE, OUT) do { unsigned a0 = cvt_pk_bf16(P[BASE + 0], P[BASE + 1]), a1 = cvt_pk_bf16(P[BASE + 2], P[BASE + 3]);   \
    unsigned b0 = cvt_pk_bf16(P[BASE + 4], P[BASE + 5]), b1 = cvt_pk_bf16(P[BASE + 6], P[BASE + 7]);                              \
    auto r0 = __builtin_amdgcn_permlane32_swap(a0, b0, false, false); auto r1 = __builtin_amdgcn_permlane32_swap(a1, b1, false, false); \
    u32x4 w = {r0[0], r1[0], r0[1], r1[1]}; OUT = *reinterpret_cast<bf16x8*>(&w); } while (0)
  PK4(p0, 0, pa0); PK4(p0, 8, pa1); PK4(p1, 0, pa2); PK4(p1, 8, pa3);
#undef PK4
}
__device__ __forceinline__ void qkt(f32x16& p0, f32x16& p1, const bf16_t* Ks, const bf16x8* qr, int r32, int hi) {
  p0 = f32x16{}; p1 = f32x16{};
  for (int d0 = 0; d0 < 8; ++d0) { int cb = (d0 * 16 + hi * 8) * 2;
    bf16x8 b0 = *reinterpret_cast<const bf16x8*>((const char*)Ks + KSWZ(r32, cb));
    bf16x8 b1 = *reinterpret_cast<const bf16x8*>((const char*)Ks + KSWZ(32 + r32, cb));
    p0 = __builtin_amdgcn_mfma_f32_32x32x16_bf16(b0, qr[d0], p0, 0, 0, 0);
    p1 = __builtin_amdgcn_mfma_f32_32x32x16_bf16(b1, qr[d0], p1, 0, 0, 0); }
}
__device__ __forceinline__ int v_st(int k, int c) { const int kk = (k & ~0xC) | ((k & 4) << 1) | ((k & 8) >> 1); return ((kk >> 3) * 4 + (c >> 5)) * 512 + ((kk & 7) * 32 + (c & 31)) * 2; }
__device__ __forceinline__ int v_rd_base(int lane) { return ((lane & 3) << 3) | (((lane >> 2) & 3) << 6) | (((lane >> 4) & 1) << 5) | (((lane >> 5) & 1) << 8); }
constexpr int v_rd_off(int d0, int ks, int half) { return d0 * 512 + ks * 4096 + half * 2048; }
template <int OFF> __device__ __forceinline__ s16x4 tr_read(int vb) {
  s16x4 r; asm volatile("ds_read_b64_tr_b16 %0, %1 offset:%2" : "=&v"(r) : "v"(vb), "i"(OFF) : "memory"); return r;
}
template <int D0> __device__ __forceinline__ void pv_one(f32x16& od, int vb, bf16x8 pa0, bf16x8 pa1, bf16x8 pa2, bf16x8 pa3) {
  const s16x4 l0 = tr_read<v_rd_off(D0, 0, 0)>(vb), h0 = tr_read<v_rd_off(D0, 0, 1)>(vb), l1 = tr_read<v_rd_off(D0, 1, 0)>(vb), h1 = tr_read<v_rd_off(D0, 1, 1)>(vb);
  const s16x4 l2 = tr_read<v_rd_off(D0, 2, 0)>(vb), h2 = tr_read<v_rd_off(D0, 2, 1)>(vb), l3 = tr_read<v_rd_off(D0, 3, 0)>(vb), h3 = tr_read<v_rd_off(D0, 3, 1)>(vb);
  asm volatile("s_waitcnt lgkmcnt(0)" ::: "memory"); SBAR();
#define PK(L, H) (bf16x8){L[0], L[1], L[2], L[3], H[0], H[1], H[2], H[3]}
  od = __builtin_amdgcn_mfma_f32_32x32x16_bf16(pa0, PK(l0, h0), od, 0, 0, 0);
  od = __builtin_amdgcn_mfma_f32_32x32x16_bf16(pa1, PK(l1, h1), od, 0, 0, 0);
  od = __builtin_amdgcn_mfma_f32_32x32x16_bf16(pa2, PK(l2, h2), od, 0, 0, 0);
  od = __builtin_amdgcn_mfma_f32_32x32x16_bf16(pa3, PK(l3, h3), od, 0, 0, 0);
#undef PK
}
__device__ __forceinline__ void pv_d0(f32x16* o, int vb, bf16x8 pa0, bf16x8 pa1, bf16x8 pa2, bf16x8 pa3) {
  pv_one<0>(o[0], vb, pa0, pa1, pa2, pa3); pv_one<1>(o[1], vb, pa0, pa1, pa2, pa3); pv_one<2>(o[2], vb, pa0, pa1, pa2, pa3); pv_one<3>(o[3], vb, pa0, pa1, pa2, pa3);
}
__device__ __forceinline__ void attn_dense_body(bf16_t* __restrict__ Qb, const bf16_t* __restrict__ Kh, const bf16_t* __restrict__ Vh, const bf16_t* __restrict__ Zb, int seq, char* lds) {
  const int tid = otid(), wid = tid >> 6, lane = tid & 63, r32 = lane & 31, hi = lane >> 5;
  bf16_t* V_lds = (bf16_t*)lds; bf16_t* K_lds = (bf16_t*)(lds + 2 * SHM_V);
  float* ws = (float*)(lds + 2 * SHM_V + 2 * SHM_K) + wid * 64; float* li_l = ws; float* al_l = ws + 32;
  float m_reg = -1e30f, l_reg = 0; f32x16 o[4] = {}; bf16x8 qr[8];
  const bf16_t* Qw = Qb + (long)(wid * QBLK + r32) * LDQ + hi * 8;
#pragma unroll
  for (int d0 = 0; d0 < 8; ++d0) qr[d0] = *reinterpret_cast<const bf16x8*>(Qw + d0 * 16);
  const int sr = tid >> 4, sc = (tid & 15) * 8, vst0 = v_st(sr, sc), vst1 = v_st(32 + sr, sc);
  const int vb0 = (int)(uintptr_t)V_lds + v_rd_base(lane);
  struct { bf16x8 vs0, vs1, ks0, ks1; } sr_[2];
#define SLOAD(i, k0) do { sr_[i].vs0 = *reinterpret_cast<const bf16x8*>(&Vh[(long)((k0) + sr) * LDK + sc]); sr_[i].vs1 = *reinterpret_cast<const bf16x8*>(&Vh[(long)((k0) + 32 + sr) * LDK + sc]); \
    sr_[i].ks0 = *reinterpret_cast<const bf16x8*>(&Kh[(long)((k0) + sr) * LDK + sc]); sr_[i].ks1 = *reinterpret_cast<const bf16x8*>(&Kh[(long)((k0) + 32 + sr) * LDK + sc]); } while (0)
#define SWRITE(b, i) do { *(bf16x8*)((char*)V_lds + (b) * SHM_V + vst0) = sr_[i].vs0;          \
    *(bf16x8*)((char*)V_lds + (b) * SHM_V + vst1) = sr_[i].vs1; int kc = sc * 2;               \
    *(bf16x8*)((char*)K_lds + (b) * SHM_K + KSWZ(sr, kc)) = sr_[i].ks0;                       \
    *(bf16x8*)((char*)K_lds + (b) * SHM_K + KSWZ(32 + sr, kc)) = sr_[i].ks1; } while (0)
#define SWAIT() do { asm volatile("s_waitcnt vmcnt(4)" ::: "memory"); } while (0)
#define RESC(a) do { if (__any((a) < 1.f)) { if (hi == 0) al_l[r32] = (a); asm volatile("s_waitcnt lgkmcnt(0)" ::: "memory"); \
    for (int d = 0; d < 4; ++d) for (int r = 0; r < 16; ++r) o[d][r] *= al_l[crow(r, hi)]; } } while (0)
  f32x16 pA0, pA1, pB0, pB1; float mnA, mnB, alA, alB; bf16x8 pa0, pa1, pa2, pa3; const int NT = seq / KVBLK;
  constexpr int SE = 0, SO = 1;
  SLOAD(SE, 0); asm volatile("s_waitcnt vmcnt(0)" ::: "memory"); SWRITE(0, SE); __syncthreads();
  qkt(pA0, pA1, K_lds, qr, r32, hi); partialSM(pA0, pA1, m_reg, mnA, alA);
  SLOAD(SO, KVBLK); { if (2 < NT) SLOAD(SE, 2 * KVBLK); }
  SWAIT(); SWRITE(1, SO); __syncthreads();
  for (int j = 1; j + 1 < NT; j += 2) {
    SBAR(); qkt(pB0, pB1, (bf16_t*)((char*)K_lds + SHM_K), qr, r32, hi);
    finishSM(pA0, pA1, alA, l_reg, pa0, pa1, pa2, pa3); SBAR();
    SLOAD(SO, (j + 2) * KVBLK); SBAR();
    pv_d0(o, vb0, pa0, pa1, pa2, pa3); partialSM(pB0, pB1, m_reg, mnB, alB);
    __syncthreads(); SWAIT(); SWRITE(0, SE);
    RESC(alB); __syncthreads();
    SBAR(); qkt(pA0, pA1, K_lds, qr, r32, hi);
    finishSM(pB0, pB1, alB, l_reg, pa0, pa1, pa2, pa3); SBAR();
    if (j + 3 < NT) SLOAD(SE, (j + 3) * KVBLK); SBAR();
    pv_d0(o, vb0 + (int)SHM_V, pa0, pa1, pa2, pa3); partialSM(pA0, pA1, m_reg, mnA, alA);
    __syncthreads(); SWAIT(); SWRITE(1, SO);
    RESC(alA); __syncthreads();
  }
  SBAR(); qkt(pB0, pB1, (bf16_t*)((char*)K_lds + SHM_K), qr, r32, hi);
  finishSM(pA0, pA1, alA, l_reg, pa0, pa1, pa2, pa3); SBAR();
  pv_d0(o, vb0, pa0, pa1, pa2, pa3); partialSM(pB0, pB1, m_reg, mnB, alB);
  __syncthreads(); RESC(alB);
  finishSM(pB0, pB1, alB, l_reg, pa0, pa1, pa2, pa3); SBAR();
  pv_d0(o, vb0 + (int)SHM_V, pa0, pa1, pa2, pa3);
  if (hi == 0) li_l[r32] = l_reg; asm volatile("s_waitcnt lgkmcnt(0)" ::: "memory");
  float rli[16];
#pragma unroll
  for (int r = 0; r < 16; ++r) rli[r] = __builtin_amdgcn_rcpf(li_l[crow(r, hi)]);
  bf16_t* Ol = (bf16_t*)(lds + SHM_ATTN) + wid * (32 * 136);
#pragma unroll
  for (int r = 0; r < 16; ++r) { const int row = crow(r, hi);
#pragma unroll
    for (int d0 = 0; d0 < 4; ++d0) Ol[row * 136 + 32 * d0 + r32] = f2bf(o[d0][r] * rli[r]); }
  asm volatile("s_waitcnt lgkmcnt(0)" ::: "memory");
  int opq = 0; asm volatile("" : "+v"(opq));
  const long gbase = (long)(wid * QBLK + opq) * LDQ;
  u32x4 ov[8], zv[8];
#pragma unroll
  for (int it = 0; it < 8; ++it) { const int chunk = it * 64 + lane, row = chunk >> 4, c8 = (chunk & 15) * 8;
    ov[it] = *(const u32x4*)(Ol + row * 136 + c8); zv[it] = *(const u32x4*)(Zb + gbase + (long)row * LDQ + c8); }
#pragma unroll
  for (int it = 0; it < 8; ++it) { const int chunk = it * 64 + lane, row = chunk >> 4, c8 = (chunk & 15) * 8;
    float of[8], zf[8], rf[8]; unpack8(ov[it], of); unpack8(zv[it], zf);
#pragma unroll
    for (int e = 0; e < 8; ++e) rf[e] = of[e] * zf[e];
    *(u32x4*)(Qb + gbase + (long)row * LDQ + c8) = pack8(rf); }
#undef SLOAD
#undef SWRITE
#undef SWAIT
#undef RESC
}
}

template <int KT>
__device__ __forceinline__ void tconv_tile(const float* __restrict__ src, int ld, int K, bool remap, bf16_t* __restrict__ dst, int n0, int k0, unsigned char* smem, const float* __restrict__ nscale = nullptr) {
    const int tid = otid(), kk = tid >> 4, n4 = (tid & 15) * 4;
    constexpr int LDT = KT + 8, NJ = KT / 32;
    bf16_t* tile = (bf16_t*)smem;
    const int n = n0 + n4; int sc = n; bool zero = false;
    if (remap) { if (n < 7680) sc = n; else if (n < 22016) sc = n + 16; else if (n < 22032) sc = 7680 + (n - 22016); else zero = true; }
    f32x4 v[NJ];
    const f32x4 nsc = nscale ? *(const f32x4*)(nscale + n) : (f32x4){1.f, 1.f, 1.f, 1.f};
#pragma unroll
    for (int j = 0; j < NJ; ++j) v[j] = zero ? (f32x4){0.f, 0.f, 0.f, 0.f} : *(const f32x4*)(src + (size_t)(k0 + kk + 32 * j) * ld + sc) * nsc;
#pragma unroll
    for (int j = 0; j < NJ; ++j)
#pragma unroll
        for (int i = 0; i < 4; ++i) tile[(n4 + i) * LDT + kk + 32 * j] = f2bf(v[j][i]);
    __syncthreads();
#pragma unroll
    for (int j = 0; j < KT / 64; ++j) { const int idx = tid + 512 * j, nn = idx / (KT / 8), k8 = (idx % (KT / 8)) * 8;
        *(u32x4*)(dst + (size_t)(n0 + nn) * K + k0 + k8) = *(const u32x4*)(tile + nn * LDT + k8); }
    __syncthreads();
}
__device__ __forceinline__ void mod_unit(const Params& p, int l, int cb, unsigned char* smem) {
    const int tid = otid();
    float* sc = (float*)smem; float* red = sc + 5 * 2048;
    for (int i = tid; i < 5 * 2048; i += 512) { const int r = i >> 11, k = i & 2047; const float v = r < 4 ? p.c[r * 2048 + k] : p.c_ctx[k]; sc[i] = siluf_(v); }
    __syncthreads();
    const int col4 = (tid & 15) * 4, ks = tid >> 4;
    f32x4 a0 = {0, 0, 0, 0}, a1 = a0, a2 = a0, a3 = a0, a4 = a0;
    const float* wp = p.w_mod + (size_t)l * 2048 * 6144 + (size_t)(ks * 64) * 6144 + cb * 64 + col4;
#pragma unroll 8
    for (int kk = 0; kk < 64; ++kk) { const f32x4 w = *(const f32x4*)(wp + (size_t)kk * 6144); const int k = ks * 64 + kk;
        a0 += sc[k] * w; a1 += sc[2048 + k] * w; a2 += sc[4096 + k] * w; a3 += sc[6144 + k] * w; a4 += sc[8192 + k] * w; }
    *(f32x4*)(red + (ks * 5 + 0) * 64 + col4) = a0; *(f32x4*)(red + (ks * 5 + 1) * 64 + col4) = a1; *(f32x4*)(red + (ks * 5 + 2) * 64 + col4) = a2;
    *(f32x4*)(red + (ks * 5 + 3) * 64 + col4) = a3; *(f32x4*)(red + (ks * 5 + 4) * 64 + col4) = a4;
    __syncthreads();
    if (tid < 320) { const int r = tid >> 6, cc = tid & 63; float s = p.b_mod[l * 6144 + cb * 64 + cc];
        for (int q = 0; q < 32; ++q) s += red[(q * 5 + r) * 64 + cc];
        ((float*)(p.ws + WS_MOD))[(size_t)(l * 5 + r) * 6144 + cb * 64 + cc] = s; }
    __syncthreads();
}
constexpr int U_WIN1 = 348 * 4, U_WBR1 = 4 * 32 * 2, U_WOUT1 = 32 * 4, U_POOL1 = 4 * 4, U_CONV1 = U_WIN1 + U_WBR1 + U_WOUT1 + U_POOL1;
__device__ __forceinline__ void conv_unit(const Params& p, int l, int v, unsigned char* smem) {
    if (v < U_WIN1) { const int nt = v >> 2, kt = v & 3;
        tconv_tile<512>(p.w_in + (size_t)l * DM * NIN, NIN, DM, true, (bf16_t*)(p.ws + WS_WIN) + (size_t)l * NPAD * DM, nt * 64, kt * 512, smem); return; }
    v -= U_WIN1;
    if (v < U_WBR1) { const int mat = l * 4 + (v >> 6), r = v & 63, nt = r >> 1, kt = r & 1;
        tconv_tile<512>(p.w_branch + (size_t)mat * BRW * DM, DM, BRW, false, (bf16_t*)(p.ws + WS_WBR) + (size_t)mat * DM * BRW, nt * 64, kt * 512, smem); return; }
    v -= U_WBR1;
    if (v < U_WOUT1) { const int nt = v >> 2, kt = v & 3;
        tconv_tile<512>(p.w_out + (size_t)l * DM * DM, DM, DM, false, (bf16_t*)(p.ws + WS_WOUT) + (size_t)l * DM * DM, nt * 64, kt * 512, smem); return; }
    v -= U_WOUT1;
    { const int mat = l * 4 + (v >> 2), nt = v & 3;
        tconv_tile<256>(p.pool_w + (size_t)mat * 256 * 256, 256, 256, false, (bf16_t*)(p.ws + WS_POOLW) + (size_t)mat * 256 * 256, nt * 64, 0, smem, p.pool_scale + (size_t)mat * 256); }
}
__device__ void phase_prep(const Params& p, unsigned char* smem) {
    constexpr int U_MOD = 192;
    for (int u = blockIdx.x; u < U_MOD + U_CONV1; u += gridDim.x) {
        if (u < U_MOD) mod_unit(p, u / 96, u % 96, smem); else conv_unit(p, 0, u - U_MOD, smem);
    }
}

__device__ void phase_norm(const Params& p, int l) {
    const int tid = otid(), lane = tid & 63, wv = obid() * 8 + (tid >> 6), nwv = gridDim.x * 8;
    const float* mod = (const float*)(p.ws + WS_MOD) + (size_t)l * 5 * 6144;
    const float* gain = p.norm_gain + l * DM;
    bf16_t* H = (bf16_t*)(p.ws + WS_H);
    for (int row = wv; row < MROWS; row += nwv) {
        const int b = row / RPB, tt = row % RPB; const bool isctx = tt >= TL;
        const float* xr = isctx ? p.ctx + ((size_t)b * LC + (tt - TL)) * DM : p.x + ((size_t)b * TL + tt) * DM;
        const bf16_t* xb = (const bf16_t*)(p.ws + WS_X1) + (size_t)row * DM;
        const float* mr = mod + (size_t)(isctx ? 4 : b) * 6144;
        f32x4 v[8]; float ss = 0.f;
#pragma unroll
        for (int j = 0; j < 8; ++j) {
            if (l == 0) v[j] = *(const f32x4*)(xr + 256 * j + 4 * lane);
            else { const u32x2 w = *(const u32x2*)(xb + 256 * j + 4 * lane); v[j] = (f32x4){bflo(w.x), bfhi(w.x), bflo(w.y), bfhi(w.y)}; }
            ss += v[j][0] * v[j][0] + v[j][1] * v[j][1] + v[j][2] * v[j][2] + v[j][3] * v[j][3]; }
#pragma unroll
        for (int o = 32; o >= 1; o >>= 1) ss += __shfl_xor(ss, o);
        const float rstd = rsqrtf(ss * (1.0f / DM) + EPS);
#pragma unroll
        for (int j = 0; j < 8; ++j) { const int cidx = 256 * j + 4 * lane;
            const f32x4 g = *(const f32x4*)(gain + cidx), sh = *(const f32x4*)(mr + cidx), sc = *(const f32x4*)(mr + 2048 + cidx);
            f32x4 y = v[j] * rstd * g * (1.0f + sc) + sh;
            u32x2 w; w.x = cvt_pk_bf16(y[0], y[1]); w.y = cvt_pk_bf16(y[2], y[3]);
            *(u32x2*)(H + (size_t)row * DM + cidx) = w; }
    }
}
__device__ void phase_final(const Params& p) {
    const int tid = otid(), lane = tid & 63, wv = obid() * 8 + (tid >> 6), nwv = gridDim.x * 8;
    for (int row = wv; row < NB * TL; row += nwv) {
        const int b = row / TL, t = row % TL;
        const bf16_t* xb = (const bf16_t*)(p.ws + WS_X1) + (size_t)(b * RPB + t) * DM;
        float* xr = p.out + (size_t)row * DM;
        f32x4 v[8]; float ss = 0.f;
#pragma unroll
        for (int j = 0; j < 8; ++j) { const u32x2 w = *(const u32x2*)(xb + 256 * j + 4 * lane); v[j] = (f32x4){bflo(w.x), bfhi(w.x), bflo(w.y), bfhi(w.y)};
            ss += v[j][0] * v[j][0] + v[j][1] * v[j][1] + v[j][2] * v[j][2] + v[j][3] * v[j][3]; }
#pragma unroll
        for (int o = 32; o >= 1; o >>= 1) ss += __shfl_xor(ss, o);
        const float rstd = rsqrtf(ss * (1.0f / DM) + EPS);
#pragma unroll
        for (int j = 0; j < 8; ++j) { const int cidx = 256 * j + 4 * lane; const f32x4 g = *(const f32x4*)(p.final_gain + cidx); *(f32x4*)(xr + cidx) = v[j] * rstd * g; }
    }
}

__device__ __forceinline__ int seq_row(int b, int dir, int pos  ) {
    if (pos < LC) { const int o = dir ? (LC - 1 - pos) : pos; return b * RPB + TL + o; }
    const int q = pos - LC; const int o = dir ? (TL - 1 - q) : q; return b * RPB + o;
}
__device__ void phase_mix1(const Params& p, int l, unsigned char* smem) {
    const int tid = otid(), lane = tid & 63, wv = obid() * 8 + (tid >> 6), nwv = gridDim.x * 8;
    bf16_t* Y = (bf16_t*)(p.ws + WS_Y);
    if ((int)blockIdx.x >= (int)gridDim.x - 32) {
        const int sq = blockIdx.x - (gridDim.x - 32), dir = sq & 1, hd = (sq >> 1) & 3, b = sq >> 3, wid = tid >> 6;
        const float* G32 = (const float*)(p.ws + WS_G32);
        f32x4* GT4 = (f32x4*)(p.ws + WS_GT4) + (size_t)sq * RPB; float* GW = (float*)(p.ws + WS_GW) + (size_t)sq * RPB; float* GD = (float*)(p.ws + WS_GD) + sq * 128;
        const float bi = p.gate_bias[l * 16 + (dir ? 8 : 0) + hd], bfv = p.gate_bias[l * 16 + (dir ? 12 : 4) + hd];
        float* sAq = (float*)smem; float* sCm = sAq + RPB; float* sB = sCm + RPB; float* sB63 = sB + RPB; float* sC63 = sB63 + 128; float* sMc = sC63 + 128;
        for (int ci = wid; ci < NCHUNK; ci += 8) {
            const int pos = ci * 64 + lane, row = seq_row(b, dir, pos);
            const float gi = G32[(size_t)row * 16 + (dir ? 8 : 0) + hd] + bi, gf = G32[(size_t)row * 16 + (dir ? 12 : 4) + hd] + bfv;
            const float lf = fminf(gf, 0.f) - log1pf(__expf(-fabsf(gf)));
            float bsum = lf;
#pragma unroll
            for (int o = 1; o < 64; o <<= 1) { const float t = __shfl_up(bsum, o); if (lane >= o) bsum += t; }
            const float a = gi - bsum; float cm = a;
#pragma unroll
            for (int o = 1; o < 64; o <<= 1) { const float t = __shfl_up(cm, o); if (lane >= o) cm = fmaxf(cm, t); }
            sAq[pos] = a; sCm[pos] = cm; sB[pos] = bsum;
            if (lane == 63) { sB63[ci] = bsum; sC63[ci] = cm; }
        }
        __syncthreads();
        if (tid == 0) { float m = -1e30f; for (int ci = 0; ci < NCHUNK; ++ci) { sMc[ci] = m; m = sB63[ci] + fmaxf(m, sC63[ci]); } }
        __syncthreads();
        for (int pos = tid; pos < RPB; pos += 512) {
            const int ci = pos >> 6; const float m = sMc[ci], M = fmaxf(m, sCm[pos]), M63 = fmaxf(m, sC63[ci]), a = sAq[pos], bsum = sB[pos];
            GT4[pos] = (f32x4){a, M, fexp(m - M), fexp(-(bsum + M))}; GW[pos] = fexp(a - M63); if ((pos & 63) == 0) GD[ci] = fexp(m - M63);
        }
        return;
    }
    const int nw2 = nwv - 32 * 8;
    {
        const float* qg = p.q_gain + l * 128; const float* kg = p.k_gain + l * 128;
        const int j = lane & 31, hw = lane >> 5;
        const bool second = (j >> 3) & 1, colpart = j >= 16;
        float frq[4];
#pragma unroll
        for (int e = 0; e < 4; ++e) frq[e] = __builtin_amdgcn_exp2f(-(float)(4 * (j & 7) + e) * (13.287712379549449f / 32.0f));
        const f32x4 qg4 = *(const f32x4*)(qg + 4 * j), kg4 = *(const f32x4*)(kg + 4 * j);
        for (int row = wv; row < MROWS; row += nw2) {
            const int tt = row % RPB; const bool lat = tt < TL;
            float cs[4], sn[4];
            const float pos = lat ? (float)(colpart ? (tt & 63) : (tt >> 6)) : 0.f;
#pragma unroll
            for (int e = 0; e < 4; ++e) { const float ang = pos * frq[e]; cs[e] = __cosf(ang); sn[e] = __sinf(ang); }
            bf16_t* rb = Y + (size_t)row * NPAD + 4 * j;
            u32x2 raw[5];
#pragma unroll
            for (int it = 0; it < 5; ++it) { const int hh = it * 2 + hw; raw[it] = *(const u32x2*)(rb + (hh < 8 ? C_AQ + hh * 128 : C_AK + (hh - 8) * 128)); }
#pragma unroll
            for (int it = 0; it < 5; ++it) { const int hh = it * 2 + hw;
                float x[4] = {bflo(raw[it].x), bfhi(raw[it].x), bflo(raw[it].y), bfhi(raw[it].y)};
                float ss = x[0] * x[0] + x[1] * x[1] + x[2] * x[2] + x[3] * x[3];
#pragma unroll
                for (int o = 16; o >= 1; o >>= 1) ss += __shfl_xor(ss, o);
                const float rstd = rsqrtf(ss * (1.0f / 128.0f) + EPS);
                const f32x4 gn = hh < 8 ? qg4 : kg4;
                float y[4];
#pragma unroll
                for (int e = 0; e < 4; ++e) { x[e] *= rstd * gn[e]; }
#pragma unroll
                for (int e = 0; e < 4; ++e) { const float pr = __shfl_xor(x[e], 8); y[e] = second ? (x[e] * cs[e] + pr * sn[e]) : (x[e] * cs[e] - pr * sn[e]); }
                u32x2 w; w.x = cvt_pk_bf16(y[0], y[1]); w.y = cvt_pk_bf16(y[2], y[3]);
                *(u32x2*)(rb + (hh < 8 ? C_AQ + hh * 128 : C_AK + (hh - 8) * 128)) = w;
            }
        }
    }
    {
        bf16_t* DMB = (bf16_t*)(p.ws + WS_H);
        const float* cw = p.conv_w + (size_t)l * 3 * BRW;
        const int nth = nw2 * 64, th = wv * 64 + lane;
        for (int task = th; task < MROWS * 128; task += nth) {
            const int row = task >> 7, c8 = (task & 127) * 8;
            const int tt = row % RPB; const bool lat = tt < TL; const int t = lat ? tt : tt - TL, T = lat ? TL : LC;
            const bf16_t* yr = Y + (size_t)row * NPAD;
            u32x4 convw;
            {
                float a0[8], a1[8], a2[8], u[8], g[8];
                unpack8(*(const u32x4*)(yr + C_CU + c8), u); unpack8(*(const u32x4*)(yr + C_CC + c8), g);
#pragma unroll
                for (int i = 0; i < 8; ++i) a1[i] = u[i] * g[i];
                if (t > 0) { unpack8(*(const u32x4*)(yr - NPAD + C_CU + c8), u); unpack8(*(const u32x4*)(yr - NPAD + C_CC + c8), g);
#pragma unroll
                    for (int i = 0; i < 8; ++i) a0[i] = u[i] * g[i]; }
                else {
#pragma unroll
                    for (int i = 0; i < 8; ++i) a0[i] = 0.f; }
                if (t < T - 1) { unpack8(*(const u32x4*)(yr + NPAD + C_CU + c8), u); unpack8(*(const u32x4*)(yr + NPAD + C_CC + c8), g);
#pragma unroll
                    for (int i = 0; i < 8; ++i) a2[i] = u[i] * g[i]; }
                else {
#pragma unroll
                    for (int i = 0; i < 8; ++i) a2[i] = 0.f; }
                float bg[8], z[8], o[8];
                unpack8(*(const u32x4*)(yr + C_CB + c8), bg); unpack8(*(const u32x4*)(yr + C_CZ + c8), z);
#pragma unroll
                for (int i = 0; i < 8; ++i) o[i] = bg[i] * (cw[c8 + i] * a0[i] + cw[BRW + c8 + i] * a1[i] + cw[2 * BRW + c8 + i] * a2[i]) * z[i];
                convw = pack8(o);
            }
            {
                const int g = c8 >> 8, w = 2 << g;
                int lo = t - (w >> 1); if (lo < 0) lo = 0; int hi = t + w - (w >> 1); if (hi > T) hi = T;
                float s[8], u0[8];
#pragma unroll
                for (int i = 0; i < 8; ++i) s[i] = 0.f;
                u32x4 tap[16];
#pragma unroll
                for (int k = 0; k < 16; ++k) { const int q = t - (w >> 1) + k; const bool ok = (k < w) && (q >= 0) && (q < T);
                    tap[k] = ok ? *(const u32x4*)(yr + (long)(q - t) * NPAD + C_PU + c8) : (u32x4){0u, 0u, 0u, 0u}; }
#pragma unroll
                for (int k = 0; k < 16; ++k) { float u[8]; unpack8(tap[k], u);
#pragma unroll
                    for (int i = 0; i < 8; ++i) s[i] += u[i]; }
                unpack8(*(const u32x4*)(yr + C_PU + c8), u0);
                const float inv = 1.0f / (float)(hi - lo);
                float o[8];
#pragma unroll
                for (int i = 0; i < 8; ++i) o[i] = s[i] * inv - u0[i];
                *(u32x4*)(DMB + (size_t)row * BRW + c8) = pack8(o);
                *(u32x4*)(Y + (size_t)row * NPAD + C_CZ + c8) = convw;
            }
        }
    }
}

__device__ __forceinline__ f32x4 mfma16(bf16x8 a, bf16x8 b, f32x4 c) { return __builtin_amdgcn_mfma_f32_16x16x32_bf16(a, b, c, 0, 0, 0); }
__device__ void mlstm_item(const Params& p, int item, unsigned char* smem) {
    const int tid = otid(), wid = tid >> 6, lane = tid & 63, fr = lane & 15, kq = lane >> 4;
    const int ep = item & 3, dir = (item >> 2) & 1, hd = (item >> 3) & 3, b = item >> 5;
    const int sq = (b * 4 + hd) * 2 + dir;
    const bf16_t* Y = (const bf16_t*)(p.ws + WS_Y);
    float* HM = (float*)(p.ws + WS_HM) + (size_t)dir * MROWS * BRW;
    const f32x4* GT4 = (const f32x4*)(p.ws + WS_GT4) + (size_t)sq * RPB; const float* GW = (const float*)(p.ws + WS_GW) + (size_t)sq * RPB; const float* GD = (const float*)(p.ws + WS_GD) + sq * 128;
    bf16_t* Ks = (bf16_t*)(smem); bf16_t* KTs = (bf16_t*)(smem + 33792);
    bf16_t* VTs = (bf16_t*)(smem + 70656); bf16_t* VWTs = (bf16_t*)(smem + 82176); bf16_t* CTs = (bf16_t*)(smem + 93696); bf16_t* Ss = (bf16_t*)(smem + 135936);
    float* sA = (float*)(smem + 145152); float* sM = sA + 64; float* sI = sA + 128; float* sE = sA + 192;
    for (int i = tid; i < 80 * 72; i += 512) { VTs[i] = 0; VWTs[i] = 0; }
    for (int i = tid; i < 80 * 264; i += 512) CTs[i] = 0;
    __syncthreads();
    if (tid < 64) VTs[64 * 72 + tid] = 0x3F80;
    f32x4 Cacc[2][5];
#pragma unroll
    for (int a = 0; a < 2; ++a)
#pragma unroll
        for (int c = 0; c < 5; ++c) Cacc[a][c] = (f32x4){0.f, 0.f, 0.f, 0.f};
    const int rg = wid >> 1, ch = wid & 1;
    u32x4 kreg[4], vreg; f32x4 g4; float wv_ = 0.f, wtok = 0.f, decay = 0.f;
    bf16x8 qf[8];
    const int dkp = tid & 127, sg = tid >> 7;
    const int vs = tid & 63, ve8 = (tid >> 6) * 8;
#define ML_LOAD(ci) do { \
        _Pragma("unroll") for (int j = 0; j < 4; ++j) { const int idx = tid + 512 * j, rr = idx >> 5, c8 = (idx & 31) * 8; \
            kreg[j] = *(const u32x4*)(Y + (size_t)seq_row(b, dir, (ci) * 64 + rr) * NPAD + C_MK + hd * 256 + c8); } \
        vreg = *(const u32x4*)(Y + (size_t)seq_row(b, dir, (ci) * 64 + vs) * NPAD + C_MV + hd * 256 + ep * 64 + ve8); wv_ = GW[(ci) * 64 + vs]; \
        g4 = GT4[(ci) * 64 + (tid & 63)]; wtok = GW[(ci) * 64 + (tid & 63)]; \
        decay = GD[(ci)]; } while (0)
#define ML_QLOAD(ci) do { const bf16_t* qrow = Y + (size_t)seq_row(b, dir, (ci) * 64 + 16 * rg + fr) * NPAD + C_MQ + hd * 256 + 8 * kq; \
        _Pragma("unroll") for (int ks = 0; ks < 8; ++ks) qf[ks] = *(const bf16x8*)(qrow + 32 * ks); } while (0)
    ML_LOAD(0); ML_QLOAD(0);
    for (int ci = 0; ci < NCHUNK; ++ci) {
#pragma unroll
        for (int j = 0; j < 4; ++j) { const int idx = tid + 512 * j, rr = idx >> 5, c8 = (idx & 31) * 8; *(u32x4*)(Ks + rr * 264 + c8) = kreg[j]; }
        { float vf[8]; unpack8(vreg, vf); const float ws_ = wv_ * 0.0625f;
#pragma unroll
            for (int i = 0; i < 8; ++i) { VTs[(ve8 + i) * 72 + vs] = f2bf(vf[i]); VWTs[(ve8 + i) * 72 + vs] = f2bf(vf[i] * ws_); } }
        if (tid < 64) { sA[tid] = g4[0]; sM[tid] = g4[1]; sI[tid] = g4[2]; sE[tid] = g4[3]; VWTs[64 * 72 + tid] = f2bf(wtok * 0.0625f); }
        const float dec = decay;
        __syncthreads();
        const int cn = ci + 1 < NCHUNK ? ci + 1 : NCHUNK - 1;
        ML_LOAD(cn);
        {
            const int t = 16 * rg + fr; const float Mt = sM[t];
#pragma unroll
            for (int s2 = 0; s2 < 2; ++s2) { const int st = 2 * ch + s2; f32x4 acc = {0.f, 0.f, 0.f, 0.f};
#pragma unroll
                for (int ks = 0; ks < 8; ++ks) { const bf16x8 kf = *(const bf16x8*)(Ks + (16 * st + fr) * 264 + 32 * ks + 8 * kq); acc = mfma16(kf, qf[ks], acc); }
                float o[4];
#pragma unroll
                for (int i = 0; i < 4; ++i) { const int s = 16 * st + 4 * kq + i; o[i] = (s <= t) ? acc[i] * fexp(sA[s] - Mt) * 0.0625f : 0.f; }
                u32x2 w; w.x = cvt_pk_bf16(o[0], o[1]); w.y = cvt_pk_bf16(o[2], o[3]);
                *(u32x2*)(Ss + t * 72 + 16 * st + 4 * kq) = w; }
        }
#pragma unroll
        for (int j = 0; j < 2; ++j) { const int s0 = 8 * (sg + 4 * j); unsigned kt[8]; u32x4 lo, hi;
#pragma unroll
            for (int jj = 0; jj < 8; ++jj) kt[jj] = *(const unsigned*)(Ks + (s0 + jj) * 264 + 2 * dkp);
            lo.x = (kt[0] & 0xffffu) | (kt[1] << 16); lo.y = (kt[2] & 0xffffu) | (kt[3] << 16); lo.z = (kt[4] & 0xffffu) | (kt[5] << 16); lo.w = (kt[6] & 0xffffu) | (kt[7] << 16);
            hi.x = (kt[0] >> 16) | (kt[1] & 0xffff0000u); hi.y = (kt[2] >> 16) | (kt[3] & 0xffff0000u); hi.z = (kt[4] >> 16) | (kt[5] & 0xffff0000u); hi.w = (kt[6] >> 16) | (kt[7] & 0xffff0000u);
            *(u32x4*)(KTs + (2 * dkp) * 72 + s0) = lo; *(u32x4*)(KTs + (2 * dkp + 1) * 72 + s0) = hi; }
        __syncthreads();
        {
            f32x4 aN0 = {0.f, 0.f, 0.f, 0.f}, aN1 = aN0, aD = aN0;
#pragma unroll
            for (int ks = 0; ks < 8; ++ks) { const bf16x8 c0 = *(const bf16x8*)(CTs + (32 * ch + fr) * 264 + 32 * ks + 8 * kq), c1 = *(const bf16x8*)(CTs + (32 * ch + 16 + fr) * 264 + 32 * ks + 8 * kq),
                                                     c2 = *(const bf16x8*)(CTs + (64 + fr) * 264 + 32 * ks + 8 * kq);
                aN0 = mfma16(qf[ks], c0, aN0); aN1 = mfma16(qf[ks], c1, aN1); aD = mfma16(qf[ks], c2, aD); }
            ML_QLOAD(cn);
            float it4[4], en4[4];
#pragma unroll
            for (int i = 0; i < 4; ++i) { it4[i] = sI[16 * rg + 4 * kq + i]; en4[i] = sE[16 * rg + 4 * kq + i]; aN0[i] *= it4[i]; aN1[i] *= it4[i]; aD[i] *= it4[i]; }
#pragma unroll
            for (int ks = 0; ks < 2; ++ks) { const bf16x8 sf = *(const bf16x8*)(Ss + (16 * rg + fr) * 72 + 32 * ks + 8 * kq);
                const bf16x8 v0 = *(const bf16x8*)(VTs + (32 * ch + fr) * 72 + 32 * ks + 8 * kq), v1 = *(const bf16x8*)(VTs + (32 * ch + 16 + fr) * 72 + 32 * ks + 8 * kq), v2 = *(const bf16x8*)(VTs + (64 + fr) * 72 + 32 * ks + 8 * kq);
                aN0 = mfma16(sf, v0, aN0); aN1 = mfma16(sf, v1, aN1); aD = mfma16(sf, v2, aD); }
#pragma unroll
            for (int i = 0; i < 4; ++i) { const float den = __shfl(aD[i], lane & 48); const float rd = 1.0f / fmaxf(fabsf(den), en4[i]);
                const int row = seq_row(b, dir, ci * 64 + 16 * rg + 4 * kq + i);
                float* hp = HM + (size_t)row * BRW + hd * 256 + ep * 64 + 32 * ch + fr;
                hp[0] = aN0[i] * rd; hp[16] = aN1[i] * rd; }
        }
#pragma unroll
        for (int rt = 0; rt < 2; ++rt)
#pragma unroll
            for (int ct = 0; ct < 5; ++ct) { f32x4 cacc = Cacc[rt][ct] * dec;
#pragma unroll
                for (int ks = 0; ks < 2; ++ks) { const bf16x8 af = *(const bf16x8*)(KTs + (32 * wid + 16 * rt + fr) * 72 + 32 * ks + 8 * kq), bv = *(const bf16x8*)(VWTs + (16 * ct + fr) * 72 + 32 * ks + 8 * kq);
                    cacc = mfma16(af, bv, cacc); }
                Cacc[rt][ct] = cacc; }
        __syncthreads();
#pragma unroll
        for (int rt = 0; rt < 2; ++rt)
#pragma unroll
            for (int ct = 0; ct < 5; ++ct) { u32x2 w; w.x = cvt_pk_bf16(Cacc[rt][ct][0], Cacc[rt][ct][1]); w.y = cvt_pk_bf16(Cacc[rt][ct][2], Cacc[rt][ct][3]);
                *(u32x2*)(CTs + (16 * ct + fr) * 264 + 32 * wid + 16 * rt + 4 * kq) = w; }
    }
#undef ML_LOAD
#undef ML_QLOAD
    __syncthreads();
}

__device__ void phase_mix2(const Params& p, int l, unsigned char* smem) {
    bf16_t* Y = (bf16_t*)(p.ws + WS_Y);
#ifndef NO_MLSTM
    if ((int)blockIdx.x < 128) mlstm_item(p, blockIdx.x, smem);
#endif
#ifndef NO_ATT
    const int natt = 512 + (l == 0 ? 32 : 0);
    unsigned* ctr = (unsigned*)(p.ws + WS_BAR + 14336) + l * 64;
    volatile unsigned* sidx = (volatile unsigned*)(smem + LDS_BYTES - 32);
    for (;;) {
        __syncthreads();
        if (threadIdx.x == 0) *sidx = atomicAdd(ctr, 1u);
        __syncthreads();
        const int it = __builtin_amdgcn_readfirstlane((int)*sidx);
        if (it >= natt) break;
        int b, head, qrow, krow, seq;
        if (it < 512) { const int qb = it & 15; head = (it >> 4) & 7; b = it >> 7; qrow = b * RPB + qb * 256; krow = b * RPB; seq = RPB; }
        else { const int i2 = it - 512; head = i2 & 7; b = i2 >> 3; qrow = b * RPB + TL; krow = qrow; seq = LC; }
        const int kvh = head >> 2;
        bf16_t* rowq = Y + (size_t)qrow * NPAD; const bf16_t* rowk = Y + (size_t)krow * NPAD;
        att::attn_dense_body(rowq + C_AQ + head * 128, rowk + C_AK + kvh * 128, rowk + C_AV + kvh * 128, rowq + C_AZ + head * 128, seq, (char*)smem);
    }
#endif
    __syncthreads();
#ifndef NO_POOLG
    { SchedPool S; S.A = (const char*)(p.ws + WS_H); S.Bt = (const char*)(p.ws + WS_POOLW) + (size_t)l * 4 * 256 * 256 * 2; S.G = gridDim.x; S.c = blockIdx.x; S.i0 = 0;
      EpiPool E; E.Y = Y;
      pg8::Gemm g; g.lda = BRW; g.ldb = 256; { int kk = 256; asm volatile("" : "+s"(kk)); g.K = kk; }
      pg8::gemm_phase(( LAS unsigned char*)smem, g, S, E); }
#endif
    __syncthreads();
}

__device__ void phase_mix3(const Params& p, int l) {
    const int tid = otid(), lane = tid & 63, wv = obid() * 8 + (tid >> 6), nwv = gridDim.x * 8;
    bf16_t* Y = (bf16_t*)(p.ws + WS_Y);
    const float* HM0 = (const float*)(p.ws + WS_HM); const float* HM1 = HM0 + (size_t)MROWS * BRW;
    const float* gain = p.m_gain + l * BRW;
    for (int row = wv; row < MROWS; row += nwv) {
        f32x4 v[4]; u32x2 ow[4], zw[4];
#pragma unroll
        for (int hd = 0; hd < 4; ++hd) { const size_t off = (size_t)row * BRW + hd * 256 + 4 * lane;
            v[hd] = *(const f32x4*)(HM0 + off) + *(const f32x4*)(HM1 + off);
            ow[hd] = *(const u32x2*)(Y + (size_t)row * NPAD + C_MO + hd * 256 + 4 * lane); zw[hd] = *(const u32x2*)(Y + (size_t)row * NPAD + C_MZ + hd * 256 + 4 * lane); }
#pragma unroll
        for (int hd = 0; hd < 4; ++hd) {
            float ss = v[hd][0] * v[hd][0] + v[hd][1] * v[hd][1] + v[hd][2] * v[hd][2] + v[hd][3] * v[hd][3];
#pragma unroll
            for (int o = 32; o >= 1; o >>= 1) ss += __shfl_xor(ss, o);
            const float rstd = rsqrtf(ss * (1.0f / 256.0f) + EPS);
            const f32x4 g = *(const f32x4*)(gain + hd * 256 + 4 * lane);
            const float o0 = bflo(ow[hd].x), o1 = bfhi(ow[hd].x), o2 = bflo(ow[hd].y), o3 = bfhi(ow[hd].y), z0 = bflo(zw[hd].x), z1 = bfhi(zw[hd].x), z2 = bflo(zw[hd].y), z3 = bfhi(zw[hd].y);
            u32x2 w; w.x = cvt_pk_bf16(v[hd][0] * rstd * g[0] * o0 * z0, v[hd][1] * rstd * g[1] * o1 * z1); w.y = cvt_pk_bf16(v[hd][2] * rstd * g[2] * o2 * z2, v[hd][3] * rstd * g[3] * o3 * z3);
            *(u32x2*)(Y + (size_t)row * NPAD + C_MO + hd * 256 + 4 * lane) = w;
        }
    }
}

#define XB_TMO      128
#define XB_XCNT(j)  (256  + 64 * (j))
#define XB_XSUB(j)  (1280 + 64 * (j))
#define XB_XGEN(j)  (2304 + 64 * (j))
#define XB_TOP      3328
#define XB_TOPGEN   3392
#define XCD_BAR_WORDS 3456
#define XB_SPIN_CAP (1u << 18)
__device__ __forceinline__ unsigned xb_ld(unsigned* p)              { return __hip_atomic_load(p, __ATOMIC_RELAXED, __HIP_MEMORY_SCOPE_AGENT); }
__device__ __forceinline__ unsigned xb_add(unsigned* p, unsigned v) { return __hip_atomic_fetch_add(p, v, __ATOMIC_RELAXED, __HIP_MEMORY_SCOPE_AGENT); }
__device__ __forceinline__ unsigned xb_xcc_id() { return (unsigned)__builtin_amdgcn_s_getreg((3 << 11) | 20) & 0xFu; }
#define XB_SPIN(cond, bar) do { unsigned _sp = 0; while (cond) { __builtin_amdgcn_s_sleep(1); \
    if ((++_sp & 255u) == 0u) { if (xb_ld(&(bar)[XB_TMO])) break; if (_sp > XB_SPIN_CAP) { atomicAdd(&(bar)[XB_TMO], 1u); break; } } } } while (0)
struct XcdBarrier { unsigned* bar; unsigned x; volatile LAS unsigned* st; };
__device__ __forceinline__ XcdBarrier xcd_barrier_post(unsigned* bar, volatile LAS unsigned* st) {
    XcdBarrier b; b.bar = bar; b.x = xb_xcc_id(); b.st = st;
    if (threadIdx.x == 0) (void)xb_add(&bar[XB_XCNT(b.x)], 1u);
    return b;
}
__device__ __forceinline__ void xcd_barrier_complete(unsigned* bar, unsigned x, unsigned& nloc, unsigned& nx) {
    const unsigned G = gridDim.x * gridDim.y * gridDim.z;
    unsigned sum, cnt, mine, sp = 0u;
    for (;;) {
        sum = 0u; cnt = 0u; mine = 0u;
#pragma unroll
        for (unsigned j = 0; j < 16; ++j) { const unsigned c = xb_ld(&bar[XB_XCNT(j)]); sum += c; cnt += (c > 0u) ? 1u : 0u; mine = (j == x) ? c : mine; }
        if (sum == G) break;
        __builtin_amdgcn_s_sleep(1);
        if ((++sp & 255u) == 0u) { if (xb_ld(&bar[XB_TMO])) break; if (sp > XB_SPIN_CAP) { atomicAdd(&bar[XB_TMO], 1u); break; } }
    }
    nloc = mine > 0u ? mine : 1u; nx = cnt > 0u ? cnt : 1u;
}
__device__ __forceinline__ void xcd_barrier(const XcdBarrier& b) {
    asm volatile("s_waitcnt vmcnt(0)" ::: "memory");
    __syncthreads();
    if (threadIdx.x == 0) {
        unsigned* bar = b.bar;
        __builtin_amdgcn_s_waitcnt(0);
        unsigned nloc = b.st[0], nx = b.st[1];
        if (nloc == 0u) { xcd_barrier_complete(bar, b.x, nloc, nx); b.st[0] = nloc; b.st[1] = nx; }
        const unsigned old = xb_add(&bar[XB_XSUB(b.x)], 1u);
        const unsigned gen = old / nloc;
        if (old + 1u == (gen + 1u) * nloc) {
            __builtin_amdgcn_fence(__ATOMIC_RELEASE, "agent");
            asm volatile("s_waitcnt vmcnt(0)" ::: "memory");
            const unsigned og = xb_add(&bar[XB_TOP], 1u);
            const unsigned tg = og / nx;
            if (og + 1u == (tg + 1u) * nx) xb_add(&bar[XB_TOPGEN], 1u);
            else XB_SPIN(xb_ld(&bar[XB_TOPGEN]) == tg, bar);
            __builtin_amdgcn_fence(__ATOMIC_ACQUIRE, "agent");
            xb_add(&bar[XB_XGEN(b.x)], 1u);
            asm volatile("s_waitcnt vmcnt(0)" ::: "memory");
        } else {
            XB_SPIN(xb_ld(&bar[XB_XGEN(b.x)]) == gen, bar);
            __builtin_amdgcn_fence(__ATOMIC_ACQUIRE, "agent");
            asm volatile("s_waitcnt vmcnt(0)" ::: "memory");
        }
    }
    __syncthreads();
}

constexpr int NPHASE = 16;
__device__ void run_phase(const Params& p, int ph, unsigned char* smem, bool dost = true) {
#ifndef NO_PREP
    if (ph == 0) { phase_prep(p, smem); return; }
#endif
#ifndef NO_FINAL
    if (ph == NPHASE - 1) { phase_final(p); return; }
#endif
    const int l = (ph - 1) / 7, s = (ph - 1) % 7;
    bf16_t* Y = (bf16_t*)(p.ws + WS_Y);
    switch (s) {
#ifndef NO_NORM
    case 0: phase_norm(p, l); break;
#endif
#ifndef NO_GIN
    case 1: { SchedIn S; S.A = (const char*)(p.ws + WS_H); S.Bt = (const char*)(p.ws + WS_WIN) + (size_t)l * NPAD * DM * 2; S.G = gridDim.x; S.c = blockIdx.x; S.trim = (l == 1);
              EpiIn E; E.Y = Y; E.G32 = (float*)(p.ws + WS_G32); E.dost = dost;
              pg8::Gemm g; g.lda = DM; g.ldb = DM; g.K = DM;
              pg8::gemm_phase((LAS unsigned char*)smem, g, S, E); } break;
#endif
#ifndef NO_MIX1
    case 2: phase_mix1(p, l, smem); break;
#endif
#ifndef NO_MIX2
    case 3: phase_mix2(p, l, smem); break;
#endif
#ifndef NO_MIX3
    case 4: phase_mix3(p, l); break;
#endif
#ifndef NO_MERGE
    case 5: { SchedMerge S; S.Y = (const char*)Y; S.Wbr = (const char*)(p.ws + WS_WBR) + (size_t)l * 4 * DM * BRW * 2; S.G = gridDim.x; S.c = blockIdx.x; S.nM = l == 0 ? 68 : 64;
              EpiMerge E; E.Y = Y; E.accb = (bf16_t*)(p.ws + WS_H);
              pg8::Gemm g; g.lda = NPAD; g.ldb = BRW; g.K = BRW;
              pg8::gemm_phase((LAS unsigned char*)smem, g, S, E);
              if (l == 0 && (int)blockIdx.x >= 32) { __syncthreads(); for (int u = blockIdx.x - 32; u < U_CONV1; u += gridDim.x - 32) conv_unit(p, 1, u, smem); } } break;
#endif
#ifndef NO_OUT
    case 6: { SchedOut S; S.A = (const char*)(p.ws + WS_H); S.Bt = (const char*)(p.ws + WS_WOUT) + (size_t)l * DM * DM * 2; S.G = gridDim.x; S.c = blockIdx.x; S.nM = l == 0 ? 68 : 64;
              EpiOut E; E.xin = p.x; E.ctxin = p.ctx; E.mod = (const float*)(p.ws + WS_MOD) + (size_t)l * 5 * 6144; E.X1 = (bf16_t*)(p.ws + WS_X1); E.first = (l == 0);
              pg8::Gemm g; g.lda = DM; g.ldb = DM; g.K = DM;
              pg8::gemm_phase((LAS unsigned char*)smem, g, S, E); } break;
#endif
    }
}

__global__ void __launch_bounds__(512, 2) hybrid_fwd(Params p) {
    extern __shared__ __attribute__((aligned(16))) unsigned char smem[];
    volatile LAS unsigned* st = (volatile LAS unsigned*)((LAS unsigned char*)smem + (LDS_BYTES - 16));
    if (threadIdx.x == 0) { st[0] = 0u; st[1] = 0u; }
    __syncthreads();
    const XcdBarrier xbar = xcd_barrier_post((unsigned*)(p.ws + WS_BAR), st);
    for (int ph = p.ph_lo; ph < p.ph_hi; ++ph) {
        int reps = 1;
#ifdef PROBE_REP_MASK
        if (ph > 0 && ph < NPHASE - 1 && ((PROBE_REP_MASK >> ((ph - 1) % 7)) & 1)) reps = 2;
        if (ph == 0 && (PROBE_REP_MASK & 128)) reps = 2;
#endif
        for (int r = 0; r < reps; ++r) { run_phase(p, ph, smem, r + 1 == reps || p.ph_hi > 1000); if (r + 1 < reps) xcd_barrier(xbar); }
        if (ph + 1 < p.ph_hi) { if (p.ph_hi > NPHASE) cg::this_grid().sync(); else xcd_barrier(xbar); }
#ifdef PROBE_EXTRA_SYNC
        if (ph + 1 < p.ph_hi) { for (int q = 0; q < PROBE_EXTRA_SYNC; ++q) cg::this_grid().sync(); }
#endif
    }
}


#ifdef DBG_STOP
__global__ void dbg_dump(Params p) {
    const bf16_t* Y = (const bf16_t*)(p.ws + WS_Y); const float* HM = (const float*)(p.ws + WS_HM); const bf16_t* H = (const bf16_t*)(p.ws + WS_H);
    for (size_t i = (size_t)blockIdx.x * blockDim.x + threadIdx.x; i < (size_t)NB * TL * DM; i += (size_t)gridDim.x * blockDim.x) {
        const size_t row = i / DM; const int c = (int)(i % DM);
        float s = 0.f;
#if DBG_WHAT & 1
        for (int j = 0; j < 11; ++j) { const int col = c + 2048 * j; if (col < 22016) s += bf2f(Y[row * NPAD + col]); }
#endif
#if DBG_WHAT & 2
        { const size_t k = i % ((size_t)MROWS * BRW); s += HM[k] + HM[k + (size_t)MROWS * BRW]; }
#endif
#if DBG_WHAT & 4
        s += bf2f(H[i]);
#endif
        p.out[i] = s;
    }
}
#endif
extern "C" void kernel_launch(void* const* d_in, const int* in_sizes, int n_in, void* d_out, int out_size, void* d_ws, size_t ws_size, hipStream_t stream) {
    static int grid = 0;
    if (grid == 0) {
        if (n_in != 18 || ws_size < WS_END) { fprintf(stderr, "kernel_launch: n_in %d ws %zu (need %zu)\n", n_in, ws_size, (size_t)WS_END); grid = -1; return; }
        if (hipFuncSetAttribute((const void*)hybrid_fwd, hipFuncAttributeMaxDynamicSharedMemorySize, LDS_BYTES) != hipSuccess) { fprintf(stderr, "kernel_launch: hipFuncSetAttribute failed\n"); grid = -1; return; }
        int dev = 0, cus = 0, per_cu = 0;
        hipGetDevice(&dev); hipDeviceGetAttribute(&cus, hipDeviceAttributeMultiprocessorCount, dev);
        hipOccupancyMaxActiveBlocksPerMultiprocessor(&per_cu, (const void*)hybrid_fwd, 512, LDS_BYTES);
        if (per_cu < 1) { fprintf(stderr, "kernel_launch: occupancy query says %d blocks per CU\n", per_cu); per_cu = 1; }
        (void)hipGetLastError();
        grid = cus;
    }
    if (grid < 0) return;
    Params p{};
    p.x = (const float*)d_in[0]; p.c = (const float*)d_in[1]; p.ctx = (const float*)d_in[2]; p.c_ctx = (const float*)d_in[3]; p.norm_gain = (const float*)d_in[4];
    p.w_mod = (const float*)d_in[5]; p.b_mod = (const float*)d_in[6]; p.w_in = (const float*)d_in[7]; p.q_gain = (const float*)d_in[8]; p.k_gain = (const float*)d_in[9];
    p.gate_bias = (const float*)d_in[10]; p.m_gain = (const float*)d_in[11]; p.conv_w = (const float*)d_in[12]; p.pool_w = (const float*)d_in[13]; p.pool_scale = (const float*)d_in[14];
    p.w_branch = (const float*)d_in[15]; p.w_out = (const float*)d_in[16]; p.final_gain = (const float*)d_in[17];
    p.out = (float*)d_out; p.ws = (unsigned char*)d_ws;
#ifdef DBG_STOP
    for (int ph = 0; ph < DBG_STOP; ++ph) { p.ph_lo = ph; p.ph_hi = ph + 1; hipLaunchKernelGGL(hybrid_fwd, dim3(grid), dim3(512), LDS_BYTES, stream, p); }
    hipLaunchKernelGGL(dbg_dump, dim3(2048), dim3(256), 0, stream, p);
#elif MK_PER_PHASE
    for (int ph = 0; ph < NPHASE; ++ph) {
        p.ph_lo = ph; p.ph_hi = ph + 1;
        hipLaunchKernelGGL(hybrid_fwd, dim3(grid), dim3(512), LDS_BYTES, stream, p);
    }
#else
    p.ph_lo = 0; p.ph_hi = NPHASE;
    if (hipMemsetAsync((char*)d_ws + WS_BAR, 0, 16384, stream) != hipSuccess) { fprintf(stderr, "kernel_launch: memset of barrier words failed\n"); return; }
    void* args[] = {&p};
    hipError_t e = hipLaunchCooperativeKernel((const void*)hybrid_fwd, dim3(grid), dim3(512), args, LDS_BYTES, stream);
    if (e != hipSuccess) fprintf(stderr, "cooperative launch failed: %s (grid %d)\n", hipGetErrorString(e), grid);
#endif
}
```

```cpp
#include <hip/hip_runtime.h>
#include <hip/hip_cooperative_groups.h>
#include <cstdio>
#include <cstdint>
namespace cg = cooperative_groups;

#ifndef MK_PER_PHASE
#define MK_PER_PHASE 0
#endif

#define LAS __attribute__((address_space(3)))
typedef unsigned short bf16_t;
typedef short bf16x8 __attribute__((ext_vector_type(8)));
typedef short s16x4 __attribute__((ext_vector_type(4)));
typedef float f32x4 __attribute__((ext_vector_type(4)));
typedef float f32x8 __attribute__((ext_vector_type(8)));
typedef float f32x16 __attribute__((ext_vector_type(16)));
typedef unsigned u32x4 __attribute__((ext_vector_type(4)));
typedef unsigned u32x2 __attribute__((ext_vector_type(2)));

constexpr int DM = 2048, NB = 4, TL = 4096, LC = 256, RPB = TL + LC  , MROWS = NB * RPB  ;
constexpr int NIN = 22032, NPAD = 22272, BRW = 1024;
constexpr int C_AQ = 0, C_AK = 1024, C_AV = 1280, C_AZ = 1536, C_MQ = 2560, C_MK = 3584, C_MV = 4608, C_MO = 5632, C_MZ = 6656,
              C_CU = 7680, C_CB = 8704, C_CC = 9728, C_CZ = 10752, C_PU = 11776, C_PZ = 12800, C_GM = 13824, C_MG = 22016;
constexpr int NCHUNK = RPB / 64;
constexpr float EPS = 1e-6f;

constexpr size_t WS_WIN = 0;
constexpr size_t WS_WBR = WS_WIN + (size_t)2 * NPAD * DM * 2;
constexpr size_t WS_WOUT = WS_WBR + (size_t)2 * 4 * DM * BRW * 2;
constexpr size_t WS_POOLW = WS_WOUT + (size_t)2 * DM * DM * 2;
constexpr size_t WS_MOD = WS_POOLW + (size_t)2 * 4 * 256 * 256 * 2;
constexpr size_t WS_H = WS_MOD + (size_t)2 * 5 * 6144 * 4;
constexpr size_t WS_Y = WS_H + (size_t)MROWS * DM * 2;
constexpr size_t WS_X1 = WS_Y + (size_t)MROWS * NPAD * 2;
constexpr size_t WS_HM = WS_X1 + (size_t)MROWS * DM * 4;
constexpr size_t WS_G32 = WS_HM + (size_t)2 * MROWS * BRW * 4;
constexpr size_t WS_GT4 = WS_G32 + (size_t)MROWS * 16 * 4;
constexpr size_t WS_GW = WS_GT4 + (size_t)32 * RPB * 16;
constexpr size_t WS_GD = WS_GW + (size_t)32 * RPB * 4;
constexpr size_t WS_BAR = WS_GD + (size_t)32 * 128 * 4;
constexpr size_t WS_END = WS_BAR + 16384;

constexpr int LDS_BYTES = 155648;

struct Params {
    const float* x; const float* c; const float* ctx; const float* c_ctx; const float* norm_gain; const float* w_mod; const float* b_mod; const float* w_in;
    const float* q_gain; const float* k_gain; const float* gate_bias; const float* m_gain; const float* conv_w; const float* pool_w; const float* pool_scale;
    const float* w_branch; const float* w_out; const float* final_gain;
    float* out; unsigned char* ws;
    int ph_lo, ph_hi;
};

__device__ __forceinline__ int otid() { int t = threadIdx.x; asm volatile("" : "+v"(t)); return t; }
__device__ __forceinline__ int obid() { int t = blockIdx.x; asm volatile("" : "+s"(t)); return t; }
typedef __bf16 bf16x2_t __attribute__((ext_vector_type(2)));
typedef float f32x2_t __attribute__((ext_vector_type(2)));
__device__ __forceinline__ unsigned cvt_pk_bf16(float lo, float hi) { f32x2_t v = {lo, hi}; bf16x2_t r = __builtin_convertvector(v, bf16x2_t); return *reinterpret_cast<unsigned*>(&r); }
__device__ __forceinline__ bf16_t f2bf(float f) { return (bf16_t)(cvt_pk_bf16(f, 0.f) & 0xffffu); }
__device__ __forceinline__ float bf2f(bf16_t b) { return __uint_as_float(((unsigned)b) << 16); }
__device__ __forceinline__ float bflo(unsigned w) { return __uint_as_float(w << 16); }
__device__ __forceinline__ float bfhi(unsigned w) { return __uint_as_float(w & 0xffff0000u); }
__device__ __forceinline__ float sigmoidf_(float x) { return __builtin_amdgcn_rcpf(1.0f + __builtin_amdgcn_exp2f(-1.4426950408889634f * x)); }
__device__ __forceinline__ float siluf_(float x) { return x * sigmoidf_(x); }
__device__ __forceinline__ float fexp(float x) { return __builtin_amdgcn_exp2f(1.4426950408889634f * x); }
__device__ __forceinline__ void unpack8(const u32x4 w, float (&f)[8]) { f[0] = bflo(w.x); f[1] = bfhi(w.x); f[2] = bflo(w.y); f[3] = bfhi(w.y); f[4] = bflo(w.z); f[5] = bfhi(w.z); f[6] = bflo(w.w); f[7] = bfhi(w.w); }
__device__ __forceinline__ u32x4 pack8(const float (&f)[8]) { u32x4 w; w.x = cvt_pk_bf16(f[0], f[1]); w.y = cvt_pk_bf16(f[2], f[3]); w.z = cvt_pk_bf16(f[4], f[5]); w.w = cvt_pk_bf16(f[6], f[7]); return w; }

namespace pg8 {
constexpr int BM = 256, BK = 64, HALF = 128, HTB = HALF * BK * 2, STAGE_BYTES = 8 * HTB, NXCD = 8, WGM = 8;
__host__ __device__ __forceinline__ int lds_byte(int r, int c) { const int st = (r >> 4) * 2 + (c >> 5), rr = r & 15, cc = c & 31, ob = rr * 64 + cc * 2; return st * 1024 + (ob ^ (((ob >> 9) & 1) << 5)); }
__host__ __device__ __forceinline__ void stage_rc(int b, int& R, int& C) { const int st = b / 1024, sb = b % 1024, swz = sb ^ (((sb >> 9) & 1) << 5); R = (st >> 1) * 16 + swz / 64; C = (st & 1) * 32 + (swz % 64) / 2; }
__host__ __device__ __forceinline__ int perm32(int rho) { const int n = rho >> 4, i = rho & 15; return 8 * (i >> 2) + 4 * n + (i & 3); }

struct Unit { const char* a; const char* b; int pm, pn, tag; };
struct Gemm { int lda, ldb, K; };

__device__ __forceinline__ bool static_tile(int nM, int nN, long L, int& pm, int& pn) {
    const int nwg = nM * nN; if (L >= nwg) return false;
    int wgid = (int)L; { const int q = nwg / NXCD, r = nwg % NXCD, xcd = wgid % NXCD, off = wgid / NXCD; wgid = (xcd < r ? xcd * (q + 1) : r * (q + 1) + (xcd - r) * q) + off; }
    const int nig = WGM * nN, gid = wgid / nig, fm = gid * WGM, gsz = (nM - fm) < WGM ? (nM - fm) : WGM;
    pm = fm + ((wgid % nig) % gsz); pn = (wgid % nig) / gsz; return true;
}

template <class Epi, class Sched>
__device__ __forceinline__ void gemm_phase(LAS unsigned char* lds, const Gemm g, const Sched& S, const Epi& E) {
    const int tid = otid(), wid = __builtin_amdgcn_readfirstlane(tid >> 6), lane = tid & 63, wr = wid >> 2, wc = wid & 3, fr = lane & 15, fq = lane >> 4;
    const int K = g.K, nt = K / BK;
    unsigned voffA[2], voffB[2];
#pragma unroll
    for (int i = 0; i < 2; ++i) { int R, C; stage_rc(tid * 16 + i * 8192, R, C); const int Rb = Epi::PERM ? ((R & ~31) + perm32(R & 31)) : R;
        voffA[i] = (unsigned)(R * g.lda + C) * 2u; voffB[i] = (unsigned)(Rb * g.ldb + C) * 2u; }
    const size_t kstep = (size_t)(BK * 2);
    const size_t hstepA = (size_t)HALF * g.lda * 2, hstepB = (size_t)HALF * g.ldb * 2;
    const unsigned ldsw = (unsigned)wid * 1024u;
    const int aoff = lds_byte(wr * 64 + fr, fq * 8), boff = lds_byte(wc * 32 + fr, fq * 8);
#define PG8_SA(b, h) (((b) * 2 + (h)) * HTB)
#define PG8_SB(b, h) ((4 + (b) * 2 + (h)) * HTB)
#define PG8_STAGE(bufoff, gbase, voff) do { _Pragma("unroll") for (int _i = 0; _i < 2; ++_i) \
        __builtin_amdgcn_global_load_lds((const unsigned*)((const char*)(gbase) + (voff)[_i]), (LAS unsigned*)(lds + (bufoff) + ldsw + _i * 8192), 16, 0, 0); } while (0)
#define PG8_LDA(dst, b, h) do { _Pragma("unroll") for (int m = 0; m < 4; ++m) _Pragma("unroll") for (int k = 0; k < 2; ++k) dst[m][k] = *(const LAS bf16x8*)(lds + PG8_SA(b, h) + aoff + m * 2048 + k * 1024); } while (0)
#define PG8_LDB(dst, b, h) do { _Pragma("unroll") for (int n = 0; n < 2; ++n) _Pragma("unroll") for (int k = 0; k < 2; ++k) dst[n][k] = *(const LAS bf16x8*)(lds + PG8_SB(b, h) + boff + n * 2048 + k * 1024); } while (0)
#define PG8_MMA(ai, bj, At, Bt) do { __builtin_amdgcn_s_setprio(1); _Pragma("unroll") for (int m = 0; m < 4; ++m) _Pragma("unroll") for (int n = 0; n < 2; ++n) _Pragma("unroll") for (int k = 0; k < 2; ++k) \
        acc[ai][bj][m][n] = __builtin_amdgcn_mfma_f32_16x16x32_bf16(Bt[n][k], At[m][k], acc[ai][bj][m][n], 0, 0, 0); __builtin_amdgcn_s_setprio(0); } while (0)
#define PG8_WAIT_V(n) asm volatile("s_waitcnt vmcnt(" #n ")" ::: "memory")
#define PG8_WAIT_L(n) asm volatile("s_waitcnt lgkmcnt(" #n ")" ::: "memory")
#define PG8_BAR __builtin_amdgcn_s_barrier()
#define PG8_SCHED __builtin_amdgcn_sched_barrier(0)
    Unit cur, nxt; int ui = 0;
    if (!S.next(0, cur)) return;
    f32x4 acc[2][2][4][2];
#pragma unroll
    for (int a = 0; a < 2; ++a)
#pragma unroll
        for (int b = 0; b < 2; ++b)
#pragma unroll
            for (int m = 0; m < 4; ++m)
#pragma unroll
                for (int n = 0; n < 2; ++n) acc[a][b][m][n] = (f32x4){0.f, 0.f, 0.f, 0.f};
    bf16x8 At[4][2], B0[2][2], B1[2][2];
    const char* cA = cur.a; const char* cB = cur.b;
    PG8_STAGE(PG8_SB(0, 0), cB, voffB); PG8_STAGE(PG8_SA(0, 0), cA, voffA); PG8_STAGE(PG8_SB(0, 1), cB + hstepB, voffB); PG8_STAGE(PG8_SA(0, 1), cA + hstepA, voffA);
    if (wr == 1) PG8_BAR;
    PG8_WAIT_V(4); PG8_BAR;
    PG8_STAGE(PG8_SB(1, 0), cB + kstep, voffB); PG8_STAGE(PG8_SA(1, 0), cA + kstep, voffA); PG8_STAGE(PG8_SB(1, 1), cB + hstepB + kstep, voffB);
    PG8_WAIT_V(6); PG8_BAR;
    for (;;) {
        const bool has_next = S.next(ui + 1, nxt);
        const char* nA = has_next ? nxt.a : cA; const char* nB = has_next ? nxt.b : cB;
        for (int t = 0; t < nt; t += 2) {
            const bool last = (t == nt - 2);
            const char* a1 = cA + (size_t)(t + 1) * kstep;
            const char* a2 = last ? nA : cA + (size_t)(t + 2) * kstep; const char* b2 = last ? nB : cB + (size_t)(t + 2) * kstep;
            const char* a3 = a2 + kstep; const char* b3 = b2 + kstep;
            PG8_LDB(B0, 0, 0); PG8_SCHED; PG8_LDA(At, 0, 0); PG8_STAGE(PG8_SA(1, 1), a1 + hstepA, voffA);
            PG8_WAIT_L(8); PG8_BAR; PG8_WAIT_L(0); PG8_MMA(0, 0, At, B0); PG8_BAR; PG8_SCHED;
            PG8_LDB(B1, 0, 1); PG8_STAGE(PG8_SB(0, 0), b2, voffB);
            PG8_BAR; PG8_WAIT_L(0); PG8_MMA(0, 1, At, B1); PG8_BAR;
            PG8_LDA(At, 0, 1); PG8_STAGE(PG8_SA(0, 0), a2, voffA);
            PG8_BAR; PG8_WAIT_L(0); PG8_MMA(1, 0, At, B0); PG8_BAR; PG8_SCHED;
            PG8_STAGE(PG8_SB(0, 1), b2 + hstepB, voffB);
            PG8_WAIT_V(6); PG8_BAR; PG8_MMA(1, 1, At, B1); PG8_BAR;
            PG8_LDB(B0, 1, 0); PG8_SCHED; PG8_LDA(At, 1, 0); PG8_STAGE(PG8_SA(0, 1), a2 + hstepA, voffA);
            PG8_WAIT_L(8); PG8_BAR; PG8_WAIT_L(0); PG8_MMA(0, 0, At, B0); PG8_BAR; PG8_SCHED;
            PG8_LDB(B1, 1, 1); PG8_STAGE(PG8_SB(1, 0), b3, voffB);
            PG8_BAR; PG8_WAIT_L(0); PG8_MMA(0, 1, At, B1); PG8_BAR;
            PG8_LDA(At, 1, 1); PG8_STAGE(PG8_SA(1, 0), a3, voffA);
            PG8_BAR; PG8_WAIT_L(0); PG8_MMA(1, 0, At, B0); PG8_BAR; PG8_SCHED;
            PG8_STAGE(PG8_SB(1, 1), b3 + hstepB, voffB);
            PG8_WAIT_V(6); PG8_BAR; PG8_MMA(1, 1, At, B1); PG8_BAR;
        }
        E(acc, cur, wr, wc, fr, fq);
        if (!has_next) break;
#pragma unroll
        for (int a = 0; a < 2; ++a)
#pragma unroll
            for (int b = 0; b < 2; ++b)
#pragma unroll
                for (int m = 0; m < 4; ++m)
#pragma unroll
                    for (int n = 0; n < 2; ++n) acc[a][b][m][n] = (f32x4){0.f, 0.f, 0.f, 0.f};
        cur = nxt; cA = nA; cB = nB; ++ui;
    }
    PG8_WAIT_V(0);
    if (wr == 0) PG8_BAR;
    PG8_BAR;
#undef PG8_SA
#undef PG8_SB
#undef PG8_STAGE
#undef PG8_LDA
#undef PG8_LDB
#undef PG8_MMA
#undef PG8_WAIT_V
#undef PG8_WAIT_L
#undef PG8_BAR
#undef PG8_SCHED
}
}


struct SchedIn {
    const char* A; const char* Bt; int G, c, trim;
    __device__ __forceinline__ bool next(int i, pg8::Unit& u) const {
        int pm, pn; const long L = (long)i * G + c;
        if (!trim) { if (!pg8::static_tile(MROWS / 256, NPAD / 256, L, pm, pn)) return false; }
        else if (L < 64 * 87) { pg8::static_tile(64, NPAD / 256, L, pm, pn); pm += pm / 16; }
        else { const int idx = (int)(L - 64 * 87); if (idx >= 4 * 15) return false; const int k = idx % 15; pm = 17 * (idx / 15) + 16; pn = k < 2 ? 4 + k : (k < 14 ? 10 + (k - 2) : 86); }
        u.pm = pm; u.pn = pn; u.tag = 0; u.a = A + (size_t)pm * 256 * DM * 2; u.b = Bt + (size_t)pn * 256 * DM * 2; return true; }
};
struct EpiIn {
    static constexpr bool PERM = true;
    bf16_t* Y; float* G32; bool dost;
    __device__ __forceinline__ void operator()(const f32x4 (&acc)[2][2][4][2], const pg8::Unit& u, int wr, int wc, int fr, int fq) const {
        if (!dost) return;
        const int pn = u.pn;
        int opq = 0; asm volatile("" : "+v"(opq));
        const int row0 = u.pm * 256 + wr * 64 + fr + opq;
        if (pn == 86) {
            if (wc == 0 && fq < 2) {
#pragma unroll
                for (int ai = 0; ai < 2; ++ai)
#pragma unroll
                    for (int m = 0; m < 4; ++m) { float* gp = G32 + (size_t)(row0 + ai * 128 + m * 16) * 16 + 8 * fq;
                        *(f32x4*)gp = acc[ai][0][m][0]; *(f32x4*)(gp + 4) = acc[ai][0][m][1]; }
            }
            return;
        }
        int act = 0;
        if ((pn >= 6 && pn < 10) || (pn >= 26 && pn < 30) || (pn >= 42 && pn < 46) || (pn >= 50 && pn < 54)) act = 1;
        else if ((pn >= 22 && pn < 26) || pn >= 54) act = 2;
        const int col0 = pn * 256 + wc * 32 + 8 * fq;
#pragma unroll
        for (int ai = 0; ai < 2; ++ai)
#pragma unroll
            for (int m = 0; m < 4; ++m) { bf16_t* rowp = Y + (size_t)(row0 + ai * 128 + m * 16) * NPAD + col0;
#pragma unroll
                for (int bj = 0; bj < 2; ++bj) { f32x4 v0 = acc[ai][bj][m][0], v1 = acc[ai][bj][m][1];
                    if (act == 1) {
#pragma unroll
                        for (int j = 0; j < 4; ++j) { v0[j] = siluf_(v0[j]); v1[j] = siluf_(v1[j]); } }
                    else if (act == 2) {
#pragma unroll
                        for (int j = 0; j < 4; ++j) { v0[j] = sigmoidf_(v0[j]); v1[j] = sigmoidf_(v1[j]); } }
                    u32x4 w; w.x = cvt_pk_bf16(v0[0], v0[1]); w.y = cvt_pk_bf16(v0[2], v0[3]); w.z = cvt_pk_bf16(v1[0], v1[1]); w.w = cvt_pk_bf16(v1[2], v1[3]);
                    *(u32x4*)(rowp + bj * 128) = w; } }
    }
};

struct SchedPool {
    const char* A; const char* Bt; int G, c, i0;
    __device__ __forceinline__ bool next(int i, pg8::Unit& u) const {
        const long L = (long)i * G + c; if (L >= (MROWS / 256) * 4) return false;
        const int pm = (int)(L >> 2), g = (int)(L & 3);
        u.pm = pm; u.pn = g; u.tag = 0; u.a = A + ((size_t)pm * 256 * BRW + g * 256) * 2; u.b = Bt + (size_t)g * 256 * 256 * 2; return true; }
};
struct EpiPool {
    static constexpr bool PERM = true;
    bf16_t* Y;
    __device__ __forceinline__ void operator()(const f32x4 (&acc)[2][2][4][2], const pg8::Unit& u, int wr, int wc, int fr, int fq) const {
        int opq = 0; asm volatile("" : "+v"(opq));
        const int row0 = u.pm * 256 + wr * 64 + fr + opq, colc = u.pn * 256 + wc * 32 + 8 * fq;
#pragma unroll
        for (int ai = 0; ai < 2; ++ai) {
            u32x4 zw[4][2];
#pragma unroll
            for (int m = 0; m < 4; ++m)
#pragma unroll
                for (int bj = 0; bj < 2; ++bj) zw[m][bj] = *(const u32x4*)(Y + (size_t)(row0 + ai * 128 + m * 16) * NPAD + C_PZ + colc + bj * 128);
#pragma unroll
            for (int m = 0; m < 4; ++m)
#pragma unroll
                for (int bj = 0; bj < 2; ++bj) { float z[8]; unpack8(zw[m][bj], z);
                    const f32x4 v0 = acc[ai][bj][m][0], v1 = acc[ai][bj][m][1]; float o[8];
#pragma unroll
                    for (int j = 0; j < 4; ++j) { o[j] = v0[j] * z[j]; o[4 + j] = v1[j] * z[4 + j]; }
                    *(u32x4*)(Y + (size_t)(row0 + ai * 128 + m * 16) * NPAD + C_PZ + colc + bj * 128) = pack8(o); }
            asm volatile("" ::: "memory"); }
    }
};

struct SchedMerge {
    const char* Y; const char* Wbr; int G, c, nM;
    __device__ __forceinline__ bool next(int i, pg8::Unit& u) const {
        const long L = (long)(i >> 2) * G + c; const int br = i & 3; if (L >= (long)nM * 8) return false;
        const int pm = (int)(L >> 3), pn = (int)(L & 7);
        const int pmr = (nM == 64) ? (pm + pm / 16) : pm;
        const int coff = br == 0 ? C_AQ : (br == 1 ? C_MO : (br == 2 ? C_CZ : C_PZ));
        u.pm = pmr; u.pn = pn; u.tag = br; u.a = Y + ((size_t)pmr * 256 * NPAD + coff) * 2; u.b = Wbr + ((size_t)br * DM * BRW + (size_t)pn * 256 * BRW) * 2; return true; }
};
struct EpiMerge {
    static constexpr bool PERM = true;
    const bf16_t* Y; bf16_t* accb;
    __device__ __forceinline__ void operator()(const f32x4 (&acc)[2][2][4][2], const pg8::Unit& u, int wr, int wc, int fr, int fq) const {
        int opq = 0; asm volatile("" : "+v"(opq));
        const int row0 = u.pm * 256 + wr * 64 + fr + opq, col0 = u.pn * 256 + wc * 32 + 8 * fq, tag = u.tag;
#pragma unroll
        for (int ai = 0; ai < 2; ++ai) {
            u32x4 gw[4][2], pw[4][2];
#pragma unroll
            for (int m = 0; m < 4; ++m) { const size_t row = (size_t)(row0 + ai * 128 + m * 16);
#pragma unroll
                for (int bj = 0; bj < 2; ++bj) { gw[m][bj] = *(const u32x4*)(Y + row * NPAD + C_GM + tag * DM + col0 + bj * 128);
                    pw[m][bj] = tag != 0 ? *(const u32x4*)(accb + row * DM + col0 + bj * 128) : (u32x4){0u, 0u, 0u, 0u}; } }
#pragma unroll
            for (int m = 0; m < 4; ++m) { const size_t row = (size_t)(row0 + ai * 128 + m * 16);
#pragma unroll
                for (int bj = 0; bj < 2; ++bj) { float gt[8], pv[8]; unpack8(gw[m][bj], gt); unpack8(pw[m][bj], pv);
                    const f32x4 v0 = acc[ai][bj][m][0], v1 = acc[ai][bj][m][1]; float o[8];
#pragma unroll
                    for (int j = 0; j < 4; ++j) { o[j] = v0[j] * gt[j] + pv[j]; o[4 + j] = v1[j] * gt[4 + j] + pv[4 + j]; }
                    *(u32x4*)(accb + row * DM + col0 + bj * 128) = pack8(o); } }
            asm volatile("" ::: "memory"); }
    }
};

struct SchedOut {
    const char* A; const char* Bt; int G, c, nM;
    __device__ __forceinline__ bool next(int i, pg8::Unit& u) const {
        const long L = (long)i * G + c; if (L >= (long)nM * 8) return false;
        const int pm = (int)(L >> 3), pn = (int)(L & 7);
        const int pmr = (nM == 64) ? (pm + pm / 16) : pm;
        u.pm = pmr; u.pn = pn; u.tag = 0; u.a = A + (size_t)pmr * 256 * DM * 2; u.b = Bt + (size_t)pn * 256 * DM * 2; return true; }
};
struct EpiOut {
    static constexpr bool PERM = false;
    const float* xin; const float* ctxin;
    const float* mod;
    bf16_t* X1; int first;
    __device__ __forceinline__ void operator()(const f32x4 (&acc)[2][2][4][2], const pg8::Unit& u, int wr, int wc, int fr, int fq) const {
        const int b = u.pm / 17, j = u.pm % 17; const bool isctx = (j == 16);
        int opq = 0; asm volatile("" : "+v"(opq));
        const int rin = wr * 64 + fr + opq;
        const int col0 = u.pn * 256 + wc * 32 + 4 * fq;
        const float* gtp = mod + (size_t)(isctx ? 4 : b) * 6144 + 4096 + col0;
        const float* resb = isctx ? ctxin + (size_t)b * LC * DM : xin + ((size_t)b * TL + (size_t)j * 256) * DM;
        bf16_t* xb = X1 + (size_t)u.pm * 256 * DM;
        f32x4 gv[2][2];
#pragma unroll
        for (int bj = 0; bj < 2; ++bj)
#pragma unroll
            for (int n = 0; n < 2; ++n) gv[bj][n] = *(const f32x4*)(gtp + bj * 128 + n * 16);
#pragma unroll
        for (int ai = 0; ai < 2; ++ai) {
            f32x4 rv[4][2][2];
#pragma unroll
            for (int m = 0; m < 4; ++m) { const size_t off = (size_t)(rin + ai * 128 + m * 16) * DM + col0;
#pragma unroll
                for (int bj = 0; bj < 2; ++bj)
#pragma unroll
                    for (int n = 0; n < 2; ++n) {
                        if (first) rv[m][bj][n] = *(const f32x4*)(resb + off + bj * 128 + n * 16);
                        else { const u32x2 w = *(const u32x2*)(xb + off + bj * 128 + n * 16); rv[m][bj][n] = (f32x4){bflo(w.x), bfhi(w.x), bflo(w.y), bfhi(w.y)}; } } }
#pragma unroll
            for (int m = 0; m < 4; ++m) { const size_t off = (size_t)(rin + ai * 128 + m * 16) * DM + col0;
#pragma unroll
                for (int bj = 0; bj < 2; ++bj)
#pragma unroll
                    for (int n = 0; n < 2; ++n) { const f32x4 o = rv[m][bj][n] + gv[bj][n] * acc[ai][bj][m][n];
                        u32x2 w; w.x = cvt_pk_bf16(o[0], o[1]); w.y = cvt_pk_bf16(o[2], o[3]); *(u32x2*)(xb + off + bj * 128 + n * 16) = w; } }
            asm volatile("" ::: "memory"); }
    }
};

namespace att {
constexpr int D = 128, NW = 8, QBLK = 32, KVBLK = 64;
constexpr float SCALE = 0.088388347648318440f;
constexpr float THR = 8.f;
constexpr int LDQ = NPAD, LDK = NPAD;
constexpr size_t SHM_V = KVBLK * D * 2, SHM_K = KVBLK * D * 2, SHM_ATTN = 2 * SHM_V + 2 * SHM_K + NW * 64 * 4;
#define KSWZ(row, colB) ((row) * 256 + ((colB) ^ (((row) & 7) << 4)))
#define SBAR() __builtin_amdgcn_sched_barrier(0)
__device__ __forceinline__ int crow(int r, int hi) { return (r & 3) + 8 * (r >> 2) + 4 * hi; }
__device__ __forceinline__ void partialSM(f32x16& p0, f32x16& p1, float& m_reg, float& mn, float& alpha) {
  constexpr float C = SCALE * 1.4426950408889634f;
  float pmax = p0[0]; for (int r = 1; r < 16; ++r) pmax = fmaxf(pmax, p0[r]); for (int r = 0; r < 16; ++r) pmax = fmaxf(pmax, p1[r]);
  { auto rr = __builtin_amdgcn_permlane32_swap(__float_as_uint(pmax), __float_as_uint(pmax), false, false);
    pmax = fmaxf(__uint_as_float(rr[0]), __uint_as_float(rr[1])); }
  if (__builtin_expect(__all(pmax - m_reg <= THR / SCALE), 1)) { mn = m_reg; alpha = 1.f; }
  else { mn = fmaxf(m_reg, pmax); alpha = __builtin_amdgcn_exp2f((m_reg - mn) * C); m_reg = mn; }
  float mnC = -mn * C;
  for (int r = 0; r < 16; ++r) p0[r] = fmaf(p0[r], C, mnC); for (int r = 0; r < 16; ++r) p1[r] = fmaf(p1[r], C, mnC);
  for (int r = 0; r < 16; ++r) p0[r] = __builtin_amdgcn_exp2f(p0[r]);
}
__device__ __forceinline__ void finishSM(f32x16& p0, f32x16& p1, float alpha, float& l_reg, bf16x8& pa0, bf16x8& pa1, bf16x8& pa2, bf16x8& pa3) {
  for (int r = 0; r < 16; ++r) p1[r] = __builtin_amdgcn_exp2f(p1[r]);
  float ps = 0; for (int r = 0; r < 16; ++r) ps += p0[r]; for (int r = 0; r < 16; ++r) ps += p1[r];
  { auto rr = __builtin_amdgcn_permlane32_swap(__float_as_uint(ps), __float_as_uint(ps), false, false);
    ps = __uint_as_float(rr[0]) + __uint_as_float(rr[1]); }
  l_reg = l_reg * alpha + ps;
#define PK4(P, BASE, OUT) do { unsigned a0 = cvt_pk_bf16(P[BASE + 0], P[BASE + 1]), a1 = cvt_pk_bf16(P[BASE + 2], P[BASE + 3]);   \
    unsigned b0 = cvt_pk_bf16(P[BASE + 4], P[BASE + 5]), b1 = cvt_pk_bf16(P[BASE + 6], P[BASE + 7]);                              \
    auto r0 = __builtin_amdgcn_permlane32_swap(a0, b0, false, false); auto r1 = __builtin_amdgcn_permlane32_swap(a1, b1, false, false); \
    u32x4 w = {r0[0], r1[0], r0[1], r1[1]}; OUT = *reinterpret_cast<bf16x8*>(&w); } while (0)
  PK4(p0, 0, pa0); PK4(p0, 8, pa1); PK4(p1, 0, pa2); PK4(p1, 8, pa3);
#undef PK4
}
__device__ __forceinline__ void qkt(f32x16& p0, f32x16& p1, const bf16_t* Ks, const bf16x8* qr, int r32, int hi) {
  p0 = f32x16{}; p1 = f32x16{};
  for (int d0 = 0; d0 < 8; ++d0) { int cb = (d0 * 16 + hi * 8) * 2;
    bf16x8 b0 = *reinterpret_cast<const bf16x8*>((const char*)Ks + KSWZ(r32, cb));
    bf16x8 b1 = *reinterpret_cast<const bf16x8*>((const char*)Ks + KSWZ(32 + r32, cb));
    p0 = __builtin_amdgcn_mfma_f32_32x32x16_bf16(b0, qr[d0], p0, 0, 0, 0);
    p1 = __builtin_amdgcn_mfma_f32_32x32x16_bf16(b1, qr[d0], p1, 0, 0, 0); }
}
__device__ __forceinline__ int v_st(int k, int c) { const int kk = (k & ~0xC) | ((k & 4) << 1) | ((k & 8) >> 1); return ((kk >> 3) * 4 + (c >> 5)) * 512 + ((kk & 7) * 32 + (c & 31)) * 2; }
__device__ __forceinline__ int v_rd_base(int lane) { return ((lane & 3) << 3) | (((lane >> 2) & 3) << 6) | (((lane >> 4) & 1) << 5) | (((lane >> 5) & 1) << 8); }
constexpr int v_rd_off(int d0, int ks, int half) { return d0 * 512 + ks * 4096 + half * 2048; }
template <int OFF> __device__ __forceinline__ s16x4 tr_read(int vb) {
  s16x4 r; asm volatile("ds_read_b64_tr_b16 %0, %1 offset:%2" : "=&v"(r) : "v"(vb), "i"(OFF) : "memory"); return r;
}
template <int D0> __device__ __forceinline__ void pv_one(f32x16& od, int vb, bf16x8 pa0, bf16x8 pa1, bf16x8 pa2, bf16x8 pa3) {
  const s16x4 l0 = tr_read<v_rd_off(D0, 0, 0)>(vb), h0 = tr_read<v_rd_off(D0, 0, 1)>(vb), l1 = tr_read<v_rd_off(D0, 1, 0)>(vb), h1 = tr_read<v_rd_off(D0, 1, 1)>(vb);
  const s16x4 l2 = tr_read<v_rd_off(D0, 2, 0)>(vb), h2 = tr_read<v_rd_off(D0, 2, 1)>(vb), l3 = tr_read<v_rd_off(D0, 3, 0)>(vb), h3 = tr_read<v_rd_off(D0, 3, 1)>(vb);
  asm volatile("s_waitcnt lgkmcnt(0)" ::: "memory"); SBAR();
#define PK(L, H) (bf16x8){L[0], L[1], L[2], L[3], H[0], H[1], H[2], H[3]}
  od = __builtin_amdgcn_mfma_f32_32x32x16_bf16(pa0, PK(l0, h0), od, 0, 0, 0);
  od = __builtin_amdgcn_mfma_f32_32x32x16_bf16(pa1, PK(l1, h1), od, 0, 0, 0);
  od = __builtin_amdgcn_mfma_f32_32x32x16_bf16(pa2, PK(l2, h2), od, 0, 0, 0);
  od = __builtin_amdgcn_mfma_f32_32x32x16_bf16(pa3, PK(l3, h3), od, 0, 0, 0);
#undef PK
}
__device__ __forceinline__ void pv_d0(f32x16* o, int vb, bf16x8 pa0, bf16x8 pa1, bf16x8 pa2, bf16x8 pa3) {
  pv_one<0>(o[0], vb, pa0, pa1, pa2, pa3); pv_one<1>(o[1], vb, pa0, pa1, pa2, pa3); pv_one<2>(o[2], vb, pa0, pa1, pa2, pa3); pv_one<3>(o[3], vb, pa0, pa1, pa2, pa3);
}
__device__ __forceinline__ void attn_dense_body(bf16_t* __restrict__ Qb, const bf16_t* __restrict__ Kh, const bf16_t* __restrict__ Vh, const bf16_t* __restrict__ Zb, int seq, char* lds) {
  const int tid = otid(), wid = tid >> 6, lane = tid & 63, r32 = lane & 31, hi = lane >> 5;
  bf16_t* V_lds = (bf16_t*)lds; bf16_t* K_lds = (bf16_t*)(lds + 2 * SHM_V);
  float* ws = (float*)(lds + 2 * SHM_V + 2 * SHM_K) + wid * 64; float* li_l = ws; float* al_l = ws + 32;
  float m_reg = -1e30f, l_reg = 0; f32x16 o[4] = {}; bf16x8 qr[8];
  const bf16_t* Qw = Qb + (long)(wid * QBLK + r32) * LDQ + hi * 8;
#pragma unroll
  for (int d0 = 0; d0 < 8; ++d0) qr[d0] = *reinterpret_cast<const bf16x8*>(Qw + d0 * 16);
  const int sr = tid >> 4, sc = (tid & 15) * 8, vst0 = v_st(sr, sc), vst1 = v_st(32 + sr, sc);
  const int vb0 = (int)(uintptr_t)V_lds + v_rd_base(lane);
  struct { bf16x8 vs0, vs1, ks0, ks1; } sr_[2];
#define SLOAD(i, k0) do { sr_[i].vs0 = *reinterpret_cast<const bf16x8*>(&Vh[(long)((k0) + sr) * LDK + sc]); sr_[i].vs1 = *reinterpret_cast<const bf16x8*>(&Vh[(long)((k0) + 32 + sr) * LDK + sc]); \
    sr_[i].ks0 = *reinterpret_cast<const bf16x8*>(&Kh[(long)((k0) + sr) * LDK + sc]); sr_[i].ks1 = *reinterpret_cast<const bf16x8*>(&Kh[(long)((k0) + 32 + sr) * LDK + sc]); } while (0)
#define SWRITE(b, i) do { *(bf16x8*)((char*)V_lds + (b) * SHM_V + vst0) = sr_[i].vs0;          \
    *(bf16x8*)((char*)V_lds + (b) * SHM_V + vst1) = sr_[i].vs1; int kc = sc * 2;               \
    *(bf16x8*)((char*)K_lds + (b) * SHM_K + KSWZ(sr, kc)) = sr_[i].ks0;                       \
    *(bf16x8*)((char*)K_lds + (b) * SHM_K + KSWZ(32 + sr, kc)) = sr_[i].ks1; } while (0)
#define SWAIT() do { asm volatile("s_waitcnt vmcnt(4)" ::: "memory"); } while (0)
#define RESC(a) do { if (__any((a) < 1.f)) { if (hi == 0) al_l[r32] = (a); asm volatile("s_waitcnt lgkmcnt(0)" ::: "memory"); \
    for (int d = 0; d < 4; ++d) for (int r = 0; r < 16; ++r) o[d][r] *= al_l[crow(r, hi)]; } } while (0)
  f32x16 pA0, pA1, pB0, pB1; float mnA, mnB, alA, alB; bf16x8 pa0, pa1, pa2, pa3; const int NT = seq / KVBLK;
  constexpr int SE = 0, SO = 1;
  SLOAD(SE, 0); asm volatile("s_waitcnt vmcnt(0)" ::: "memory"); SWRITE(0, SE); __syncthreads();
  qkt(pA0, pA1, K_lds, qr, r32, hi); partialSM(pA0, pA1, m_reg, mnA, alA);
  SLOAD(SO, KVBLK); { if (2 < NT) SLOAD(SE, 2 * KVBLK); }
  SWAIT(); SWRITE(1, SO); __syncthreads();
  for (int j = 1; j + 1 < NT; j += 2) {
    SBAR(); qkt(pB0, pB1, (bf16_t*)((char*)K_lds + SHM_K), qr, r32, hi);
    finishSM(pA0, pA1, alA, l_reg, pa0, pa1, pa2, pa3); SBAR();
    SLOAD(SO, (j + 2) * KVBLK); SBAR();
    pv_d0(o, vb0, pa0, pa1, pa2, pa3); partialSM(pB0, pB1, m_reg, mnB, alB);
    __syncthreads(); SWAIT(); SWRITE(0, SE);
    RESC(alB); __syncthreads();
    SBAR(); qkt(pA0, pA1, K_lds, qr, r32, hi);
    finishSM(pB0, pB1, alB, l_reg, pa0, pa1, pa2, pa3); SBAR();
    if (j + 3 < NT) SLOAD(SE, (j + 3) * KVBLK); SBAR();
    pv_d0(o, vb0 + (int)SHM_V, pa0, pa1, pa2, pa3); partialSM(pA0, pA1, m_reg, mnA, alA);
    __syncthreads(); SWAIT(); SWRITE(1, SO);
    RESC(alA); __syncthreads();
  }
  SBAR(); qkt(pB0, pB1, (bf16_t*)((char*)K_lds + SHM_K), qr, r32, hi);
  finishSM(pA0, pA1, alA, l_reg, pa0, pa1, pa2, pa3); SBAR();
  pv_d0(o, vb0, pa0, pa1, pa2, pa3); partialSM(pB0, pB1, m_reg, mnB, alB);
  __syncthreads(); RESC(alB);
  finishSM(pB0, pB1, alB, l_reg, pa0, pa1, pa2, pa3); SBAR();
  pv_d0(o, vb0 + (int)SHM_V, pa0, pa1, pa2, pa3);
  if (hi == 0) li_l[r32] = l_reg; asm volatile("s_waitcnt lgkmcnt(0)" ::: "memory");
  float rli[16];
#pragma unroll
  for (int r = 0; r < 16; ++r) rli[r] = __builtin_amdgcn_rcpf(li_l[crow(r, hi)]);
  bf16_t* Ol = (bf16_t*)(lds + SHM_ATTN) + wid * (32 * 136);
#pragma unroll
  for (int r = 0; r < 16; ++r) { const int row = crow(r, hi);
#pragma unroll
    for (int d0 = 0; d0 < 4; ++d0) Ol[row * 136 + 32 * d0 + r32] = f2bf(o[d0][r] * rli[r]); }
  asm volatile("s_waitcnt lgkmcnt(0)" ::: "memory");
  int opq = 0; asm volatile("" : "+v"(opq));
  const long gbase = (long)(wid * QBLK + opq) * LDQ;
  u32x4 ov[8], zv[8];
#pragma unroll
  for (int it = 0; it < 8; ++it) { const int chunk = it * 64 + lane, row = chunk >> 4, c8 = (chunk & 15) * 8;
    ov[it] = *(const u32x4*)(Ol + row * 136 + c8); zv[it] = *(const u32x4*)(Zb + gbase + (long)row * LDQ + c8); }
#pragma unroll
  for (int it = 0; it < 8; ++it) { const int chunk = it * 64 + lane, row = chunk >> 4, c8 = (chunk & 15) * 8;
    float of[8], zf[8], rf[8]; unpack8(ov[it], of); unpack8(zv[it], zf);
#pragma unroll
    for (int e = 0; e < 8; ++e) rf[e] = of[e] * zf[e];
    *(u32x4*)(Qb + gbase + (long)row * LDQ + c8) = pack8(rf); }
#undef SLOAD
#undef SWRITE
#undef SWAIT
#undef RESC
}
}

template <int KT>
__device__ __forceinline__ void tconv_tile(const float* __restrict__ src, int ld, int K, bool remap, bf16_t* __restrict__ dst, int n0, int k0, unsigned char* smem, const float* __restrict__ nscale = nullptr) {
    const int tid = otid(), kk = tid >> 4, n4 = (tid & 15) * 4;
    constexpr int LDT = KT + 8, NJ = KT / 32;
    bf16_t* tile = (bf16_t*)smem;
    const int n = n0 + n4; int sc = n; bool zero = false;
    if (remap) { if (n < 7680) sc = n; else if (n < 22016) sc = n + 16; else if (n < 22032) sc = 7680 + (n - 22016); else zero = true; }
    f32x4 v[NJ];
    const f32x4 nsc = nscale ? *(const f32x4*)(nscale + n) : (f32x4){1.f, 1.f, 1.f, 1.f};
#pragma unroll
    for (int j = 0; j < NJ; ++j) v[j] = zero ? (f32x4){0.f, 0.f, 0.f, 0.f} : *(const f32x4*)(src + (size_t)(k0 + kk + 32 * j) * ld + sc) * nsc;
#pragma unroll
    for (int j = 0; j < NJ; ++j)
#pragma unroll
        for (int i = 0; i < 4; ++i) tile[(n4 + i) * LDT + kk + 32 * j] = f2bf(v[j][i]);
    __syncthreads();
#pragma unroll
    for (int j = 0; j < KT / 64; ++j) { const int idx = tid + 512 * j, nn = idx / (KT / 8), k8 = (idx % (KT / 8)) * 8;
        *(u32x4*)(dst + (size_t)(n0 + nn) * K + k0 + k8) = *(const u32x4*)(tile + nn * LDT + k8); }
    __syncthreads();
}
__device__ __forceinline__ void mod_unit(const Params& p, int l, int cb, unsigned char* smem) {
    const int tid = otid();
    float* sc = (float*)smem; float* red = sc + 5 * 2048;
    for (int i = tid; i < 5 * 2048; i += 512) { const int r = i >> 11, k = i & 2047; const float v = r < 4 ? p.c[r * 2048 + k] : p.c_ctx[k]; sc[i] = siluf_(v); }
    __syncthreads();
    const int col4 = (tid & 15) * 4, ks = tid >> 4;
    f32x4 a0 = {0, 0, 0, 0}, a1 = a0, a2 = a0, a3 = a0, a4 = a0;
    const float* wp = p.w_mod + (size_t)l * 2048 * 6144 + (size_t)(ks * 64) * 6144 + cb * 64 + col4;
#pragma unroll 8
    for (int kk = 0; kk < 64; ++kk) { const f32x4 w = *(const f32x4*)(wp + (size_t)kk * 6144); const int k = ks * 64 + kk;
        a0 += sc[k] * w; a1 += sc[2048 + k] * w; a2 += sc[4096 + k] * w; a3 += sc[6144 + k] * w; a4 += sc[8192 + k] * w; }
    *(f32x4*)(red + (ks * 5 + 0) * 64 + col4) = a0; *(f32x4*)(red + (ks * 5 + 1) * 64 + col4) = a1; *(f32x4*)(red + (ks * 5 + 2) * 64 + col4) = a2;
    *(f32x4*)(red + (ks * 5 + 3) * 64 + col4) = a3; *(f32x4*)(red + (ks * 5 + 4) * 64 + col4) = a4;
    __syncthreads();
    if (tid < 320) { const int r = tid >> 6, cc = tid & 63; float s = p.b_mod[l * 6144 + cb * 64 + cc];
        for (int q = 0; q < 32; ++q) s += red[(q * 5 + r) * 64 + cc];
        ((float*)(p.ws + WS_MOD))[(size_t)(l * 5 + r) * 6144 + cb * 64 + cc] = s; }
    __syncthreads();
}
constexpr int U_WIN1 = 348 * 4, U_WBR1 = 4 * 32 * 2, U_WOUT1 = 32 * 4, U_POOL1 = 4 * 4, U_CONV1 = U_WIN1 + U_WBR1 + U_WOUT1 + U_POOL1;
__device__ __forceinline__ void conv_unit(const Params& p, int l, int v, unsigned char* smem) {
    if (v < U_WIN1) { const int nt = v >> 2, kt = v & 3;
        tconv_tile<512>(p.w_in + (size_t)l * DM * NIN, NIN, DM, true, (bf16_t*)(p.ws + WS_WIN) + (size_t)l * NPAD * DM, nt * 64, kt * 512, smem); return; }
    v -= U_WIN1;
    if (v < U_WBR1) { const int mat = l * 4 + (v >> 6), r = v & 63, nt = r >> 1, kt = r & 1;
        tconv_tile<512>(p.w_branch + (size_t)mat * BRW * DM, DM, BRW, false, (bf16_t*)(p.ws + WS_WBR) + (size_t)mat * DM * BRW, nt * 64, kt * 512, smem); return; }
    v -= U_WBR1;
    if (v < U_WOUT1) { const int nt = v >> 2, kt = v & 3;
        tconv_tile<512>(p.w_out + (size_t)l * DM * DM, DM, DM, false, (bf16_t*)(p.ws + WS_WOUT) + (size_t)l * DM * DM, nt * 64, kt * 512, smem); return; }
    v -= U_WOUT1;
    { const int mat = l * 4 + (v >> 2), nt = v & 3;
        tconv_tile<256>(p.pool_w + (size_t)mat * 256 * 256, 256, 256, false, (bf16_t*)(p.ws + WS_POOLW) + (size_t)mat * 256 * 256, nt * 64, 0, smem, p.pool_scale + (size_t)mat * 256); }
}
__device__ void phase_prep(const Params& p, unsigned char* smem) {
    constexpr int U_MOD = 192;
    for (int u = blockIdx.x; u < U_MOD + U_CONV1; u += gridDim.x) {
        if (u < U_MOD) mod_unit(p, u / 96, u % 96, smem); else conv_unit(p, 0, u - U_MOD, smem);
    }
}

__device__ void phase_norm(const Params& p, int l) {
    const int tid = otid(), lane = tid & 63, wv = obid() * 8 + (tid >> 6), nwv = gridDim.x * 8;
    const float* mod = (const float*)(p.ws + WS_MOD) + (size_t)l * 5 * 6144;
    const float* gain = p.norm_gain + l * DM;
    bf16_t* H = (bf16_t*)(p.ws + WS_H);
    for (int row = wv; row < MROWS; row += nwv) {
        const int b = row / RPB, tt = row % RPB; const bool isctx = tt >= TL;
        const float* xr = isctx ? p.ctx + ((size_t)b * LC + (tt - TL)) * DM : p.x + ((size_t)b * TL + tt) * DM;
        const bf16_t* xb = (const bf16_t*)(p.ws + WS_X1) + (size_t)row * DM;
        const float* mr = mod + (size_t)(isctx ? 4 : b) * 6144;
        f32x4 v[8]; float ss = 0.f;
#pragma unroll
        for (int j = 0; j < 8; ++j) {
            if (l == 0) v[j] = *(const f32x4*)(xr + 256 * j + 4 * lane);
            else { const u32x2 w = *(const u32x2*)(xb + 256 * j + 4 * lane); v[j] = (f32x4){bflo(w.x), bfhi(w.x), bflo(w.y), bfhi(w.y)}; }
            ss += v[j][0] * v[j][0] + v[j][1] * v[j][1] + v[j][2] * v[j][2] + v[j][3] * v[j][3]; }
#pragma unroll
        for (int o = 32; o >= 1; o >>= 1) ss += __shfl_xor(ss, o);
        const float rstd = rsqrtf(ss * (1.0f / DM) + EPS);
#pragma unroll
        for (int j = 0; j < 8; ++j) { const int cidx = 256 * j + 4 * lane;
            const f32x4 g = *(const f32x4*)(gain + cidx), sh = *(const f32x4*)(mr + cidx), sc = *(const f32x4*)(mr + 2048 + cidx);
            f32x4 y = v[j] * rstd * g * (1.0f + sc) + sh;
            u32x2 w; w.x = cvt_pk_bf16(y[0], y[1]); w.y = cvt_pk_bf16(y[2], y[3]);
            *(u32x2*)(H + (size_t)row * DM + cidx) = w; }
    }
}
__device__ void phase_final(const Params& p) {
    const int tid = otid(), lane = tid & 63, wv = obid() * 8 + (tid >> 6), nwv = gridDim.x * 8;
    for (int row = wv; row < NB * TL; row += nwv) {
        const int b = row / TL, t = row % TL;
        const bf16_t* xb = (const bf16_t*)(p.ws + WS_X1) + (size_t)(b * RPB + t) * DM;
        float* xr = p.out + (size_t)row * DM;
        f32x4 v[8]; float ss = 0.f;
#pragma unroll
        for (int j = 0; j < 8; ++j) { const u32x2 w = *(const u32x2*)(xb + 256 * j + 4 * lane); v[j] = (f32x4){bflo(w.x), bfhi(w.x), bflo(w.y), bfhi(w.y)};
            ss += v[j][0] * v[j][0] + v[j][1] * v[j][1] + v[j][2] * v[j][2] + v[j][3] * v[j][3]; }
#pragma unroll
        for (int o = 32; o >= 1; o >>= 1) ss += __shfl_xor(ss, o);
        const float rstd = rsqrtf(ss * (1.0f / DM) + EPS);
#pragma unroll
        for (int j = 0; j < 8; ++j) { const int cidx = 256 * j + 4 * lane; const f32x4 g = *(const f32x4*)(p.final_gain + cidx); *(f32x4*)(xr + cidx) = v[j] * rstd * g; }
    }
}

__device__ __forceinline__ int seq_row(int b, int dir, int pos  ) {
    if (pos < LC) { const int o = dir ? (LC - 1 - pos) : pos; return b * RPB + TL + o; }
    const int q = pos - LC; const int o = dir ? (TL - 1 - q) : q; return b * RPB + o;
}
__device__ void phase_mix1(const Params& p, int l, unsigned char* smem) {
    const int tid = otid(), lane = tid & 63, wv = obid() * 8 + (tid >> 6), nwv = gridDim.x * 8;
    bf16_t* Y = (bf16_t*)(p.ws + WS_Y);
    if ((int)blockIdx.x >= (int)gridDim.x - 32) {
        const int sq = blockIdx.x - (gridDim.x - 32), dir = sq & 1, hd = (sq >> 1) & 3, b = sq >> 3, wid = tid >> 6;
        const float* G32 = (const float*)(p.ws + WS_G32);
        f32x4* GT4 = (f32x4*)(p.ws + WS_GT4) + (size_t)sq * RPB; float* GW = (float*)(p.ws + WS_GW) + (size_t)sq * RPB; float* GD = (float*)(p.ws + WS_GD) + sq * 128;
        const float bi = p.gate_bias[l * 16 + (dir ? 8 : 0) + hd], bfv = p.gate_bias[l * 16 + (dir ? 12 : 4) + hd];
        float* sAq = (float*)smem; float* sCm = sAq + RPB; float* sB = sCm + RPB; float* sB63 = sB + RPB; float* sC63 = sB63 + 128; float* sMc = sC63 + 128;
        for (int ci = wid; ci < NCHUNK; ci += 8) {
            const int pos = ci * 64 + lane, row = seq_row(b, dir, pos);
            const float gi = G32[(size_t)row * 16 + (dir ? 8 : 0) + hd] + bi, gf = G32[(size_t)row * 16 + (dir ? 12 : 4) + hd] + bfv;
            const float lf = fminf(gf, 0.f) - log1pf(__expf(-fabsf(gf)));
            float bsum = lf;
#pragma unroll
            for (int o = 1; o < 64; o <<= 1) { const float t = __shfl_up(bsum, o); if (lane >= o) bsum += t; }
            const float a = gi - bsum; float cm = a;
#pragma unroll
            for (int o = 1; o < 64; o <<= 1) { const float t = __shfl_up(cm, o); if (lane >= o) cm = fmaxf(cm, t); }
            sAq[pos] = a; sCm[pos] = cm; sB[pos] = bsum;
            if (lane == 63) { sB63[ci] = bsum; sC63[ci] = cm; }
        }
        __syncthreads();
        if (tid == 0) { float m = -1e30f; for (int ci = 0; ci < NCHUNK; ++ci) { sMc[ci] = m; m = sB63[ci] + fmaxf(m, sC63[ci]); } }
        __syncthreads();
        for (int pos = tid; pos < RPB; pos += 512) {
            const int ci = pos >> 6; const float m = sMc[ci], M = fmaxf(m, sCm[pos]), M63 = fmaxf(m, sC63[ci]), a = sAq[pos], bsum = sB[pos];
            GT4[pos] = (f32x4){a, M, fexp(m - M), fexp(-(bsum + M))}; GW[pos] = fexp(a - M63); if ((pos & 63) == 0) GD[ci] = fexp(m - M63);
        }
        return;
    }
    const int nw2 = nwv - 32 * 8;
    {
        const float* qg = p.q_gain + l * 128; const float* kg = p.k_gain + l * 128;
        const int j = lane & 31, hw = lane >> 5;
        const bool second = (j >> 3) & 1, colpart = j >= 16;
        float frq[4];
#pragma unroll
        for (int e = 0; e < 4; ++e) frq[e] = __builtin_amdgcn_exp2f(-(float)(4 * (j & 7) + e) * (13.287712379549449f / 32.0f));
        const f32x4 qg4 = *(const f32x4*)(qg + 4 * j), kg4 = *(const f32x4*)(kg + 4 * j);
        for (int row = wv; row < MROWS; row += nw2) {
            const int tt = row % RPB; const bool lat = tt < TL;
            float cs[4], sn[4];
            const float pos = lat ? (float)(colpart ? (tt & 63) : (tt >> 6)) : 0.f;
#pragma unroll
            for (int e = 0; e < 4; ++e) { const float ang = pos * frq[e]; cs[e] = __cosf(ang); sn[e] = __sinf(ang); }
            bf16_t* rb = Y + (size_t)row * NPAD + 4 * j;
            u32x2 raw[5];
#pragma unroll
            for (int it = 0; it < 5; ++it) { const int hh = it * 2 + hw; raw[it] = *(const u32x2*)(rb + (hh < 8 ? C_AQ + hh * 128 : C_AK + (hh - 8) * 128)); }
#pragma unroll
            for (int it = 0; it < 5; ++it) { const int hh = it * 2 + hw;
                float x[4] = {bflo(raw[it].x), bfhi(raw[it].x), bflo(raw[it].y), bfhi(raw[it].y)};
                float ss = x[0] * x[0] + x[1] * x[1] + x[2] * x[2] + x[3] * x[3];
#pragma unroll
                for (int o = 16; o >= 1; o >>= 1) ss += __shfl_xor(ss, o);
                const float rstd = rsqrtf(ss * (1.0f / 128.0f) + EPS);
                const f32x4 gn = hh < 8 ? qg4 : kg4;
                float y[4];
#pragma unroll
                for (int e = 0; e < 4; ++e) { x[e] *= rstd * gn[e]; }
#pragma unroll
                for (int e = 0; e < 4; ++e) { const float pr = __shfl_xor(x[e], 8); y[e] = second ? (x[e] * cs[e] + pr * sn[e]) : (x[e] * cs[e] - pr * sn[e]); }
                u32x2 w; w.x = cvt_pk_bf16(y[0], y[1]); w.y = cvt_pk_bf16(y[2], y[3]);
                *(u32x2*)(rb + (hh < 8 ? C_AQ + hh * 128 : C_AK + (hh - 8) * 128)) = w;
            }
        }
    }
    {
        bf16_t* DMB = (bf16_t*)(p.ws + WS_H);
        const float* cw = p.conv_w + (size_t)l * 3 * BRW;
        const int nth = nw2 * 64, th = wv * 64 + lane;
        for (int task = th; task < MROWS * 128; task += nth) {
            const int row = task >> 7, c8 = (task & 127) * 8;
            const int tt = row % RPB; const bool lat = tt < TL; const int t = lat ? tt : tt - TL, T = lat ? TL : LC;
            const bf16_t* yr = Y + (size_t)row * NPAD;
            u32x4 convw;
            {
                float a0[8], a1[8], a2[8], u[8], g[8];
                unpack8(*(const u32x4*)(yr + C_CU + c8), u); unpack8(*(const u32x4*)(yr + C_CC + c8), g);
#pragma unroll
                for (int i = 0; i < 8; ++i) a1[i] = u[i] * g[i];
                if (t > 0) { unpack8(*(const u32x4*)(yr - NPAD + C_CU + c8), u); unpack8(*(const u32x4*)(yr - NPAD + C_CC + c8), g);
#pragma unroll
                    for (int i = 0; i < 8; ++i) a0[i] = u[i] * g[i]; }
                else {
#pragma unroll
                    for (int i = 0; i < 8; ++i) a0[i] = 0.f; }
                if (t < T - 1) { unpack8(*(const u32x4*)(yr + NPAD + C_CU + c8), u); unpack8(*(const u32x4*)(yr + NPAD + C_CC + c8), g);
#pragma unroll
                    for (int i = 0; i < 8; ++i) a2[i] = u[i] * g[i]; }
                else {
#pragma unroll
                    for (int i = 0; i < 8; ++i) a2[i] = 0.f; }
                float bg[8], z[8], o[8];
                unpack8(*(const u32x4*)(yr + C_CB + c8), bg); unpack8(*(const u32x4*)(yr + C_CZ + c8), z);
#pragma unroll
                for (int i = 0; i < 8; ++i) o[i] = bg[i] * (cw[c8 + i] * a0[i] + cw[BRW + c8 + i] * a1[i] + cw[2 * BRW + c8 + i] * a2[i]) * z[i];
                convw = pack8(o);
            }
            {
                const int g = c8 >> 8, w = 2 << g;
                int lo = t - (w >> 1); if (lo < 0) lo = 0; int hi = t + w - (w >> 1); if (hi > T) hi = T;
                float s[8], u0[8];
#pragma unroll
                for (int i = 0; i < 8; ++i) s[i] = 0.f;
                u32x4 tap[16];
#pragma unroll
                for (int k = 0; k < 16; ++k) { const int q = t - (w >> 1) + k; const bool ok = (k < w) && (q >= 0) && (q < T);
                    tap[k] = ok ? *(const u32x4*)(yr + (long)(q - t) * NPAD + C_PU + c8) : (u32x4){0u, 0u, 0u, 0u}; }
#pragma unroll
                for (int k = 0; k < 16; ++k) { float u[8]; unpack8(tap[k], u);
#pragma unroll
                    for (int i = 0; i < 8; ++i) s[i] += u[i]; }
                unpack8(*(const u32x4*)(yr + C_PU + c8), u0);
                const float inv = 1.0f / (float)(hi - lo);
                float o[8];
#pragma unroll
                for (int i = 0; i < 8; ++i) o[i] = s[i] * inv - u0[i];
                *(u32x4*)(DMB + (size_t)row * BRW + c8) = pack8(o);
                *(u32x4*)(Y + (size_t)row * NPAD + C_CZ + c8) = convw;
            }
        }
    }
}

__device__ __forceinline__ f32x4 mfma16(bf16x8 a, bf16x8 b, f32x4 c) { return __builtin_amdgcn_mfma_f32_16x16x32_bf16(a, b, c, 0, 0, 0); }
__device__ void mlstm_item(const Params& p, int item, unsigned char* smem) {
    const int tid = otid(), wid = tid >> 6, lane = tid & 63, fr = lane & 15, kq = lane >> 4;
    const int ep = item & 3, dir = (item >> 2) & 1, hd = (item >> 3) & 3, b = item >> 5;
    const int sq = (b * 4 + hd) * 2 + dir;
    const bf16_t* Y = (const bf16_t*)(p.ws + WS_Y);
    bf16_t* HM = (bf16_t*)(p.ws + WS_HM) + (size_t)dir * MROWS * BRW;
    const f32x4* GT4 = (const f32x4*)(p.ws + WS_GT4) + (size_t)sq * RPB; const float* GW = (const float*)(p.ws + WS_GW) + (size_t)sq * RPB; const float* GD = (const float*)(p.ws + WS_GD) + sq * 128;
    bf16_t* Ks = (bf16_t*)(smem); bf16_t* KTs = (bf16_t*)(smem + 33792);
    bf16_t* VTs = (bf16_t*)(smem + 70656); bf16_t* VWTs = (bf16_t*)(smem + 82176); bf16_t* CTs = (bf16_t*)(smem + 93696); bf16_t* Ss = (bf16_t*)(smem + 135936);
    float* sA = (float*)(smem + 145152); float* sM = sA + 64; float* sI = sA + 128; float* sE = sA + 192;
    for (int i = tid; i < 80 * 72; i += 512) { VTs[i] = 0; VWTs[i] = 0; }
    for (int i = tid; i < 80 * 264; i += 512) CTs[i] = 0;
    __syncthreads();
    if (tid < 64) VTs[64 * 72 + tid] = 0x3F80;
    f32x4 Cacc[2][5];
#pragma unroll
    for (int a = 0; a < 2; ++a)
#pragma unroll
        for (int c = 0; c < 5; ++c) Cacc[a][c] = (f32x4){0.f, 0.f, 0.f, 0.f};
    const int rg = wid >> 1, ch = wid & 1;
    u32x4 kreg[4], vreg; f32x4 g4; float wv_ = 0.f, wtok = 0.f, decay = 0.f;
    bf16x8 qf[8];
    const int dkp = tid & 127, sg = tid >> 7;
    const int vs = tid & 63, ve8 = (tid >> 6) * 8;
#define ML_LOAD(ci) do { \
        _Pragma("unroll") for (int j = 0; j < 4; ++j) { const int idx = tid + 512 * j, rr = idx >> 5, c8 = (idx & 31) * 8; \
            kreg[j] = *(const u32x4*)(Y + (size_t)seq_row(b, dir, (ci) * 64 + rr) * NPAD + C_MK + hd * 256 + c8); } \
        vreg = *(const u32x4*)(Y + (size_t)seq_row(b, dir, (ci) * 64 + vs) * NPAD + C_MV + hd * 256 + ep * 64 + ve8); wv_ = GW[(ci) * 64 + vs]; \
        g4 = GT4[(ci) * 64 + (tid & 63)]; wtok = GW[(ci) * 64 + (tid & 63)]; \
        decay = GD[(ci)]; } while (0)
#define ML_QLOAD(ci) do { const bf16_t* qrow = Y + (size_t)seq_row(b, dir, (ci) * 64 + 16 * rg + fr) * NPAD + C_MQ + hd * 256 + 8 * kq; \
        _Pragma("unroll") for (int ks = 0; ks < 8; ++ks) qf[ks] = *(const bf16x8*)(qrow + 32 * ks); } while (0)
    ML_LOAD(0); ML_QLOAD(0);
    for (int ci = 0; ci < NCHUNK; ++ci) {
#pragma unroll
        for (int j = 0; j < 4; ++j) { const int idx = tid + 512 * j, rr = idx >> 5, c8 = (idx & 31) * 8; *(u32x4*)(Ks + rr * 264 + c8) = kreg[j]; }
        { float vf[8]; unpack8(vreg, vf); const float ws_ = wv_ * 0.0625f;
#pragma unroll
            for (int i = 0; i < 8; ++i) { VTs[(ve8 + i) * 72 + vs] = f2bf(vf[i]); VWTs[(ve8 + i) * 72 + vs] = f2bf(vf[i] * ws_); } }
        if (tid < 64) { sA[tid] = g4[0]; sM[tid] = g4[1]; sI[tid] = g4[2]; sE[tid] = g4[3]; VWTs[64 * 72 + tid] = f2bf(wtok * 0.0625f); }
        const float dec = decay;
        __syncthreads();
        const int cn = ci + 1 < NCHUNK ? ci + 1 : NCHUNK - 1;
        ML_LOAD(cn);
        {
            const int t = 16 * rg + fr; const float Mt = sM[t];
#pragma unroll
            for (int s2 = 0; s2 < 2; ++s2) { const int st = 2 * ch + s2; f32x4 acc = {0.f, 0.f, 0.f, 0.f};
#pragma unroll
                for (int ks = 0; ks < 8; ++ks) { const bf16x8 kf = *(const bf16x8*)(Ks + (16 * st + fr) * 264 + 32 * ks + 8 * kq); acc = mfma16(kf, qf[ks], acc); }
                float o[4];
#pragma unroll
                for (int i = 0; i < 4; ++i) { const int s = 16 * st + 4 * kq + i; o[i] = (s <= t) ? acc[i] * fexp(sA[s] - Mt) * 0.0625f : 0.f; }
                u32x2 w; w.x = cvt_pk_bf16(o[0], o[1]); w.y = cvt_pk_bf16(o[2], o[3]);
                *(u32x2*)(Ss + t * 72 + 16 * st + 4 * kq) = w; }
        }
#pragma unroll
        for (int j = 0; j < 2; ++j) { const int s0 = 8 * (sg + 4 * j); unsigned kt[8]; u32x4 lo, hi;
#pragma unroll
            for (int jj = 0; jj < 8; ++jj) kt[jj] = *(const unsigned*)(Ks + (s0 + jj) * 264 + 2 * dkp);
            lo.x = (kt[0] & 0xffffu) | (kt[1] << 16); lo.y = (kt[2] & 0xffffu) | (kt[3] << 16); lo.z = (kt[4] & 0xffffu) | (kt[5] << 16); lo.w = (kt[6] & 0xffffu) | (kt[7] << 16);
            hi.x = (kt[0] >> 16) | (kt[1] & 0xffff0000u); hi.y = (kt[2] >> 16) | (kt[3] & 0xffff0000u); hi.z = (kt[4] >> 16) | (kt[5] & 0xffff0000u); hi.w = (kt[6] >> 16) | (kt[7] & 0xffff0000u);
            *(u32x4*)(KTs + (2 * dkp) * 72 + s0) = lo; *(u32x4*)(KTs + (2 * dkp + 1) * 72 + s0) = hi; }
        __syncthreads();
        {
            f32x4 aN0 = {0.f, 0.f, 0.f, 0.f}, aN1 = aN0, aD = aN0;
#pragma unroll
            for (int ks = 0; ks < 8; ++ks) { const bf16x8 c0 = *(const bf16x8*)(CTs + (32 * ch + fr) * 264 + 32 * ks + 8 * kq), c1 = *(const bf16x8*)(CTs + (32 * ch + 16 + fr) * 264 + 32 * ks + 8 * kq),
                                                     c2 = *(const bf16x8*)(CTs + (64 + fr) * 264 + 32 * ks + 8 * kq);
                aN0 = mfma16(qf[ks], c0, aN0); aN1 = mfma16(qf[ks], c1, aN1); aD = mfma16(qf[ks], c2, aD); }
            ML_QLOAD(cn);
            float it4[4], en4[4];
#pragma unroll
            for (int i = 0; i < 4; ++i) { it4[i] = sI[16 * rg + 4 * kq + i]; en4[i] = sE[16 * rg + 4 * kq + i]; aN0[i] *= it4[i]; aN1[i] *= it4[i]; aD[i] *= it4[i]; }
#pragma unroll
            for (int ks = 0; ks < 2; ++ks) { const bf16x8 sf = *(const bf16x8*)(Ss + (16 * rg + fr) * 72 + 32 * ks + 8 * kq);
                const bf16x8 v0 = *(const bf16x8*)(VTs + (32 * ch + fr) * 72 + 32 * ks + 8 * kq), v1 = *(const bf16x8*)(VTs + (32 * ch + 16 + fr) * 72 + 32 * ks + 8 * kq), v2 = *(const bf16x8*)(VTs + (64 + fr) * 72 + 32 * ks + 8 * kq);
                aN0 = mfma16(sf, v0, aN0); aN1 = mfma16(sf, v1, aN1); aD = mfma16(sf, v2, aD); }
#pragma unroll
            for (int i = 0; i < 4; ++i) { const float den = __shfl(aD[i], lane & 48); const float rd = 1.0f / fmaxf(fabsf(den), en4[i]);
                const int row = seq_row(b, dir, ci * 64 + 16 * rg + 4 * kq + i);
                bf16_t* hp = HM + (size_t)row * BRW + hd * 256 + ep * 64 + 32 * ch + fr;
                hp[0] = f2bf(aN0[i] * rd); hp[16] = f2bf(aN1[i] * rd); }
        }
#pragma unroll
        for (int rt = 0; rt < 2; ++rt)
#pragma unroll
            for (int ct = 0; ct < 5; ++ct) { f32x4 cacc = Cacc[rt][ct] * dec;
#pragma unroll
                for (int ks = 0; ks < 2; ++ks) { const bf16x8 af = *(const bf16x8*)(KTs + (32 * wid + 16 * rt + fr) * 72 + 32 * ks + 8 * kq), bv = *(const bf16x8*)(VWTs + (16 * ct + fr) * 72 + 32 * ks + 8 * kq);
                    cacc = mfma16(af, bv, cacc); }
                Cacc[rt][ct] = cacc; }
        __syncthreads();
#pragma unroll
        for (int rt = 0; rt < 2; ++rt)
#pragma unroll
            for (int ct = 0; ct < 5; ++ct) { u32x2 w; w.x = cvt_pk_bf16(Cacc[rt][ct][0], Cacc[rt][ct][1]); w.y = cvt_pk_bf16(Cacc[rt][ct][2], Cacc[rt][ct][3]);
                *(u32x2*)(CTs + (16 * ct + fr) * 264 + 32 * wid + 16 * rt + 4 * kq) = w; }
    }
#undef ML_LOAD
#undef ML_QLOAD
    __syncthreads();
}

__device__ void phase_mix2(const Params& p, int l, unsigned char* smem) {
    bf16_t* Y = (bf16_t*)(p.ws + WS_Y);
#ifndef NO_MLSTM
    if ((int)blockIdx.x < 128) mlstm_item(p, blockIdx.x, smem);
#endif
#ifndef NO_ATT
    const int natt = 512 + (l == 0 ? 32 : 0);
    unsigned* ctr = (unsigned*)(p.ws + WS_BAR + 14336) + l * 64;
    volatile unsigned* sidx = (volatile unsigned*)(smem + LDS_BYTES - 32);
    for (;;) {
        __syncthreads();
        if (threadIdx.x == 0) *sidx = atomicAdd(ctr, 1u);
        __syncthreads();
        const int it = __builtin_amdgcn_readfirstlane((int)*sidx);
        if (it >= natt) break;
        int b, head, qrow, krow, seq;
        if (it < 512) { const int qb = it & 15; head = (it >> 4) & 7; b = it >> 7; qrow = b * RPB + qb * 256; krow = b * RPB; seq = RPB; }
        else { const int i2 = it - 512; head = i2 & 7; b = i2 >> 3; qrow = b * RPB + TL; krow = qrow; seq = LC; }
        const int kvh = head >> 2;
        bf16_t* rowq = Y + (size_t)qrow * NPAD; const bf16_t* rowk = Y + (size_t)krow * NPAD;
        att::attn_dense_body(rowq + C_AQ + head * 128, rowk + C_AK + kvh * 128, rowk + C_AV + kvh * 128, rowq + C_AZ + head * 128, seq, (char*)smem);
    }
#endif
    __syncthreads();
#ifndef NO_POOLG
    { SchedPool S; S.A = (const char*)(p.ws + WS_H); S.Bt = (const char*)(p.ws + WS_POOLW) + (size_t)l * 4 * 256 * 256 * 2; S.G = gridDim.x; S.c = blockIdx.x; S.i0 = 0;
      EpiPool E; E.Y = Y;
      pg8::Gemm g; g.lda = BRW; g.ldb = 256; { int kk = 256; asm volatile("" : "+s"(kk)); g.K = kk; }
      pg8::gemm_phase(( LAS unsigned char*)smem, g, S, E); }
#endif
    __syncthreads();
}

__device__ void phase_mix3(const Params& p, int l) {
    const int tid = otid(), lane = tid & 63, wv = obid() * 8 + (tid >> 6), nwv = gridDim.x * 8;
    bf16_t* Y = (bf16_t*)(p.ws + WS_Y);
    const bf16_t* HM0 = (const bf16_t*)(p.ws + WS_HM); const bf16_t* HM1 = HM0 + (size_t)MROWS * BRW;
    const float* gain = p.m_gain + l * BRW;
    for (int row = wv; row < MROWS; row += nwv) {
        f32x4 v[4]; u32x2 ow[4], zw[4];
#pragma unroll
        for (int hd = 0; hd < 4; ++hd) { const size_t off = (size_t)row * BRW + hd * 256 + 4 * lane;
            { const u32x2 h0 = *(const u32x2*)(HM0 + off), h1 = *(const u32x2*)(HM1 + off);
              v[hd] = (f32x4){bflo(h0.x) + bflo(h1.x), bfhi(h0.x) + bfhi(h1.x), bflo(h0.y) + bflo(h1.y), bfhi(h0.y) + bfhi(h1.y)}; }
            ow[hd] = *(const u32x2*)(Y + (size_t)row * NPAD + C_MO + hd * 256 + 4 * lane); zw[hd] = *(const u32x2*)(Y + (size_t)row * NPAD + C_MZ + hd * 256 + 4 * lane); }
#pragma unroll
        for (int hd = 0; hd < 4; ++hd) {
            float ss = v[hd][0] * v[hd][0] + v[hd][1] * v[hd][1] + v[hd][2] * v[hd][2] + v[hd][3] * v[hd][3];
#pragma unroll
            for (int o = 32; o >= 1; o >>= 1) ss += __shfl_xor(ss, o);
            const float rstd = rsqrtf(ss * (1.0f / 256.0f) + EPS);
            const f32x4 g = *(const f32x4*)(gain + hd * 256 + 4 * lane);
            const float o0 = bflo(ow[hd].x), o1 = bfhi(ow[hd].x), o2 = bflo(ow[hd].y), o3 = bfhi(ow[hd].y), z0 = bflo(zw[hd].x), z1 = bfhi(zw[hd].x), z2 = bflo(zw[hd].y), z3 = bfhi(zw[hd].y);
            u32x2 w; w.x = cvt_pk_bf16(v[hd][0] * rstd * g[0] * o0 * z0, v[hd][1] * rstd * g[1] * o1 * z1); w.y = cvt_pk_bf16(v[hd][2] * rstd * g[2] * o2 * z2, v[hd][3] * rstd * g[3] * o3 * z3);
            *(u32x2*)(Y + (size_t)row * NPAD + C_MO + hd * 256 + 4 * lane) = w;
        }
    }
}

#define XB_TMO      128
#define XB_XCNT(j)  (256  + 64 * (j))
#define XB_XSUB(j)  (1280 + 64 * (j))
#define XB_XGEN(j)  (2304 + 64 * (j))
#define XB_TOP      3328
#define XB_TOPGEN   3392
#define XCD_BAR_WORDS 3456
#define XB_SPIN_CAP (1u << 18)
__device__ __forceinline__ unsigned xb_ld(unsigned* p)              { return __hip_atomic_load(p, __ATOMIC_RELAXED, __HIP_MEMORY_SCOPE_AGENT); }
__device__ __forceinline__ unsigned xb_add(unsigned* p, unsigned v) { return __hip_atomic_fetch_add(p, v, __ATOMIC_RELAXED, __HIP_MEMORY_SCOPE_AGENT); }
__device__ __forceinline__ unsigned xb_xcc_id() { return (unsigned)__builtin_amdgcn_s_getreg((3 << 11) | 20) & 0xFu; }
#define XB_SPIN(cond, bar) do { unsigned _sp = 0; while (cond) { __builtin_amdgcn_s_sleep(1); \
    if ((++_sp & 255u) == 0u) { if (xb_ld(&(bar)[XB_TMO])) break; if (_sp > XB_SPIN_CAP) { atomicAdd(&(bar)[XB_TMO], 1u); break; } } } } while (0)
struct XcdBarrier { unsigned* bar; unsigned x; volatile LAS unsigned* st; };
__device__ __forceinline__ XcdBarrier xcd_barrier_post(unsigned* bar, volatile LAS unsigned* st) {
    XcdBarrier b; b.bar = bar; b.x = xb_xcc_id(); b.st = st;
    if (threadIdx.x == 0) (void)xb_add(&bar[XB_XCNT(b.x)], 1u);
    return b;
}
__device__ __forceinline__ void xcd_barrier_complete(unsigned* bar, unsigned x, unsigned& nloc, unsigned& nx) {
    const unsigned G = gridDim.x * gridDim.y * gridDim.z;
    unsigned sum, cnt, mine, sp = 0u;
    for (;;) {
        sum = 0u; cnt = 0u; mine = 0u;
#pragma unroll
        for (unsigned j = 0; j < 16; ++j) { const unsigned c = xb_ld(&bar[XB_XCNT(j)]); sum += c; cnt += (c > 0u) ? 1u : 0u; mine = (j == x) ? c : mine; }
        if (sum == G) break;
        __builtin_amdgcn_s_sleep(1);
        if ((++sp & 255u) == 0u) { if (xb_ld(&bar[XB_TMO])) break; if (sp > XB_SPIN_CAP) { atomicAdd(&bar[XB_TMO], 1u); break; } }
    }
    nloc = mine > 0u ? mine : 1u; nx = cnt > 0u ? cnt : 1u;
}
__device__ __forceinline__ void xcd_barrier(const XcdBarrier& b) {
    asm volatile("s_waitcnt vmcnt(0)" ::: "memory");
    __syncthreads();
    if (threadIdx.x == 0) {
        unsigned* bar = b.bar;
        __builtin_amdgcn_s_waitcnt(0);
        unsigned nloc = b.st[0], nx = b.st[1];
        if (nloc == 0u) { xcd_barrier_complete(bar, b.x, nloc, nx); b.st[0] = nloc; b.st[1] = nx; }
        const unsigned old = xb_add(&bar[XB_XSUB(b.x)], 1u);
        const unsigned gen = old / nloc;
        if (old + 1u == (gen + 1u) * nloc) {
            __builtin_amdgcn_fence(__ATOMIC_RELEASE, "agent");
            asm volatile("s_waitcnt vmcnt(0)" ::: "memory");
            const unsigned og = xb_add(&bar[XB_TOP], 1u);
            const unsigned tg = og / nx;
            if (og + 1u == (tg + 1u) * nx) xb_add(&bar[XB_TOPGEN], 1u);
            else XB_SPIN(xb_ld(&bar[XB_TOPGEN]) == tg, bar);
            __builtin_amdgcn_fence(__ATOMIC_ACQUIRE, "agent");
            xb_add(&bar[XB_XGEN(b.x)], 1u);
            asm volatile("s_waitcnt vmcnt(0)" ::: "memory");
        } else {
            XB_SPIN(xb_ld(&bar[XB_XGEN(b.x)]) == gen, bar);
            __builtin_amdgcn_fence(__ATOMIC_ACQUIRE, "agent");
            asm volatile("s_waitcnt vmcnt(0)" ::: "memory");
        }
    }
    __syncthreads();
}

constexpr int NPHASE = 16;
__device__ void run_phase(const Params& p, int ph, unsigned char* smem, bool dost = true) {
#ifndef NO_PREP
    if (ph == 0) { phase_prep(p, smem); return; }
#endif
#ifndef NO_FINAL
    if (ph == NPHASE - 1) { phase_final(p); return; }
#endif
    const int l = (ph - 1) / 7, s = (ph - 1) % 7;
    bf16_t* Y = (bf16_t*)(p.ws + WS_Y);
    switch (s) {
#ifndef NO_NORM
    case 0: phase_norm(p, l); break;
#endif
#ifndef NO_GIN
    case 1: { SchedIn S; S.A = (const char*)(p.ws + WS_H); S.Bt = (const char*)(p.ws + WS_WIN) + (size_t)l * NPAD * DM * 2; S.G = gridDim.x; S.c = blockIdx.x; S.trim = (l == 1);
              EpiIn E; E.Y = Y; E.G32 = (float*)(p.ws + WS_G32); E.dost = dost;
              pg8::Gemm g; g.lda = DM; g.ldb = DM; g.K = DM;
              pg8::gemm_phase((LAS unsigned char*)smem, g, S, E); } break;
#endif
#ifndef NO_MIX1
    case 2: phase_mix1(p, l, smem); break;
#endif
#ifndef NO_MIX2
    case 3: phase_mix2(p, l, smem); break;
#endif
#ifndef NO_MIX3
    case 4: phase_mix3(p, l); break;
#endif
#ifndef NO_MERGE
    case 5: { SchedMerge S; S.Y = (const char*)Y; S.Wbr = (const char*)(p.ws + WS_WBR) + (size_t)l * 4 * DM * BRW * 2; S.G = gridDim.x; S.c = blockIdx.x; S.nM = l == 0 ? 68 : 64;
              EpiMerge E; E.Y = Y; E.accb = (bf16_t*)(p.ws + WS_H);
              pg8::Gemm g; g.lda = NPAD; g.ldb = BRW; g.K = BRW;
              pg8::gemm_phase((LAS unsigned char*)smem, g, S, E);
              if (l == 0 && (int)blockIdx.x >= 32) { __syncthreads(); for (int u = blockIdx.x - 32; u < U_CONV1; u += gridDim.x - 32) conv_unit(p, 1, u, smem); } } break;
#endif
#ifndef NO_OUT
    case 6: { SchedOut S; S.A = (const char*)(p.ws + WS_H); S.Bt = (const char*)(p.ws + WS_WOUT) + (size_t)l * DM * DM * 2; S.G = gridDim.x; S.c = blockIdx.x; S.nM = l == 0 ? 68 : 64;
              EpiOut E; E.xin = p.x; E.ctxin = p.ctx; E.mod = (const float*)(p.ws + WS_MOD) + (size_t)l * 5 * 6144; E.X1 = (bf16_t*)(p.ws + WS_X1); E.first = (l == 0);
              pg8::Gemm g; g.lda = DM; g.ldb = DM; g.K = DM;
              pg8::gemm_phase((LAS unsigned char*)smem, g, S, E); } break;
#endif
    }
}

__global__ void __launch_bounds__(512, 2) hybrid_fwd(Params p) {
    extern __shared__ __attribute__((aligned(16))) unsigned char smem[];
    volatile LAS unsigned* st = (volatile LAS unsigned*)((LAS unsigned char*)smem + (LDS_BYTES - 16));
    if (threadIdx.x == 0) { st[0] = 0u; st[1] = 0u; }
    __syncthreads();
    const XcdBarrier xbar = xcd_barrier_post((unsigned*)(p.ws + WS_BAR), st);
    for (int ph = p.ph_lo; ph < p.ph_hi; ++ph) {
        int reps = 1;
#ifdef PROBE_REP_MASK
        if (ph > 0 && ph < NPHASE - 1 && ((PROBE_REP_MASK >> ((ph - 1) % 7)) & 1)) reps = 2;
        if (ph == 0 && (PROBE_REP_MASK & 128)) reps = 2;
#endif
        for (int r = 0; r < reps; ++r) { run_phase(p, ph, smem, r + 1 == reps || p.ph_hi > 1000); if (r + 1 < reps) xcd_barrier(xbar); }
        if (ph + 1 < p.ph_hi) { if (p.ph_hi > NPHASE) cg::this_grid().sync(); else xcd_barrier(xbar); }
#ifdef PROBE_EXTRA_SYNC
        if (ph + 1 < p.ph_hi) { for (int q = 0; q < PROBE_EXTRA_SYNC; ++q) cg::this_grid().sync(); }
#endif
    }
}


#ifdef DBG_STOP
__global__ void dbg_dump(Params p) {
    const bf16_t* Y = (const bf16_t*)(p.ws + WS_Y); const float* HM = (const float*)(p.ws + WS_HM); const bf16_t* H = (const bf16_t*)(p.ws + WS_H);
    for (size_t i = (size_t)blockIdx.x * blockDim.x + threadIdx.x; i < (size_t)NB * TL * DM; i += (size_t)gridDim.x * blockDim.x) {
        const size_t row = i / DM; const int c = (int)(i % DM);
        float s = 0.f;
#if DBG_WHAT & 1
        for (int j = 0; j < 11; ++j) { const int col = c + 2048 * j; if (col < 22016) s += bf2f(Y[row * NPAD + col]); }
#endif
#if DBG_WHAT & 2
        { const size_t k = i % ((size_t)MROWS * BRW); s += HM[k] + HM[k + (size_t)MROWS * BRW]; }
#endif
#if DBG_WHAT & 4
        s += bf2f(H[i]);
#endif
        p.out[i] = s;
    }
}
#endif
extern "C" void kernel_launch(void* const* d_in, const int* in_sizes, int n_in, void* d_out, int out_size, void* d_ws, size_t ws_size, hipStream_t stream) {
    static int grid = 0;
    if (grid == 0) {
        if (n_in != 18 || ws_size < WS_END) { fprintf(stderr, "kernel_launch: n_in %d ws %zu (need %zu)\n", n_in, ws_size, (size_t)WS_END); grid = -1; return; }
        if (hipFuncSetAttribute((const void*)hybrid_fwd, hipFuncAttributeMaxDynamicSharedMemorySize, LDS_BYTES) != hipSuccess) { fprintf(stderr, "kernel_launch: hipFuncSetAttribute failed\n"); grid = -1; return; }
        int dev = 0, cus = 0, per_cu = 0;
        hipGetDevice(&dev); hipDeviceGetAttribute(&cus, hipDeviceAttributeMultiprocessorCount, dev);
        hipOccupancyMaxActiveBlocksPerMultiprocessor(&per_cu, (const void*)hybrid_fwd, 512, LDS_BYTES);
        if (per_cu < 1) { fprintf(stderr, "kernel_launch: occupancy query says %d blocks per CU\n", per_cu); per_cu = 1; }
        (void)hipGetLastError();
        grid = cus;
    }
    if (grid < 0) return;
    Params p{};
    p.x = (const float*)d_in[0]; p.c = (const float*)d_in[1]; p.ctx = (const float*)d_in[2]; p.c_ctx = (const float*)d_in[3]; p.norm_gain = (const float*)d_in[4];
    p.w_mod = (const float*)d_in[5]; p.b_mod = (const float*)d_in[6]; p.w_in = (const float*)d_in[7]; p.q_gain = (const float*)d_in[8]; p.k_gain = (const float*)d_in[9];
    p.gate_bias = (const float*)d_in[10]; p.m_gain = (const float*)d_in[11]; p.conv_w = (const float*)d_in[12]; p.pool_w = (const float*)d_in[13]; p.pool_scale = (const float*)d_in[14];
    p.w_branch = (const float*)d_in[15]; p.w_out = (const float*)d_in[16]; p.final_gain = (const float*)d_in[17];
    p.out = (float*)d_out; p.ws = (unsigned char*)d_ws;
#ifdef DBG_STOP
    for (int ph = 0; ph < DBG_STOP; ++ph) { p.ph_lo = ph; p.ph_hi = ph + 1; hipLaunchKernelGGL(hybrid_fwd, dim3(grid), dim3(512), LDS_BYTES, stream, p); }
    hipLaunchKernelGGL(dbg_dump, dim3(2048), dim3(256), 0, stream, p);
#elif MK_PER_PHASE
    for (int ph = 0; ph < NPHASE; ++ph) {
        p.ph_lo = ph; p.ph_hi = ph + 1;
        hipLaunchKernelGGL(hybrid_fwd, dim3(grid), dim3(512), LDS_BYTES, stream, p);
    }
#else
    p.ph_lo = 0; p.ph_hi = NPHASE;
    if (hipMemsetAsync((char*)d_ws + WS_BAR, 0, 16384, stream) != hipSuccess) { fprintf(stderr, "kernel_launch: memset of barrier words failed\n"); return; }
    void* args[] = {&p};
    hipError_t e = hipLaunchCooperativeKernel((const void*)hybrid_fwd, dim3(grid), dim3(512), args, LDS_BYTES, stream);
    if (e != hipSuccess) fprintf(stderr, "cooperative launch failed: %s (grid %d)\n", hipGetErrorString(e), grid);
#endif
}
```

```cpp
#include <hip/hip_runtime.h>
#include <hip/hip_cooperative_groups.h>
#include <cstdio>
#include <cstdint>
namespace cg = cooperative_groups;

#ifndef MK_PER_PHASE
#define MK_PER_PHASE 0
#endif

#define LAS __attribute__((address_space(3)))
typedef unsigned short bf16_t;
typedef short bf16x8 __attribute__((ext_vector_type(8)));
typedef short s16x4 __attribute__((ext_vector_type(4)));
typedef float f32x4 __attribute__((ext_vector_type(4)));
typedef float f32x8 __attribute__((ext_vector_type(8)));
typedef float f32x16 __attribute__((ext_vector_type(16)));
typedef unsigned u32x4 __attribute__((ext_vector_type(4)));
typedef unsigned u32x2 __attribute__((ext_vector_type(2)));

constexpr int DM = 2048, NB = 4, TL = 4096, LC = 256, RPB = TL + LC  , MROWS = NB * RPB  ;
constexpr int NIN = 22032, NPAD = 22272, BRW = 1024;
constexpr int C_AQ = 0, C_AK = 1024, C_AV = 1280, C_AZ = 1536, C_MQ = 2560, C_MK = 3584, C_MV = 4608, C_MO = 5632, C_MZ = 6656,
              C_CU = 7680, C_CB = 8704, C_CC = 9728, C_CZ = 10752, C_PU = 11776, C_PZ = 12800, C_GM = 13824, C_MG = 22016;
constexpr int NCHUNK = RPB / 64;
constexpr float EPS = 1e-6f;

constexpr size_t WS_WIN = 0;
constexpr size_t WS_WBR = WS_WIN + (size_t)2 * NPAD * DM * 2;
constexpr size_t WS_WOUT = WS_WBR + (size_t)2 * 4 * DM * BRW * 2;
constexpr size_t WS_POOLW = WS_WOUT + (size_t)2 * DM * DM * 2;
constexpr size_t WS_MOD = WS_POOLW + (size_t)2 * 4 * 256 * 256 * 2;
constexpr size_t WS_H = WS_MOD + (size_t)2 * 5 * 6144 * 4;
constexpr size_t WS_Y = WS_H + (size_t)MROWS * DM * 2;
constexpr size_t WS_X1 = WS_Y + (size_t)MROWS * NPAD * 2;
constexpr size_t WS_H8 = WS_X1 + (size_t)MROWS * DM * 2;
constexpr size_t WS_HM = WS_X1 + (size_t)MROWS * DM * 4;
static_assert(WS_H8 + (size_t)MROWS * DM <= WS_HM, "the fp8 copy of h must fit in the free half of the X1 slot");
constexpr size_t WS_G32 = WS_HM + (size_t)2 * MROWS * BRW * 4;
constexpr size_t WS_GT4 = WS_G32 + (size_t)MROWS * 16 * 4;
constexpr size_t WS_GW = WS_GT4 + (size_t)32 * RPB * 16;
constexpr size_t WS_GD = WS_GW + (size_t)32 * RPB * 4;
constexpr size_t WS_BAR = WS_GD + (size_t)32 * 128 * 4;
constexpr int NT8 = 42;
constexpr size_t WS_W8 = WS_BAR + 16384;
constexpr size_t WS_K8 = WS_W8 + (size_t)2 * NT8 * 256 * DM;
constexpr size_t WS_V8 = WS_K8 + (size_t)MROWS * 256;
constexpr size_t WS_END = WS_V8 + (size_t)MROWS * 256;
__host__ __device__ __forceinline__ constexpr int pn_of_q8(int q) { return q < 6 ? q : (q < 10 ? 18 + (q - 6) : 54 + (q - 10)); }
__host__ __device__ __forceinline__ constexpr int pn_of_p16(int p) { return p < 12 ? 6 + p : (p < 44 ? 22 + (p - 12) : 86); }

constexpr int LDS_BYTES = 155648;

struct Params {
    const float* x; const float* c; const float* ctx; const float* c_ctx; const float* norm_gain; const float* w_mod; const float* b_mod; const float* w_in;
    const float* q_gain; const float* k_gain; const float* gate_bias; const float* m_gain; const float* conv_w; const float* pool_w; const float* pool_scale;
    const float* w_branch; const float* w_out; const float* final_gain;
    float* out; unsigned char* ws;
    int ph_lo, ph_hi;
};

__device__ __forceinline__ int otid() { int t = threadIdx.x; asm volatile("" : "+v"(t)); return t; }
__device__ __forceinline__ int obid() { int t = blockIdx.x; asm volatile("" : "+s"(t)); return t; }
typedef __bf16 bf16x2_t __attribute__((ext_vector_type(2)));
typedef float f32x2_t __attribute__((ext_vector_type(2)));
__device__ __forceinline__ unsigned cvt_pk_bf16(float lo, float hi) { f32x2_t v = {lo, hi}; bf16x2_t r = __builtin_convertvector(v, bf16x2_t); return *reinterpret_cast<unsigned*>(&r); }
__device__ __forceinline__ bf16_t f2bf(float f) { return (bf16_t)(cvt_pk_bf16(f, 0.f) & 0xffffu); }
__device__ __forceinline__ float bf2f(bf16_t b) { return __uint_as_float(((unsigned)b) << 16); }
__device__ __forceinline__ float bflo(unsigned w) { return __uint_as_float(w << 16); }
__device__ __forceinline__ float bfhi(unsigned w) { return __uint_as_float(w & 0xffff0000u); }
__device__ __forceinline__ float sigmoidf_(float x) { return __builtin_amdgcn_rcpf(1.0f + __builtin_amdgcn_exp2f(-1.4426950408889634f * x)); }
__device__ __forceinline__ float siluf_(float x) { return x * sigmoidf_(x); }
__device__ __forceinline__ float fexp(float x) { return __builtin_amdgcn_exp2f(1.4426950408889634f * x); }
__device__ __forceinline__ void unpack8(const u32x4 w, float (&f)[8]) { f[0] = bflo(w.x); f[1] = bfhi(w.x); f[2] = bflo(w.y); f[3] = bfhi(w.y); f[4] = bflo(w.z); f[5] = bfhi(w.z); f[6] = bflo(w.w); f[7] = bfhi(w.w); }
__device__ __forceinline__ u32x4 pack8(const float (&f)[8]) { u32x4 w; w.x = cvt_pk_bf16(f[0], f[1]); w.y = cvt_pk_bf16(f[2], f[3]); w.z = cvt_pk_bf16(f[4], f[5]); w.w = cvt_pk_bf16(f[6], f[7]); return w; }

namespace pg8 {
constexpr int BM = 256, BK = 64, HALF = 128, HTB = HALF * BK * 2, STAGE_BYTES = 8 * HTB, NXCD = 8, WGM = 8;
__host__ __device__ __forceinline__ int lds_byte(int r, int c) { const int st = (r >> 4) * 2 + (c >> 5), rr = r & 15, cc = c & 31, ob = rr * 64 + cc * 2; return st * 1024 + (ob ^ (((ob >> 9) & 1) << 5)); }
__host__ __device__ __forceinline__ void stage_rc(int b, int& R, int& C) { const int st = b / 1024, sb = b % 1024, swz = sb ^ (((sb >> 9) & 1) << 5); R = (st >> 1) * 16 + swz / 64; C = (st & 1) * 32 + (swz % 64) / 2; }
__host__ __device__ __forceinline__ int perm32(int rho) { const int n = rho >> 4, i = rho & 15; return 8 * (i >> 2) + 4 * n + (i & 3); }

struct Unit { const char* a; const char* b; int pm, pn, tag; };
struct Gemm { int lda, ldb, K; };

__device__ __forceinline__ bool static_tile(int nM, int nN, long L, int& pm, int& pn) {
    const int nwg = nM * nN; if (L >= nwg) return false;
    int wgid = (int)L; { const int q = nwg / NXCD, r = nwg % NXCD, xcd = wgid % NXCD, off = wgid / NXCD; wgid = (xcd < r ? xcd * (q + 1) : r * (q + 1) + (xcd - r) * q) + off; }
    const int nig = WGM * nN, gid = wgid / nig, fm = gid * WGM, gsz = (nM - fm) < WGM ? (nM - fm) : WGM;
    pm = fm + ((wgid % nig) % gsz); pn = (wgid % nig) / gsz; return true;
}

typedef int v4i_t __attribute__((ext_vector_type(4)));
typedef int v8i_t __attribute__((ext_vector_type(8)));
template <bool F8> struct Frag;
template <> struct Frag<false> { bf16x8 h[2]; __device__ __forceinline__ void set(int k, bf16x8 x) { h[k] = x; } };
template <> struct Frag<true>  { v8i_t v;     __device__ __forceinline__ void set(int k, bf16x8 x) { const v4i_t q = __builtin_bit_cast(v4i_t, x); if (k == 0) v.lo = q; else v.hi = q; } };
template <class Epi, class Sched, bool FP8 = false>
__device__ __forceinline__ void gemm_phase(LAS unsigned char* lds, const Gemm g, const Sched& S, const Epi& E) {
    const int tid = otid(), wid = __builtin_amdgcn_readfirstlane(tid >> 6), lane = tid & 63, wr = wid >> 2, wc = wid & 3, fr = lane & 15, fq = lane >> 4;
    const int K = g.K, nt = K / BK;
    unsigned voffA[2], voffB[2];
#pragma unroll
    for (int i = 0; i < 2; ++i) { int R, C; stage_rc(tid * 16 + i * 8192, R, C); const int Rb = Epi::PERM ? ((R & ~31) + perm32(R & 31)) : R;
        voffA[i] = (unsigned)(R * g.lda + C) * 2u; voffB[i] = (unsigned)(Rb * g.ldb + C) * 2u; }
    const size_t kstep = (size_t)(BK * 2);
    const size_t hstepA = (size_t)HALF * g.lda * 2, hstepB = (size_t)HALF * g.ldb * 2;
    const unsigned ldsw = (unsigned)wid * 1024u;
    const int aoff = lds_byte(wr * 64 + fr, fq * 8), boff = lds_byte(wc * 32 + fr, fq * 8);
#define PG8_SA(b, h) (((b) * 2 + (h)) * HTB)
#define PG8_SB(b, h) ((4 + (b) * 2 + (h)) * HTB)
#define PG8_STAGE(bufoff, gbase, voff) do { _Pragma("unroll") for (int _i = 0; _i < 2; ++_i) \
        __builtin_amdgcn_global_load_lds((const unsigned*)((const char*)(gbase) + (voff)[_i]), (LAS unsigned*)(lds + (bufoff) + ldsw + _i * 8192), 16, 0, 0); } while (0)
#define PG8_LDA(dst, b, h) do { _Pragma("unroll") for (int m = 0; m < 4; ++m) _Pragma("unroll") for (int k = 0; k < 2; ++k) dst[m].set(k, *(const LAS bf16x8*)(lds + PG8_SA(b, h) + aoff + m * 2048 + k * 1024)); } while (0)
#define PG8_LDB(dst, b, h) do { _Pragma("unroll") for (int n = 0; n < 2; ++n) _Pragma("unroll") for (int k = 0; k < 2; ++k) dst[n].set(k, *(const LAS bf16x8*)(lds + PG8_SB(b, h) + boff + n * 2048 + k * 1024)); } while (0)
#define PG8_MMA(ai, bj, At, Bt) do { __builtin_amdgcn_s_setprio(1); _Pragma("unroll") for (int m = 0; m < 4; ++m) _Pragma("unroll") for (int n = 0; n < 2; ++n) { \
        if constexpr (FP8)   \
            asm volatile("v_mfma_f32_16x16x128_f8f6f4 %0, %1, %2, %0" : "+v"(acc[ai][bj][m][n]) : "v"(Bt[n].v), "v"(At[m].v));   \
        else { _Pragma("unroll") for (int k = 0; k < 2; ++k) acc[ai][bj][m][n] = __builtin_amdgcn_mfma_f32_16x16x32_bf16(Bt[n].h[k], At[m].h[k], acc[ai][bj][m][n], 0, 0, 0); } } \
        __builtin_amdgcn_s_setprio(0); } while (0)
#define PG8_WAIT_V(n) asm volatile("s_waitcnt vmcnt(" #n ")" ::: "memory")
#define PG8_WAIT_L(n) asm volatile("s_waitcnt lgkmcnt(" #n ")" ::: "memory")
#define PG8_BAR __builtin_amdgcn_s_barrier()
#define PG8_SCHED __builtin_amdgcn_sched_barrier(0)
    Unit cur, nxt; int ui = 0;
    if (!S.next(0, cur)) return;
    f32x4 acc[2][2][4][2];
#pragma unroll
    for (int a = 0; a < 2; ++a)
#pragma unroll
        for (int b = 0; b < 2; ++b)
#pragma unroll
            for (int m = 0; m < 4; ++m)
#pragma unroll
                for (int n = 0; n < 2; ++n) acc[a][b][m][n] = (f32x4){0.f, 0.f, 0.f, 0.f};
    Frag<FP8> At[4], B0[2], B1[2];
    const char* cA = cur.a; const char* cB = cur.b;
    PG8_STAGE(PG8_SB(0, 0), cB, voffB); PG8_STAGE(PG8_SA(0, 0), cA, voffA); PG8_STAGE(PG8_SB(0, 1), cB + hstepB, voffB); PG8_STAGE(PG8_SA(0, 1), cA + hstepA, voffA);
    if (wr == 1) PG8_BAR;
    PG8_WAIT_V(4); PG8_BAR;
    PG8_STAGE(PG8_SB(1, 0), cB + kstep, voffB); PG8_STAGE(PG8_SA(1, 0), cA + kstep, voffA); PG8_STAGE(PG8_SB(1, 1), cB + hstepB + kstep, voffB);
    PG8_WAIT_V(6); PG8_BAR;
    for (;;) {
        const bool has_next = S.next(ui + 1, nxt);
        const char* nA = has_next ? nxt.a : cA; const char* nB = has_next ? nxt.b : cB;
        for (int t = 0; t < nt; t += 2) {
            const bool last = (t == nt - 2);
            const char* a1 = cA + (size_t)(t + 1) * kstep;
            const char* a2 = last ? nA : cA + (size_t)(t + 2) * kstep; const char* b2 = last ? nB : cB + (size_t)(t + 2) * kstep;
            const char* a3 = a2 + kstep; const char* b3 = b2 + kstep;
            PG8_LDB(B0, 0, 0); PG8_SCHED; PG8_LDA(At, 0, 0); PG8_STAGE(PG8_SA(1, 1), a1 + hstepA, voffA);
            PG8_WAIT_L(8); PG8_BAR; PG8_WAIT_L(0); PG8_MMA(0, 0, At, B0); PG8_BAR; PG8_SCHED;
            PG8_LDB(B1, 0, 1); PG8_STAGE(PG8_SB(0, 0), b2, voffB);
            PG8_BAR; PG8_WAIT_L(0); PG8_MMA(0, 1, At, B1); PG8_BAR;
            PG8_LDA(At, 0, 1); PG8_STAGE(PG8_SA(0, 0), a2, voffA);
            PG8_BAR; PG8_WAIT_L(0); PG8_MMA(1, 0, At, B0); PG8_BAR; PG8_SCHED;
            PG8_STAGE(PG8_SB(0, 1), b2 + hstepB, voffB);
            PG8_WAIT_V(6); PG8_BAR; PG8_MMA(1, 1, At, B1); PG8_BAR;
            PG8_LDB(B0, 1, 0); PG8_SCHED; PG8_LDA(At, 1, 0); PG8_STAGE(PG8_SA(0, 1), a2 + hstepA, voffA);
            PG8_WAIT_L(8); PG8_BAR; PG8_WAIT_L(0); PG8_MMA(0, 0, At, B0); PG8_BAR; PG8_SCHED;
            PG8_LDB(B1, 1, 1); PG8_STAGE(PG8_SB(1, 0), b3, voffB);
            PG8_BAR; PG8_WAIT_L(0); PG8_MMA(0, 1, At, B1); PG8_BAR;
            PG8_LDA(At, 1, 1); PG8_STAGE(PG8_SA(1, 0), a3, voffA);
            PG8_BAR; PG8_WAIT_L(0); PG8_MMA(1, 0, At, B0); PG8_BAR; PG8_SCHED;
            PG8_STAGE(PG8_SB(1, 1), b3 + hstepB, voffB);
            PG8_WAIT_V(6); PG8_BAR; PG8_MMA(1, 1, At, B1); PG8_BAR;
        }
        if constexpr (FP8) asm volatile("s_nop 15\n\ts_nop 15" ::: "memory");
        E(acc, cur, wr, wc, fr, fq);
        if (!has_next) break;
#pragma unroll
        for (int a = 0; a < 2; ++a)
#pragma unroll
            for (int b = 0; b < 2; ++b)
#pragma unroll
                for (int m = 0; m < 4; ++m)
#pragma unroll
                    for (int n = 0; n < 2; ++n) acc[a][b][m][n] = (f32x4){0.f, 0.f, 0.f, 0.f};
        cur = nxt; cA = nA; cB = nB; ++ui;
    }
    PG8_WAIT_V(0);
    if (wr == 0) PG8_BAR;
    PG8_BAR;
#undef PG8_SA
#undef PG8_SB
#undef PG8_STAGE
#undef PG8_LDA
#undef PG8_LDB
#undef PG8_MMA
#undef PG8_WAIT_V
#undef PG8_WAIT_L
#undef PG8_BAR
#undef PG8_SCHED
}
}


struct SchedIn {
    const char* A; const char* Bt; int G, c, trim, part;
    __device__ __forceinline__ bool next(int i, pg8::Unit& u) const {
        int pm, pn, q = 0; const long L = (long)i * G + c;
        const int nN = part ? NT8 : 45, nM = trim ? 64 : MROWS / 256;
        if (L < (long)nM * nN) { pg8::static_tile(nM, nN, L, pm, pn); if (trim) pm += pm / 16; q = pn; pn = part ? pn_of_q8(pn) : pn_of_p16(pn); }
        else { if (!trim) return false; const int idx = (int)(L - (long)nM * nN);
            if (part) { if (idx >= 4 * 6) return false; const int k = idx % 6; pm = 17 * (idx / 6) + 16; q = 4 + k; pn = pn_of_q8(q); }
            else { if (idx >= 4 * 9) return false; const int k = idx % 9; pm = 17 * (idx / 9) + 16; pn = k < 8 ? 10 + k : 86; } }
        u.pm = pm; u.pn = pn; u.tag = 0;
        if (part) { u.a = A + (size_t)pm * 256 * DM; u.b = Bt + (size_t)q * 256 * DM; }
        else { u.a = A + (size_t)pm * 256 * DM * 2; u.b = Bt + (size_t)pn * 256 * DM * 2; }
        return true; }
};
struct EpiIn {
    static constexpr bool PERM = true;
    bf16_t* Y; float* G32; bool dost; float ps;
    __device__ __forceinline__ void operator()(const f32x4 (&acc)[2][2][4][2], const pg8::Unit& u, int wr, int wc, int fr, int fq) const {
        if (!dost) return;
        const int pn = u.pn;
        int opq = 0; asm volatile("" : "+v"(opq));
        const int row0 = u.pm * 256 + wr * 64 + fr + opq;
        if (pn == 86) {
            if (wc == 0 && fq < 2) {
#pragma unroll
                for (int ai = 0; ai < 2; ++ai)
#pragma unroll
                    for (int m = 0; m < 4; ++m) { float* gp = G32 + (size_t)(row0 + ai * 128 + m * 16) * 16 + 8 * fq;
                        *(f32x4*)gp = acc[ai][0][m][0]; *(f32x4*)(gp + 4) = acc[ai][0][m][1]; }
            }
            return;
        }
        int act = 0;
        if ((pn >= 6 && pn < 10) || (pn >= 26 && pn < 30) || (pn >= 42 && pn < 46) || (pn >= 50 && pn < 54)) act = 1;
        else if ((pn >= 22 && pn < 26) || pn >= 54) act = 2;
        const int col0 = pn * 256 + wc * 32 + 8 * fq;
#pragma unroll
        for (int ai = 0; ai < 2; ++ai)
#pragma unroll
            for (int m = 0; m < 4; ++m) { bf16_t* rowp = Y + (size_t)(row0 + ai * 128 + m * 16) * NPAD + col0;
#pragma unroll
                for (int bj = 0; bj < 2; ++bj) { f32x4 v0 = acc[ai][bj][m][0], v1 = acc[ai][bj][m][1];
                    if (act == 1) {
#pragma unroll
                        for (int j = 0; j < 4; ++j) { v0[j] = siluf_(v0[j]); v1[j] = siluf_(v1[j]); } }
                    else if (act == 2) {
#pragma unroll
                        for (int j = 0; j < 4; ++j) { v0[j] = sigmoidf_(v0[j] * ps); v1[j] = sigmoidf_(v1[j] * ps); } }
                    u32x4 w; w.x = cvt_pk_bf16(v0[0], v0[1]); w.y = cvt_pk_bf16(v0[2], v0[3]); w.z = cvt_pk_bf16(v1[0], v1[1]); w.w = cvt_pk_bf16(v1[2], v1[3]);
                    *(u32x4*)(rowp + bj * 128) = w; } }
    }
};

struct EpiGate8 {
    static constexpr bool PERM = true;
    bf16_t* Y;
    __device__ __forceinline__ void operator()(const f32x4 (&acc)[2][2][4][2], const pg8::Unit& u, int wr, int wc, int fr, int fq) const {
        int opq = 0; asm volatile("" : "+v"(opq));
        const int row0 = u.pm * 256 + wr * 64 + fr + opq, col0 = u.pn * 256 + wc * 32 + 8 * fq; const bool gate = u.pn >= 54;
#pragma unroll
        for (int ai = 0; ai < 2; ++ai)
#pragma unroll
            for (int m = 0; m < 4; ++m) { bf16_t* rowp = Y + (size_t)(row0 + ai * 128 + m * 16) * NPAD + col0;
#pragma unroll
                for (int bj = 0; bj < 2; ++bj) { float o[8];
#pragma unroll
                    for (int j = 0; j < 4; ++j) { const float x0 = acc[ai][bj][m][0][j] * (1.0f / 64.0f), x1 = acc[ai][bj][m][1][j] * (1.0f / 64.0f); o[j] = gate ? sigmoidf_(x0) : x0; o[4 + j] = gate ? sigmoidf_(x1) : x1; }
                    *(u32x4*)(rowp + bj * 128) = pack8(o); } }
    }
};
struct SchedPool {
    const char* A; const char* Bt; int G, c, i0;
    __device__ __forceinline__ bool next(int i, pg8::Unit& u) const {
        const long L = (long)i * G + c; if (L >= (MROWS / 256) * 4) return false;
        const int pm = (int)(L >> 2), g = (int)(L & 3);
        u.pm = pm; u.pn = g; u.tag = 0; u.a = A + ((size_t)pm * 256 * BRW + g * 256) * 2; u.b = Bt + (size_t)g * 256 * 256 * 2; return true; }
};
struct EpiPool {
    static constexpr bool PERM = true;
    bf16_t* Y;
    __device__ __forceinline__ void operator()(const f32x4 (&acc)[2][2][4][2], const pg8::Unit& u, int wr, int wc, int fr, int fq) const {
        int opq = 0; asm volatile("" : "+v"(opq));
        const int row0 = u.pm * 256 + wr * 64 + fr + opq, colc = u.pn * 256 + wc * 32 + 8 * fq;
#pragma unroll
        for (int ai = 0; ai < 2; ++ai) {
            u32x4 zw[4][2];
#pragma unroll
            for (int m = 0; m < 4; ++m)
#pragma unroll
                for (int bj = 0; bj < 2; ++bj) zw[m][bj] = *(const u32x4*)(Y + (size_t)(row0 + ai * 128 + m * 16) * NPAD + C_PZ + colc + bj * 128);
#pragma unroll
            for (int m = 0; m < 4; ++m)
#pragma unroll
                for (int bj = 0; bj < 2; ++bj) { float z[8]; unpack8(zw[m][bj], z);
                    const f32x4 v0 = acc[ai][bj][m][0], v1 = acc[ai][bj][m][1]; float o[8];
#pragma unroll
                    for (int j = 0; j < 4; ++j) { o[j] = v0[j] * z[j]; o[4 + j] = v1[j] * z[4 + j]; }
                    *(u32x4*)(Y + (size_t)(row0 + ai * 128 + m * 16) * NPAD + C_PZ + colc + bj * 128) = pack8(o); }
            asm volatile("" ::: "memory"); }
    }
};

struct SchedMerge {
    const char* Y; const char* Wbr; int G, c, nM;
    __device__ __forceinline__ bool next(int i, pg8::Unit& u) const {
        const long L = (long)(i >> 2) * G + c; const int br = i & 3; if (L >= (long)nM * 8) return false;
        const int pm = (int)(L >> 3), pn = (int)(L & 7);
        const int pmr = (nM == 64) ? (pm + pm / 16) : pm;
        const int coff = br == 0 ? C_AQ : (br == 1 ? C_MO : (br == 2 ? C_CZ : C_PZ));
        u.pm = pmr; u.pn = pn; u.tag = br; u.a = Y + ((size_t)pmr * 256 * NPAD + coff) * 2; u.b = Wbr + ((size_t)br * DM * BRW + (size_t)pn * 256 * BRW) * 2; return true; }
};
struct EpiMerge {
    static constexpr bool PERM = true;
    const bf16_t* Y; bf16_t* accb;
    __device__ __forceinline__ void operator()(const f32x4 (&acc)[2][2][4][2], const pg8::Unit& u, int wr, int wc, int fr, int fq) const {
        int opq = 0; asm volatile("" : "+v"(opq));
        const int row0 = u.pm * 256 + wr * 64 + fr + opq, col0 = u.pn * 256 + wc * 32 + 8 * fq, tag = u.tag;
#pragma unroll
        for (int ai = 0; ai < 2; ++ai) {
            u32x4 gw[4][2], pw[4][2];
#pragma unroll
            for (int m = 0; m < 4; ++m) { const size_t row = (size_t)(row0 + ai * 128 + m * 16);
#pragma unroll
                for (int bj = 0; bj < 2; ++bj) { gw[m][bj] = *(const u32x4*)(Y + row * NPAD + C_GM + tag * DM + col0 + bj * 128);
                    pw[m][bj] = tag != 0 ? *(const u32x4*)(accb + row * DM + col0 + bj * 128) : (u32x4){0u, 0u, 0u, 0u}; } }
#pragma unroll
            for (int m = 0; m < 4; ++m) { const size_t row = (size_t)(row0 + ai * 128 + m * 16);
#pragma unroll
                for (int bj = 0; bj < 2; ++bj) { float gt[8], pv[8]; unpack8(gw[m][bj], gt); unpack8(pw[m][bj], pv);
                    const f32x4 v0 = acc[ai][bj][m][0], v1 = acc[ai][bj][m][1]; float o[8];
#pragma unroll
                    for (int j = 0; j < 4; ++j) { o[j] = v0[j] * gt[j] + pv[j]; o[4 + j] = v1[j] * gt[4 + j] + pv[4 + j]; }
                    *(u32x4*)(accb + row * DM + col0 + bj * 128) = pack8(o); } }
            asm volatile("" ::: "memory"); }
    }
};

struct SchedOut {
    const char* A; const char* Bt; int G, c, nM;
    __device__ __forceinline__ bool next(int i, pg8::Unit& u) const {
        const long L = (long)i * G + c; if (L >= (long)nM * 8) return false;
        const int pm = (int)(L >> 3), pn = (int)(L & 7);
        const int pmr = (nM == 64) ? (pm + pm / 16) : pm;
        u.pm = pmr; u.pn = pn; u.tag = 0; u.a = A + (size_t)pmr * 256 * DM * 2; u.b = Bt + (size_t)pn * 256 * DM * 2; return true; }
};
struct EpiOut {
    static constexpr bool PERM = false;
    const float* xin; const float* ctxin;
    const float* mod;
    bf16_t* X1; int first;
    __device__ __forceinline__ void operator()(const f32x4 (&acc)[2][2][4][2], const pg8::Unit& u, int wr, int wc, int fr, int fq) const {
        const int b = u.pm / 17, j = u.pm % 17; const bool isctx = (j == 16);
        int opq = 0; asm volatile("" : "+v"(opq));
        const int rin = wr * 64 + fr + opq;
        const int col0 = u.pn * 256 + wc * 32 + 4 * fq;
        const float* gtp = mod + (size_t)(isctx ? 4 : b) * 6144 + 4096 + col0;
        const float* resb = isctx ? ctxin + (size_t)b * LC * DM : xin + ((size_t)b * TL + (size_t)j * 256) * DM;
        bf16_t* xb = X1 + (size_t)u.pm * 256 * DM;
        f32x4 gv[2][2];
#pragma unroll
        for (int bj = 0; bj < 2; ++bj)
#pragma unroll
            for (int n = 0; n < 2; ++n) gv[bj][n] = *(const f32x4*)(gtp + bj * 128 + n * 16);
#pragma unroll
        for (int ai = 0; ai < 2; ++ai) {
            f32x4 rv[4][2][2];
#pragma unroll
            for (int m = 0; m < 4; ++m) { const size_t off = (size_t)(rin + ai * 128 + m * 16) * DM + col0;
#pragma unroll
                for (int bj = 0; bj < 2; ++bj)
#pragma unroll
                    for (int n = 0; n < 2; ++n) {
                        if (first) rv[m][bj][n] = *(const f32x4*)(resb + off + bj * 128 + n * 16);
                        else { const u32x2 w = *(const u32x2*)(xb + off + bj * 128 + n * 16); rv[m][bj][n] = (f32x4){bflo(w.x), bfhi(w.x), bflo(w.y), bfhi(w.y)}; } } }
#pragma unroll
            for (int m = 0; m < 4; ++m) { const size_t off = (size_t)(rin + ai * 128 + m * 16) * DM + col0;
#pragma unroll
                for (int bj = 0; bj < 2; ++bj)
#pragma unroll
                    for (int n = 0; n < 2; ++n) { const f32x4 o = rv[m][bj][n] + gv[bj][n] * acc[ai][bj][m][n];
                        u32x2 w; w.x = cvt_pk_bf16(o[0], o[1]); w.y = cvt_pk_bf16(o[2], o[3]); *(u32x2*)(xb + off + bj * 128 + n * 16) = w; } }
            asm volatile("" ::: "memory"); }
    }
};

namespace att {
using pg8::v4i_t; using pg8::v8i_t;
constexpr int D = 128, NW = 8, QBLK = 32, KVBLK = 64;
constexpr float SCALE = 0.088388347648318440f;
constexpr float THR = 5.f;
constexpr int LDQ = NPAD, LDK = NPAD;
constexpr size_t SHM_V = KVBLK * D * 2, SHM_K = KVBLK * D * 2, SHM_ATTN = 2 * SHM_V + 2 * SHM_K + NW * 64 * 4;
#define KSWZ(row, colB) ((row) * 256 + ((colB) ^ (((row) & 7) << 4)))
#define SBAR() __builtin_amdgcn_sched_barrier(0)
__device__ __forceinline__ int crow(int r, int hi) { return (r & 3) + 8 * (r >> 2) + 4 * hi; }
__device__ __forceinline__ void partialSM(f32x16& p0, f32x16& p1, float& m_reg, float& mn, float& alpha) {
  constexpr float C = SCALE * 1.4426950408889634f;
  float pmax = p0[0]; for (int r = 1; r < 16; ++r) pmax = fmaxf(pmax, p0[r]); for (int r = 0; r < 16; ++r) pmax = fmaxf(pmax, p1[r]);
  { auto rr = __builtin_amdgcn_permlane32_swap(__float_as_uint(pmax), __float_as_uint(pmax), false, false);
    pmax = fmaxf(__uint_as_float(rr[0]), __uint_as_float(rr[1])); }
  if (__builtin_expect(__all(pmax - m_reg <= THR / SCALE), 1)) { mn = m_reg; alpha = 1.f; }
  else { mn = fmaxf(m_reg, pmax); alpha = __builtin_amdgcn_exp2f((m_reg - mn) * C); m_reg = mn; }
  float mnC = -mn * C;
  for (int r = 0; r < 16; ++r) p0[r] = fmaf(p0[r], C, mnC); for (int r = 0; r < 16; ++r) p1[r] = fmaf(p1[r], C, mnC);
  for (int r = 0; r < 16; ++r) p0[r] = __builtin_amdgcn_exp2f(p0[r]);
}
__device__ __forceinline__ void finishSM(f32x16& p0, f32x16& p1, v8i_t& p8) {
  for (int r = 0; r < 16; ++r) p1[r] = __builtin_amdgcn_exp2f(p1[r]);
#pragma unroll
  for (int i = 0; i < 4; ++i) { int w = __builtin_amdgcn_cvt_pk_fp8_f32(p0[4 * i], p0[4 * i + 1], 0, false); w = __builtin_amdgcn_cvt_pk_fp8_f32(p0[4 * i + 2], p0[4 * i + 3], w, true); p8[i] = w;
    int v = __builtin_amdgcn_cvt_pk_fp8_f32(p1[4 * i], p1[4 * i + 1], 0, false); v = __builtin_amdgcn_cvt_pk_fp8_f32(p1[4 * i + 2], p1[4 * i + 3], v, true); p8[4 + i] = v; }
}
#define KSWZ8(row, colB) ((row) * 128 + ((colB) ^ (((row) & 7) << 4)))
__device__ __forceinline__ u32x2 bf8x_to_fp8(bf16x8 x) {
  const u32x4 w = __builtin_bit_cast(u32x4, x);
  int lo = __builtin_amdgcn_cvt_pk_fp8_f32(bflo(w.x), bfhi(w.x), 0, false); lo = __builtin_amdgcn_cvt_pk_fp8_f32(bflo(w.y), bfhi(w.y), lo, true);
  int hi = __builtin_amdgcn_cvt_pk_fp8_f32(bflo(w.z), bfhi(w.z), 0, false); hi = __builtin_amdgcn_cvt_pk_fp8_f32(bflo(w.w), bfhi(w.w), hi, true);
  return (u32x2){(unsigned)lo, (unsigned)hi};
}
__device__ __forceinline__ void qkt(f32x16& p0, f32x16& p1, const char* Ks, const v8i_t* q8, int r32, int hi) {
  const int c0 = 32 * hi, c1 = 64 + 32 * hi;
  const v8i_t a00 = __builtin_shufflevector(*(const v4i_t*)(Ks + KSWZ8(r32, c0)), *(const v4i_t*)(Ks + KSWZ8(r32, c0 + 16)), 0, 1, 2, 3, 4, 5, 6, 7);
  const v8i_t a10 = __builtin_shufflevector(*(const v4i_t*)(Ks + KSWZ8(32 + r32, c0)), *(const v4i_t*)(Ks + KSWZ8(32 + r32, c0 + 16)), 0, 1, 2, 3, 4, 5, 6, 7);
  const v8i_t a01 = __builtin_shufflevector(*(const v4i_t*)(Ks + KSWZ8(r32, c1)), *(const v4i_t*)(Ks + KSWZ8(r32, c1 + 16)), 0, 1, 2, 3, 4, 5, 6, 7);
  const v8i_t a11 = __builtin_shufflevector(*(const v4i_t*)(Ks + KSWZ8(32 + r32, c1)), *(const v4i_t*)(Ks + KSWZ8(32 + r32, c1 + 16)), 0, 1, 2, 3, 4, 5, 6, 7);
  asm volatile("v_mfma_f32_32x32x64_f8f6f4 %0, %1, %2, 0" : "=&v"(p0) : "v"(a00), "v"(q8[0]));
  asm volatile("v_mfma_f32_32x32x64_f8f6f4 %0, %1, %2, 0" : "=&v"(p1) : "v"(a10), "v"(q8[0]));
  asm volatile("v_mfma_f32_32x32x64_f8f6f4 %0, %1, %2, %0" : "+v"(p0) : "v"(a01), "v"(q8[1]));
  asm volatile("v_mfma_f32_32x32x64_f8f6f4 %0, %1, %2, %0\n\ts_nop 15\n\ts_nop 15" : "+v"(p1) : "v"(a11), "v"(q8[1]));
}
__device__ __forceinline__ int v_st(int k, int c) { const int kk = (k & ~0xC) | ((k & 4) << 1) | ((k & 8) >> 1); return ((kk >> 3) * 4 + (c >> 5)) * 512 + ((kk & 7) * 32 + (c & 31)) * 2; }
__device__ __forceinline__ int v_rd_base(int lane) { return ((lane & 3) << 3) | (((lane >> 2) & 3) << 6) | (((lane >> 4) & 1) << 5) | (((lane >> 5) & 1) << 8); }
constexpr int v_rd_off(int d0, int ks, int half) { return d0 * 512 + ks * 4096 + half * 2048; }
template <int OFF> __device__ __forceinline__ s16x4 tr_read(int vb) {
  s16x4 r; asm volatile("ds_read_b64_tr_b16 %0, %1 offset:%2" : "=&v"(r) : "v"(vb), "i"(OFF) : "memory"); return r;
}
__device__ __forceinline__ void pv_d0(f32x16* o, const char* Vs, v8i_t p8, int r32, int hi) {
  const char* vp = Vs + r32 * 80 + 32 * hi;
#define PV_LD(d0) __builtin_shufflevector(*(const v4i_t*)(vp + (d0) * 32 * 80), *(const v4i_t*)(vp + (d0) * 32 * 80 + 16), 0, 1, 2, 3, 4, 5, 6, 7)
  v8i_t va = PV_LD(0), vb = PV_LD(1);
  asm volatile("s_nop 4\n\tv_mfma_f32_32x32x64_f8f6f4 %0, %1, %2, %0" : "+v"(o[0]) : "v"(p8), "v"(va));
  SBAR(); va = PV_LD(2);
  asm volatile("v_mfma_f32_32x32x64_f8f6f4 %0, %1, %2, %0" : "+v"(o[1]) : "v"(p8), "v"(vb));
  SBAR(); vb = PV_LD(3);
  asm volatile("v_mfma_f32_32x32x64_f8f6f4 %0, %1, %2, %0" : "+v"(o[2]) : "v"(p8), "v"(va));
  SBAR(); va = PV_LD(4);
  asm volatile("v_mfma_f32_32x32x64_f8f6f4 %0, %1, %2, %0" : "+v"(o[3]) : "v"(p8), "v"(vb));
  asm volatile("v_mfma_f32_32x32x64_f8f6f4 %0, %1, %2, %0\n\ts_nop 15\n\ts_nop 15" : "+v"(o[4]) : "v"(p8), "v"(va));
#undef PV_LD
}
__device__ __forceinline__ void attn_dense_body(bf16_t* __restrict__ Qb, const unsigned char* __restrict__ K8h, const unsigned char* __restrict__ V8t, const bf16_t* __restrict__ Zb, int seq, char* lds) {
  const int tid = otid(), wid = tid >> 6, lane = tid & 63, r32 = lane & 31, hi = lane >> 5;
  bf16_t* V_lds = (bf16_t*)lds; bf16_t* K_lds = (bf16_t*)(lds + 2 * SHM_V);
  float* ws = (float*)(lds + 2 * SHM_V + 2 * SHM_K) + wid * 64; float* al_l = ws + 32;
  float m_reg = -1e30f; f32x16 o[5] = {}; v8i_t qr[2];
  for (int i = tid; i < 2 * 32 * 20; i += 512) { const int bsel = i / (32 * 20), w = i % (32 * 20);
    *(unsigned*)(lds + bsel * SHM_V + 128 * 80 + w * 4) = (w < 20) ? 0x38383838u : 0u; }
  const bf16_t* Qw = Qb + (long)(wid * QBLK + r32) * LDQ + hi * 32;
#pragma unroll
  for (int j = 0; j < 2; ++j) { u32x2 c[4];
#pragma unroll
    for (int e = 0; e < 4; ++e) c[e] = bf8x_to_fp8(*reinterpret_cast<const bf16x8*>(Qw + j * 64 + e * 8));
    qr[j] = (v8i_t){(int)c[0].x, (int)c[0].y, (int)c[1].x, (int)c[1].y, (int)c[2].x, (int)c[2].y, (int)c[3].x, (int)c[3].y}; }
  const int sr = tid >> 4, sc = (tid & 15) * 8;
  struct { u32x4 vs0; u32x2 ks0, ks1; } sr_[2];
#define SLOAD(i, k0) do { sr_[i].vs0 = *reinterpret_cast<const u32x4*>(V8t + (long)((k0) >> 6) * 8192 + tid * 16); \
    sr_[i].ks0 = *reinterpret_cast<const u32x2*>(K8h + (long)((k0) + sr) * 256 + sc); sr_[i].ks1 = *reinterpret_cast<const u32x2*>(K8h + (long)((k0) + 32 + sr) * 256 + sc); } while (0)
#define SWRITE(b, i) do { *(u32x4*)((char*)V_lds + (b) * SHM_V + (tid >> 2) * 80 + (tid & 3) * 16) = sr_[i].vs0;          \
    *(u32x2*)((char*)K_lds + (b) * SHM_K + KSWZ8(sr, sc)) = sr_[i].ks0;                       \
    *(u32x2*)((char*)K_lds + (b) * SHM_K + KSWZ8(32 + sr, sc)) = sr_[i].ks1; } while (0)
#define SWAIT() do { asm volatile("s_waitcnt vmcnt(3)" ::: "memory"); } while (0)
#define RESC(a) do { if (__any((a) < 1.f)) { if (hi == 0) al_l[r32] = (a); asm volatile("s_waitcnt lgkmcnt(0)" ::: "memory"); \
    for (int d = 0; d < 5; ++d) for (int r = 0; r < 16; ++r) o[d][r] *= al_l[crow(r, hi)]; } } while (0)
  f32x16 pA0, pA1, pB0, pB1; float mnA, mnB, alA, alB; v8i_t p8; const int NT = seq / KVBLK;
  constexpr int SE = 0, SO = 1;
  SLOAD(SE, 0); asm volatile("s_waitcnt vmcnt(0)" ::: "memory"); SWRITE(0, SE); __syncthreads();
  qkt(pA0, pA1, (const char*)K_lds, qr, r32, hi); partialSM(pA0, pA1, m_reg, mnA, alA);
  SLOAD(SO, KVBLK); { if (2 < NT) SLOAD(SE, 2 * KVBLK); }
  SWAIT(); SWRITE(1, SO); __syncthreads();
  for (int j = 1; j + 1 < NT; j += 2) {
    SBAR(); qkt(pB0, pB1, (const char*)K_lds + SHM_K, qr, r32, hi);
    finishSM(pA0, pA1, p8); SBAR();
    SLOAD(SO, (j + 2) * KVBLK); SBAR();
    pv_d0(o, (const char*)V_lds, p8, r32, hi); partialSM(pB0, pB1, m_reg, mnB, alB);
    __syncthreads(); SWAIT(); SWRITE(0, SE);
    RESC(alB); __syncthreads();
    SBAR(); qkt(pA0, pA1, (const char*)K_lds, qr, r32, hi);
    finishSM(pB0, pB1, p8); SBAR();
    if (j + 3 < NT) SLOAD(SE, (j + 3) * KVBLK); SBAR();
    pv_d0(o, (const char*)V_lds + SHM_V, p8, r32, hi); partialSM(pA0, pA1, m_reg, mnA, alA);
    __syncthreads(); SWAIT(); SWRITE(1, SO);
    RESC(alA); __syncthreads();
  }
  SBAR(); qkt(pB0, pB1, (const char*)K_lds + SHM_K, qr, r32, hi);
  finishSM(pA0, pA1, p8); SBAR();
  pv_d0(o, (const char*)V_lds, p8, r32, hi); partialSM(pB0, pB1, m_reg, mnB, alB);
  __syncthreads(); RESC(alB);
  finishSM(pB0, pB1, p8); SBAR();
  pv_d0(o, (const char*)V_lds + SHM_V, p8, r32, hi);
  float rli[16];
#pragma unroll
  for (int r = 0; r < 16; ++r) rli[r] = __builtin_amdgcn_rcpf(__shfl(o[4][r], lane & 32));
  bf16_t* Ol = (bf16_t*)(lds + SHM_ATTN) + wid * (32 * 136);
#pragma unroll
  for (int r = 0; r < 16; ++r) { const int row = crow(r, hi);
#pragma unroll
    for (int d0 = 0; d0 < 4; ++d0) Ol[row * 136 + 32 * d0 + r32] = f2bf(o[d0][r] * rli[r]); }
  asm volatile("s_waitcnt lgkmcnt(0)" ::: "memory");
  int opq = 0; asm volatile("" : "+v"(opq));
  const long gbase = (long)(wid * QBLK + opq) * LDQ;
  u32x4 ov[8], zv[8];
#pragma unroll
  for (int it = 0; it < 8; ++it) { const int chunk = it * 64 + lane, row = chunk >> 4, c8 = (chunk & 15) * 8;
    ov[it] = *(const u32x4*)(Ol + row * 136 + c8); zv[it] = *(const u32x4*)(Zb + gbase + (long)row * LDQ + c8); }
#pragma unroll
  for (int it = 0; it < 8; ++it) { const int chunk = it * 64 + lane, row = chunk >> 4, c8 = (chunk & 15) * 8;
    float of[8], zf[8], rf[8]; unpack8(ov[it], of); unpack8(zv[it], zf);
#pragma unroll
    for (int e = 0; e < 8; ++e) rf[e] = of[e] * zf[e];
    *(u32x4*)(Qb + gbase + (long)row * LDQ + c8) = pack8(rf); }
#undef SLOAD
#undef SWRITE
#undef SWAIT
#undef RESC
}
}

template <int KT>
__device__ __forceinline__ void tconv_tile(const float* __restrict__ src, int ld, int K, bool remap, bf16_t* __restrict__ dst, int n0, int k0, unsigned char* smem, const float* __restrict__ nscale = nullptr) {
    const int tid = otid(), kk = tid >> 4, n4 = (tid & 15) * 4;
    constexpr int LDT = KT + 8, NJ = KT / 32;
    bf16_t* tile = (bf16_t*)smem;
    const int n = n0 + n4; int sc = n; bool zero = false;
    if (remap) { if (n < 7680) sc = n; else if (n < 22016) sc = n + 16; else if (n < 22032) sc = 7680 + (n - 22016); else zero = true; }
    f32x4 v[NJ];
    const f32x4 nsc = nscale ? *(const f32x4*)(nscale + n) : (f32x4){1.f, 1.f, 1.f, 1.f};
#pragma unroll
    for (int j = 0; j < NJ; ++j) v[j] = zero ? (f32x4){0.f, 0.f, 0.f, 0.f} : *(const f32x4*)(src + (size_t)(k0 + kk + 32 * j) * ld + sc) * nsc;
#pragma unroll
    for (int j = 0; j < NJ; ++j)
#pragma unroll
        for (int i = 0; i < 4; ++i) tile[(n4 + i) * LDT + kk + 32 * j] = f2bf(v[j][i]);
    __syncthreads();
#pragma unroll
    for (int j = 0; j < KT / 64; ++j) { const int idx = tid + 512 * j, nn = idx / (KT / 8), k8 = (idx % (KT / 8)) * 8;
        *(u32x4*)(dst + (size_t)(n0 + nn) * K + k0 + k8) = *(const u32x4*)(tile + nn * LDT + k8); }
    __syncthreads();
}
__device__ __forceinline__ void mod_unit(const Params& p, int l, int cb, unsigned char* smem) {
    const int tid = otid();
    float* sc = (float*)smem; float* red = sc + 5 * 2048;
    for (int i = tid; i < 5 * 2048; i += 512) { const int r = i >> 11, k = i & 2047; const float v = r < 4 ? p.c[r * 2048 + k] : p.c_ctx[k]; sc[i] = siluf_(v); }
    __syncthreads();
    const int col4 = (tid & 15) * 4, ks = tid >> 4;
    f32x4 a0 = {0, 0, 0, 0}, a1 = a0, a2 = a0, a3 = a0, a4 = a0;
    const float* wp = p.w_mod + (size_t)l * 2048 * 6144 + (size_t)(ks * 64) * 6144 + cb * 64 + col4;
#pragma unroll 8
    for (int kk = 0; kk < 64; ++kk) { const f32x4 w = *(const f32x4*)(wp + (size_t)kk * 6144); const int k = ks * 64 + kk;
        a0 += sc[k] * w; a1 += sc[2048 + k] * w; a2 += sc[4096 + k] * w; a3 += sc[6144 + k] * w; a4 += sc[8192 + k] * w; }
    *(f32x4*)(red + (ks * 5 + 0) * 64 + col4) = a0; *(f32x4*)(red + (ks * 5 + 1) * 64 + col4) = a1; *(f32x4*)(red + (ks * 5 + 2) * 64 + col4) = a2;
    *(f32x4*)(red + (ks * 5 + 3) * 64 + col4) = a3; *(f32x4*)(red + (ks * 5 + 4) * 64 + col4) = a4;
    __syncthreads();
    if (tid < 320) { const int r = tid >> 6, cc = tid & 63; float s = p.b_mod[l * 6144 + cb * 64 + cc];
        for (int q = 0; q < 32; ++q) s += red[(q * 5 + r) * 64 + cc];
        ((float*)(p.ws + WS_MOD))[(size_t)(l * 5 + r) * 6144 + cb * 64 + cc] = s; }
    __syncthreads();
}
__device__ __forceinline__ void tconv8_tile(const float* __restrict__ src, int ld, int col0, unsigned char* __restrict__ dst, int n0, int k0, unsigned char* smem) {
    const int tid = otid(), kk = tid >> 4, n4 = (tid & 15) * 4;
    constexpr int LDT = 512 + 16;
    unsigned char* tile = smem;
    f32x4 v[16];
#pragma unroll
    for (int j = 0; j < 16; ++j) v[j] = *(const f32x4*)(src + (size_t)(k0 + kk + 32 * j) * ld + col0 + n0 + n4) * 64.0f;
#pragma unroll
    for (int j = 0; j < 16; ++j) { const int w01 = __builtin_amdgcn_cvt_pk_fp8_f32(v[j][0], v[j][1], 0, false), w23 = __builtin_amdgcn_cvt_pk_fp8_f32(v[j][2], v[j][3], 0, false);
        tile[(n4 + 0) * LDT + kk + 32 * j] = (unsigned char)(w01 & 0xff); tile[(n4 + 1) * LDT + kk + 32 * j] = (unsigned char)((w01 >> 8) & 0xff);
        tile[(n4 + 2) * LDT + kk + 32 * j] = (unsigned char)(w23 & 0xff); tile[(n4 + 3) * LDT + kk + 32 * j] = (unsigned char)((w23 >> 8) & 0xff); }
    __syncthreads();
#pragma unroll
    for (int j = 0; j < 4; ++j) { const int idx = tid + 512 * j, nn = idx >> 5, k16 = (idx & 31) * 16;
        *(u32x4*)(dst + (size_t)(n0 + nn) * DM + k0 + k16) = *(const u32x4*)(tile + nn * LDT + k16); }
    __syncthreads();
}
constexpr int U_WINB = 196 * 4, U_W8 = NT8 * 4 * 4, U_WIN1 = U_WINB + U_W8, U_WBR1 = 4 * 32 * 2, U_WOUT1 = 32 * 4, U_POOL1 = 4 * 4, U_CONV1 = U_WIN1 + U_WBR1 + U_WOUT1 + U_POOL1;
__device__ __forceinline__ void conv_unit(const Params& p, int l, int v, unsigned char* smem) {
    if (v < U_WINB) { const int t = v >> 2, nt = t < 192 ? t + 24 : t + 152, kt = v & 3;
        tconv_tile<512>(p.w_in + (size_t)l * DM * NIN, NIN, DM, true, (bf16_t*)(p.ws + WS_WIN) + (size_t)l * NPAD * DM, nt * 64, kt * 512, smem); return; }
    if (v < U_WIN1) { const int w = v - U_WINB, nt = w >> 2, kt = w & 3, q = nt >> 2, col = pn_of_q8(q) * 256 + (nt & 3) * 64;
        tconv8_tile(p.w_in + (size_t)l * DM * NIN, NIN, (col < 7680 ? col : col + 16) - nt * 64, p.ws + WS_W8 + (size_t)l * NT8 * 256 * DM, nt * 64, kt * 512, smem); return; }
    v -= U_WIN1;
    if (v < U_WBR1) { const int mat = l * 4 + (v >> 6), r = v & 63, nt = r >> 1, kt = r & 1;
        tconv_tile<512>(p.w_branch + (size_t)mat * BRW * DM, DM, BRW, false, (bf16_t*)(p.ws + WS_WBR) + (size_t)mat * DM * BRW, nt * 64, kt * 512, smem); return; }
    v -= U_WBR1;
    if (v < U_WOUT1) { const int nt = v >> 2, kt = v & 3;
        tconv_tile<512>(p.w_out + (size_t)l * DM * DM, DM, DM, false, (bf16_t*)(p.ws + WS_WOUT) + (size_t)l * DM * DM, nt * 64, kt * 512, smem); return; }
    v -= U_WOUT1;
    { const int mat = l * 4 + (v >> 2), nt = v & 3;
        tconv_tile<256>(p.pool_w + (size_t)mat * 256 * 256, 256, 256, false, (bf16_t*)(p.ws + WS_POOLW) + (size_t)mat * 256 * 256, nt * 64, 0, smem, p.pool_scale + (size_t)mat * 256); }
}
__device__ void phase_prep(const Params& p, unsigned char* smem) {
    constexpr int U_MOD = 192;
    for (int u = blockIdx.x; u < U_MOD + U_CONV1; u += gridDim.x) {
        if (u < U_MOD) mod_unit(p, u / 96, u % 96, smem); else conv_unit(p, 0, u - U_MOD, smem);
    }
}

__device__ void phase_norm(const Params& p, int l) {
    const int tid = otid(), lane = tid & 63, wv = obid() * 8 + (tid >> 6), nwv = gridDim.x * 8;
    const float* mod = (const float*)(p.ws + WS_MOD) + (size_t)l * 5 * 6144;
    const float* gain = p.norm_gain + l * DM;
    bf16_t* H = (bf16_t*)(p.ws + WS_H);
    for (int row = wv; row < MROWS; row += nwv) {
        const int b = row / RPB, tt = row % RPB; const bool isctx = tt >= TL;
        const float* xr = isctx ? p.ctx + ((size_t)b * LC + (tt - TL)) * DM : p.x + ((size_t)b * TL + tt) * DM;
        const bf16_t* xb = (const bf16_t*)(p.ws + WS_X1) + (size_t)row * DM;
        const float* mr = mod + (size_t)(isctx ? 4 : b) * 6144;
        f32x4 v[8]; float ss = 0.f;
#pragma unroll
        for (int j = 0; j < 8; ++j) {
            if (l == 0) v[j] = *(const f32x4*)(xr + 256 * j + 4 * lane);
            else { const u32x2 w = *(const u32x2*)(xb + 256 * j + 4 * lane); v[j] = (f32x4){bflo(w.x), bfhi(w.x), bflo(w.y), bfhi(w.y)}; }
            ss += v[j][0] * v[j][0] + v[j][1] * v[j][1] + v[j][2] * v[j][2] + v[j][3] * v[j][3]; }
#pragma unroll
        for (int o = 32; o >= 1; o >>= 1) ss += __shfl_xor(ss, o);
        const float rstd = rsqrtf(ss * (1.0f / DM) + EPS);
#pragma unroll
        for (int j = 0; j < 8; ++j) { const int cidx = 256 * j + 4 * lane;
            const f32x4 g = *(const f32x4*)(gain + cidx), sh = *(const f32x4*)(mr + cidx), sc = *(const f32x4*)(mr + 2048 + cidx);
            f32x4 y = v[j] * rstd * g * (1.0f + sc) + sh;
            u32x2 w; w.x = cvt_pk_bf16(y[0], y[1]); w.y = cvt_pk_bf16(y[2], y[3]);
            *(u32x2*)(H + (size_t)row * DM + cidx) = w;
            int w8 = __builtin_amdgcn_cvt_pk_fp8_f32(y[0], y[1], 0, false); w8 = __builtin_amdgcn_cvt_pk_fp8_f32(y[2], y[3], w8, true);
            *(int*)(p.ws + WS_H8 + (size_t)row * DM + cidx) = w8; }
    }
}
__device__ void phase_final(const Params& p) {
    const int tid = otid(), lane = tid & 63, wv = obid() * 8 + (tid >> 6), nwv = gridDim.x * 8;
    for (int row = wv; row < NB * TL; row += nwv) {
        const int b = row / TL, t = row % TL;
        const bf16_t* xb = (const bf16_t*)(p.ws + WS_X1) + (size_t)(b * RPB + t) * DM;
        float* xr = p.out + (size_t)row * DM;
        f32x4 v[8]; float ss = 0.f;
#pragma unroll
        for (int j = 0; j < 8; ++j) { const u32x2 w = *(const u32x2*)(xb + 256 * j + 4 * lane); v[j] = (f32x4){bflo(w.x), bfhi(w.x), bflo(w.y), bfhi(w.y)};
            ss += v[j][0] * v[j][0] + v[j][1] * v[j][1] + v[j][2] * v[j][2] + v[j][3] * v[j][3]; }
#pragma unroll
        for (int o = 32; o >= 1; o >>= 1) ss += __shfl_xor(ss, o);
        const float rstd = rsqrtf(ss * (1.0f / DM) + EPS);
#pragma unroll
        for (int j = 0; j < 8; ++j) { const int cidx = 256 * j + 4 * lane; const f32x4 g = *(const f32x4*)(p.final_gain + cidx); *(f32x4*)(xr + cidx) = v[j] * rstd * g; }
    }
}

__device__ __forceinline__ int seq_row(int b, int dir, int pos  ) {
    if (pos < LC) { const int o = dir ? (LC - 1 - pos) : pos; return b * RPB + TL + o; }
    const int q = pos - LC; const int o = dir ? (TL - 1 - q) : q; return b * RPB + o;
}
__device__ void phase_mix1(const Params& p, int l, unsigned char* smem) {
    const int tid = otid(), lane = tid & 63, wv = obid() * 8 + (tid >> 6), nwv = gridDim.x * 8;
    bf16_t* Y = (bf16_t*)(p.ws + WS_Y);
    if ((int)blockIdx.x >= (int)gridDim.x - 32) {
        const int sq = blockIdx.x - (gridDim.x - 32), dir = sq & 1, hd = (sq >> 1) & 3, b = sq >> 3, wid = tid >> 6;
        const float* G32 = (const float*)(p.ws + WS_G32);
        f32x4* GT4 = (f32x4*)(p.ws + WS_GT4) + (size_t)sq * RPB; float* GW = (float*)(p.ws + WS_GW) + (size_t)sq * RPB; float* GD = (float*)(p.ws + WS_GD) + sq * 128;
        const float bi = p.gate_bias[l * 16 + (dir ? 8 : 0) + hd], bfv = p.gate_bias[l * 16 + (dir ? 12 : 4) + hd];
        float* sAq = (float*)smem; float* sCm = sAq + RPB; float* sB = sCm + RPB; float* sB63 = sB + RPB; float* sC63 = sB63 + 128; float* sMc = sC63 + 128;
        for (int ci = wid; ci < NCHUNK; ci += 8) {
            const int pos = ci * 64 + lane, row = seq_row(b, dir, pos);
            const float gi = G32[(size_t)row * 16 + (dir ? 8 : 0) + hd] + bi, gf = G32[(size_t)row * 16 + (dir ? 12 : 4) + hd] + bfv;
            const float lf = fminf(gf, 0.f) - log1pf(__expf(-fabsf(gf)));
            float bsum = lf;
#pragma unroll
            for (int o = 1; o < 64; o <<= 1) { const float t = __shfl_up(bsum, o); if (lane >= o) bsum += t; }
            const float a = gi - bsum; float cm = a;
#pragma unroll
            for (int o = 1; o < 64; o <<= 1) { const float t = __shfl_up(cm, o); if (lane >= o) cm = fmaxf(cm, t); }
            sAq[pos] = a; sCm[pos] = cm; sB[pos] = bsum;
            if (lane == 63) { sB63[ci] = bsum; sC63[ci] = cm; }
        }
        __syncthreads();
        if (tid == 0) { float m = -1e30f; for (int ci = 0; ci < NCHUNK; ++ci) { sMc[ci] = m; m = sB63[ci] + fmaxf(m, sC63[ci]); } }
        __syncthreads();
        for (int pos = tid; pos < RPB; pos += 512) {
            const int ci = pos >> 6; const float m = sMc[ci], M = fmaxf(m, sCm[pos]), M63 = fmaxf(m, sC63[ci]), a = sAq[pos], bsum = sB[pos];
            GT4[pos] = (f32x4){a, M, fexp(m - M), fexp(-(bsum + M))}; GW[pos] = fexp(a - M63); if ((pos & 63) == 0) GD[ci] = fexp(m - M63);
        }
        return;
    }
    const int nw2 = nwv - 32 * 8;
    {
        const float* qg = p.q_gain + l * 128; const float* kg = p.k_gain + l * 128;
        const int j = lane & 31, hw = lane >> 5;
        const bool second = (j >> 3) & 1, colpart = j >= 16;
        float frq[4];
#pragma unroll
        for (int e = 0; e < 4; ++e) frq[e] = __builtin_amdgcn_exp2f(-(float)(4 * (j & 7) + e) * (13.287712379549449f / 32.0f));
        const f32x4 qg4 = *(const f32x4*)(qg + 4 * j), kg4 = *(const f32x4*)(kg + 4 * j);
        for (int row = wv; row < MROWS; row += nw2) {
            const int tt = row % RPB; const bool lat = tt < TL;
            float cs[4], sn[4];
            const float pos = lat ? (float)(colpart ? (tt & 63) : (tt >> 6)) : 0.f;
#pragma unroll
            for (int e = 0; e < 4; ++e) { const float ang = pos * frq[e]; cs[e] = __cosf(ang); sn[e] = __sinf(ang); }
            bf16_t* rb = Y + (size_t)row * NPAD + 4 * j;
            u32x2 raw[5];
#pragma unroll
            for (int it = 0; it < 5; ++it) { const int hh = it * 2 + hw; raw[it] = *(const u32x2*)(rb + (hh < 8 ? C_AQ + hh * 128 : C_AK + (hh - 8) * 128)); }
#pragma unroll
            for (int it = 0; it < 5; ++it) { const int hh = it * 2 + hw;
                float x[4] = {bflo(raw[it].x), bfhi(raw[it].x), bflo(raw[it].y), bfhi(raw[it].y)};
                float ss = x[0] * x[0] + x[1] * x[1] + x[2] * x[2] + x[3] * x[3];
#pragma unroll
                for (int o = 16; o >= 1; o >>= 1) ss += __shfl_xor(ss, o);
                const float rstd = rsqrtf(ss * (1.0f / 128.0f) + EPS);
                const f32x4 gn = hh < 8 ? qg4 : kg4;
                float y[4];
#pragma unroll
                for (int e = 0; e < 4; ++e) { x[e] *= rstd * gn[e]; }
#pragma unroll
                for (int e = 0; e < 4; ++e) { const float pr = __shfl_xor(x[e], 8); y[e] = second ? (x[e] * cs[e] + pr * sn[e]) : (x[e] * cs[e] - pr * sn[e]); }
                u32x2 w; w.x = cvt_pk_bf16(y[0], y[1]); w.y = cvt_pk_bf16(y[2], y[3]);
                if (hh < 8) *(u32x2*)(rb + C_AQ + hh * 128) = w;
                if (hh >= 8) { int k8 = __builtin_amdgcn_cvt_pk_fp8_f32(y[0], y[1], 0, false); k8 = __builtin_amdgcn_cvt_pk_fp8_f32(y[2], y[3], k8, true);
                    *(int*)(p.ws + WS_K8 + (size_t)row * 256 + (hh - 8) * 128 + 4 * j) = k8; }
            }
        }
    }
    {
        const int nth = nw2 * 64, th = wv * 64 + lane;
        for (int task = th; task < NB * 2 * NCHUNK * 128 * 8; task += nth) {
            const int d = task & 127, g = (task >> 7) & 7, T = (task >> 10) % NCHUNK, bk = (task >> 10) / NCHUNK, kvh = bk & 1, bb = bk >> 1;
            const bf16_t* vsrc = Y + (size_t)(bb * RPB + T * 64) * NPAD + C_AV + kvh * 128 + d;
            float f[8];
#pragma unroll
            for (int e = 0; e < 8; ++e) { const int pos = 8 * g + e, hi_ = pos >> 5, bq = pos & 31, half = bq >> 4, r = bq & 15, key = 32 * half + (r & 3) + 8 * (r >> 2) + 4 * hi_;
                f[e] = bf2f(vsrc[(size_t)key * NPAD]); }
            int w0 = __builtin_amdgcn_cvt_pk_fp8_f32(f[0], f[1], 0, false); w0 = __builtin_amdgcn_cvt_pk_fp8_f32(f[2], f[3], w0, true);
            int w1 = __builtin_amdgcn_cvt_pk_fp8_f32(f[4], f[5], 0, false); w1 = __builtin_amdgcn_cvt_pk_fp8_f32(f[6], f[7], w1, true);
            *(u32x2*)(p.ws + WS_V8 + ((size_t)bk * NCHUNK + T) * 8192 + d * 64 + 8 * g) = (u32x2){(unsigned)w0, (unsigned)w1};
        }
    }
    {
        bf16_t* DMB = (bf16_t*)(p.ws + WS_H);
        const float* cw = p.conv_w + (size_t)l * 3 * BRW;
        const int nth = nw2 * 64, th = wv * 64 + lane;
        for (int task = th; task < MROWS * 128; task += nth) {
            const int row = task >> 7, c8 = (task & 127) * 8;
            const int tt = row % RPB; const bool lat = tt < TL; const int t = lat ? tt : tt - TL, T = lat ? TL : LC;
            const bf16_t* yr = Y + (size_t)row * NPAD;
            u32x4 convw;
            {
                float a0[8], a1[8], a2[8], u[8], g[8];
                unpack8(*(const u32x4*)(yr + C_CU + c8), u); unpack8(*(const u32x4*)(yr + C_CC + c8), g);
#pragma unroll
                for (int i = 0; i < 8; ++i) a1[i] = u[i] * g[i];
                if (t > 0) { unpack8(*(const u32x4*)(yr - NPAD + C_CU + c8), u); unpack8(*(const u32x4*)(yr - NPAD + C_CC + c8), g);
#pragma unroll
                    for (int i = 0; i < 8; ++i) a0[i] = u[i] * g[i]; }
                else {
#pragma unroll
                    for (int i = 0; i < 8; ++i) a0[i] = 0.f; }
                if (t < T - 1) { unpack8(*(const u32x4*)(yr + NPAD + C_CU + c8), u); unpack8(*(const u32x4*)(yr + NPAD + C_CC + c8), g);
#pragma unroll
                    for (int i = 0; i < 8; ++i) a2[i] = u[i] * g[i]; }
                else {
#pragma unroll
                    for (int i = 0; i < 8; ++i) a2[i] = 0.f; }
                float bg[8], z[8], o[8];
                unpack8(*(const u32x4*)(yr + C_CB + c8), bg); unpack8(*(const u32x4*)(yr + C_CZ + c8), z);
#pragma unroll
                for (int i = 0; i < 8; ++i) o[i] = bg[i] * (cw[c8 + i] * a0[i] + cw[BRW + c8 + i] * a1[i] + cw[2 * BRW + c8 + i] * a2[i]) * z[i];
                convw = pack8(o);
            }
            {
                const int g = c8 >> 8, w = 2 << g;
                int lo = t - (w >> 1); if (lo < 0) lo = 0; int hi = t + w - (w >> 1); if (hi > T) hi = T;
                float s[8], u0[8];
#pragma unroll
                for (int i = 0; i < 8; ++i) s[i] = 0.f;
                u32x4 tap[16];
#pragma unroll
                for (int k = 0; k < 16; ++k) { const int q = t - (w >> 1) + k; const bool ok = (k < w) && (q >= 0) && (q < T);
                    tap[k] = ok ? *(const u32x4*)(yr + (long)(q - t) * NPAD + C_PU + c8) : (u32x4){0u, 0u, 0u, 0u}; }
#pragma unroll
                for (int k = 0; k < 16; ++k) { float u[8]; unpack8(tap[k], u);
#pragma unroll
                    for (int i = 0; i < 8; ++i) s[i] += u[i]; }
                unpack8(*(const u32x4*)(yr + C_PU + c8), u0);
                const float inv = 1.0f / (float)(hi - lo);
                float o[8];
#pragma unroll
                for (int i = 0; i < 8; ++i) o[i] = s[i] * inv - u0[i];
                *(u32x4*)(DMB + (size_t)row * BRW + c8) = pack8(o);
                *(u32x4*)(Y + (size_t)row * NPAD + C_CZ + c8) = convw;
            }
        }
    }
}

__device__ __forceinline__ f32x4 mfma16(bf16x8 a, bf16x8 b, f32x4 c) { return __builtin_amdgcn_mfma_f32_16x16x32_bf16(a, b, c, 0, 0, 0); }
__device__ void mlstm_item(const Params& p, int item, unsigned char* smem) {
    const int tid = otid(), wid = tid >> 6, lane = tid & 63, fr = lane & 15, kq = lane >> 4;
    const int ep = item & 3, dir = (item >> 2) & 1, hd = (item >> 3) & 3, b = item >> 5;
    const int sq = (b * 4 + hd) * 2 + dir;
    const bf16_t* Y = (const bf16_t*)(p.ws + WS_Y);
    bf16_t* HM = (bf16_t*)(p.ws + WS_HM) + (size_t)dir * MROWS * BRW;
    const f32x4* GT4 = (const f32x4*)(p.ws + WS_GT4) + (size_t)sq * RPB; const float* GW = (const float*)(p.ws + WS_GW) + (size_t)sq * RPB; const float* GD = (const float*)(p.ws + WS_GD) + sq * 128;
    bf16_t* Ks = (bf16_t*)(smem); bf16_t* KTs = (bf16_t*)(smem + 33792);
    bf16_t* VTs = (bf16_t*)(smem + 70656); bf16_t* VWTs = (bf16_t*)(smem + 82176); bf16_t* CTs = (bf16_t*)(smem + 93696); bf16_t* Ss = (bf16_t*)(smem + 135936);
    float* sA = (float*)(smem + 145152); float* sM = sA + 64; float* sI = sA + 128; float* sE = sA + 192;
    for (int i = tid; i < 80 * 72; i += 512) { VTs[i] = 0; VWTs[i] = 0; }
    for (int i = tid; i < 80 * 264; i += 512) CTs[i] = 0;
    __syncthreads();
    if (tid < 64) VTs[64 * 72 + tid] = 0x3F80;
    f32x4 Cacc[2][5];
#pragma unroll
    for (int a = 0; a < 2; ++a)
#pragma unroll
        for (int c = 0; c < 5; ++c) Cacc[a][c] = (f32x4){0.f, 0.f, 0.f, 0.f};
    const int rg = wid >> 1, ch = wid & 1;
    u32x4 kreg[4], vreg; f32x4 g4; float wv_ = 0.f, wtok = 0.f, decay = 0.f;
    bf16x8 qf[8];
    const int dkp = tid & 127, sg = tid >> 7;
    const int vs = tid & 63, ve8 = (tid >> 6) * 8;
#define ML_LOAD(ci) do { \
        _Pragma("unroll") for (int j = 0; j < 4; ++j) { const int idx = tid + 512 * j, rr = idx >> 5, c8 = (idx & 31) * 8; \
            kreg[j] = *(const u32x4*)(Y + (size_t)seq_row(b, dir, (ci) * 64 + rr) * NPAD + C_MK + hd * 256 + c8); } \
        vreg = *(const u32x4*)(Y + (size_t)seq_row(b, dir, (ci) * 64 + vs) * NPAD + C_MV + hd * 256 + ep * 64 + ve8); wv_ = GW[(ci) * 64 + vs]; \
        g4 = GT4[(ci) * 64 + (tid & 63)]; wtok = GW[(ci) * 64 + (tid & 63)]; \
        decay = GD[(ci)]; } while (0)
#define ML_QLOAD(ci) do { const bf16_t* qrow = Y + (size_t)seq_row(b, dir, (ci) * 64 + 16 * rg + fr) * NPAD + C_MQ + hd * 256 + 8 * kq; \
        _Pragma("unroll") for (int ks = 0; ks < 8; ++ks) qf[ks] = *(const bf16x8*)(qrow + 32 * ks); } while (0)
    ML_LOAD(0); ML_QLOAD(0);
    for (int ci = 0; ci < NCHUNK; ++ci) {
#pragma unroll
        for (int j = 0; j < 4; ++j) { const int idx = tid + 512 * j, rr = idx >> 5, c8 = (idx & 31) * 8; *(u32x4*)(Ks + rr * 264 + c8) = kreg[j]; }
        { float vf[8]; unpack8(vreg, vf); const float ws_ = wv_ * 0.0625f;
#pragma unroll
            for (int i = 0; i < 8; ++i) { VTs[(ve8 + i) * 72 + vs] = f2bf(vf[i]); VWTs[(ve8 + i) * 72 + vs] = f2bf(vf[i] * ws_); } }
        if (tid < 64) { sA[tid] = g4[0]; sM[tid] = g4[1]; sI[tid] = g4[2]; sE[tid] = g4[3]; VWTs[64 * 72 + tid] = f2bf(wtok * 0.0625f); }
        const float dec = decay;
        __syncthreads();
        const int cn = ci + 1 < NCHUNK ? ci + 1 : NCHUNK - 1;
        ML_LOAD(cn);
        {
            const int t = 16 * rg + fr; const float Mt = sM[t];
#pragma unroll
            for (int s2 = 0; s2 < 2; ++s2) { const int st = 2 * ch + s2; f32x4 acc = {0.f, 0.f, 0.f, 0.f};
#pragma unroll
                for (int ks = 0; ks < 8; ++ks) { const bf16x8 kf = *(const bf16x8*)(Ks + (16 * st + fr) * 264 + 32 * ks + 8 * kq); acc = mfma16(kf, qf[ks], acc); }
                float o[4];
#pragma unroll
                for (int i = 0; i < 4; ++i) { const int s = 16 * st + 4 * kq + i; o[i] = (s <= t) ? acc[i] * fexp(sA[s] - Mt) * 0.0625f : 0.f; }
                u32x2 w; w.x = cvt_pk_bf16(o[0], o[1]); w.y = cvt_pk_bf16(o[2], o[3]);
                *(u32x2*)(Ss + t * 72 + 16 * st + 4 * kq) = w; }
        }
#pragma unroll
        for (int j = 0; j < 2; ++j) { const int s0 = 8 * (sg + 4 * j); unsigned kt[8]; u32x4 lo, hi;
#pragma unroll
            for (int jj = 0; jj < 8; ++jj) kt[jj] = *(const unsigned*)(Ks + (s0 + jj) * 264 + 2 * dkp);
            lo.x = (kt[0] & 0xffffu) | (kt[1] << 16); lo.y = (kt[2] & 0xffffu) | (kt[3] << 16); lo.z = (kt[4] & 0xffffu) | (kt[5] << 16); lo.w = (kt[6] & 0xffffu) | (kt[7] << 16);
            hi.x = (kt[0] >> 16) | (kt[1] & 0xffff0000u); hi.y = (kt[2] >> 16) | (kt[3] & 0xffff0000u); hi.z = (kt[4] >> 16) | (kt[5] & 0xffff0000u); hi.w = (kt[6] >> 16) | (kt[7] & 0xffff0000u);
            *(u32x4*)(KTs + (2 * dkp) * 72 + s0) = lo; *(u32x4*)(KTs + (2 * dkp + 1) * 72 + s0) = hi; }
        __syncthreads();
        {
            f32x4 aN0 = {0.f, 0.f, 0.f, 0.f}, aN1 = aN0, aD = aN0;
#pragma unroll
            for (int ks = 0; ks < 8; ++ks) { const bf16x8 c0 = *(const bf16x8*)(CTs + (32 * ch + fr) * 264 + 32 * ks + 8 * kq), c1 = *(const bf16x8*)(CTs + (32 * ch + 16 + fr) * 264 + 32 * ks + 8 * kq),
                                                     c2 = *(const bf16x8*)(CTs + (64 + fr) * 264 + 32 * ks + 8 * kq);
                aN0 = mfma16(qf[ks], c0, aN0); aN1 = mfma16(qf[ks], c1, aN1); aD = mfma16(qf[ks], c2, aD); }
            ML_QLOAD(cn);
            float it4[4], en4[4];
#pragma unroll
            for (int i = 0; i < 4; ++i) { it4[i] = sI[16 * rg + 4 * kq + i]; en4[i] = sE[16 * rg + 4 * kq + i]; aN0[i] *= it4[i]; aN1[i] *= it4[i]; aD[i] *= it4[i]; }
#pragma unroll
            for (int ks = 0; ks < 2; ++ks) { const bf16x8 sf = *(const bf16x8*)(Ss + (16 * rg + fr) * 72 + 32 * ks + 8 * kq);
                const bf16x8 v0 = *(const bf16x8*)(VTs + (32 * ch + fr) * 72 + 32 * ks + 8 * kq), v1 = *(const bf16x8*)(VTs + (32 * ch + 16 + fr) * 72 + 32 * ks + 8 * kq), v2 = *(const bf16x8*)(VTs + (64 + fr) * 72 + 32 * ks + 8 * kq);
                aN0 = mfma16(sf, v0, aN0); aN1 = mfma16(sf, v1, aN1); aD = mfma16(sf, v2, aD); }
#pragma unroll
            for (int i = 0; i < 4; ++i) { const float den = __shfl(aD[i], lane & 48); const float rd = 1.0f / fmaxf(fabsf(den), en4[i]);
                const int row = seq_row(b, dir, ci * 64 + 16 * rg + 4 * kq + i);
                bf16_t* hp = HM + (size_t)row * BRW + hd * 256 + ep * 64 + 32 * ch + fr;
                hp[0] = f2bf(aN0[i] * rd); hp[16] = f2bf(aN1[i] * rd); }
        }
#pragma unroll
        for (int rt = 0; rt < 2; ++rt)
#pragma unroll
            for (int ct = 0; ct < 5; ++ct) { f32x4 cacc = Cacc[rt][ct] * dec;
#pragma unroll
                for (int ks = 0; ks < 2; ++ks) { const bf16x8 af = *(const bf16x8*)(KTs + (32 * wid + 16 * rt + fr) * 72 + 32 * ks + 8 * kq), bv = *(const bf16x8*)(VWTs + (16 * ct + fr) * 72 + 32 * ks + 8 * kq);
                    cacc = mfma16(af, bv, cacc); }
                Cacc[rt][ct] = cacc; }
        __syncthreads();
#pragma unroll
        for (int rt = 0; rt < 2; ++rt)
#pragma unroll
            for (int ct = 0; ct < 5; ++ct) { u32x2 w; w.x = cvt_pk_bf16(Cacc[rt][ct][0], Cacc[rt][ct][1]); w.y = cvt_pk_bf16(Cacc[rt][ct][2], Cacc[rt][ct][3]);
                *(u32x2*)(CTs + (16 * ct + fr) * 264 + 32 * wid + 16 * rt + 4 * kq) = w; }
    }
#undef ML_LOAD
#undef ML_QLOAD
    __syncthreads();
}

__device__ void phase_mix2(const Params& p, int l, unsigned char* smem) {
    bf16_t* Y = (bf16_t*)(p.ws + WS_Y);
#ifndef NO_MLSTM
    if ((int)blockIdx.x < 128) mlstm_item(p, blockIdx.x, smem);
#endif
#ifndef NO_ATT
    const int natt = 512 + (l == 0 ? 32 : 0);
    unsigned* ctr = (unsigned*)(p.ws + WS_BAR + 14336) + l * 64;
    volatile unsigned* sidx = (volatile unsigned*)(smem + LDS_BYTES - 32);
    for (;;) {
        __syncthreads();
        if (threadIdx.x == 0) *sidx = atomicAdd(ctr, 1u);
        __syncthreads();
        const int it = __builtin_amdgcn_readfirstlane((int)*sidx);
        if (it >= natt) break;
        int b, head, qrow, krow, seq;
        if (it < 512) { const int qb = it & 15; head = (it >> 4) & 7; b = it >> 7; qrow = b * RPB + qb * 256; krow = b * RPB; seq = RPB; }
        else { const int i2 = it - 512; head = i2 & 7; b = i2 >> 3; qrow = b * RPB + TL; krow = qrow; seq = LC; }
        const int kvh = head >> 2;
        bf16_t* rowq = Y + (size_t)qrow * NPAD; const bf16_t* rowk = Y + (size_t)krow * NPAD;
        att::attn_dense_body(rowq + C_AQ + head * 128, p.ws + WS_K8 + (size_t)krow * 256 + kvh * 128, p.ws + WS_V8 + ((size_t)(b * 2 + kvh) * NCHUNK + (krow - b * RPB) / 64) * 8192, rowq + C_AZ + head * 128, seq, (char*)smem);
    }
#endif
    __syncthreads();
#ifndef NO_POOLG
    { SchedPool S; S.A = (const char*)(p.ws + WS_H); S.Bt = (const char*)(p.ws + WS_POOLW) + (size_t)l * 4 * 256 * 256 * 2; S.G = gridDim.x; S.c = blockIdx.x; S.i0 = 0;
      EpiPool E; E.Y = Y;
      pg8::Gemm g; g.lda = BRW; g.ldb = 256; { int kk = 256; asm volatile("" : "+s"(kk)); g.K = kk; }
      pg8::gemm_phase(( LAS unsigned char*)smem, g, S, E); }
#endif
    __syncthreads();
}

__device__ void phase_mix3(const Params& p, int l) {
    const int tid = otid(), lane = tid & 63, wv = obid() * 8 + (tid >> 6), nwv = gridDim.x * 8;
    bf16_t* Y = (bf16_t*)(p.ws + WS_Y);
    const bf16_t* HM0 = (const bf16_t*)(p.ws + WS_HM); const bf16_t* HM1 = HM0 + (size_t)MROWS * BRW;
    const float* gain = p.m_gain + l * BRW;
    for (int row = wv; row < MROWS; row += nwv) {
        f32x4 v[4]; u32x2 ow[4], zw[4];
#pragma unroll
        for (int hd = 0; hd < 4; ++hd) { const size_t off = (size_t)row * BRW + hd * 256 + 4 * lane;
            { const u32x2 h0 = *(const u32x2*)(HM0 + off), h1 = *(const u32x2*)(HM1 + off);
              v[hd] = (f32x4){bflo(h0.x) + bflo(h1.x), bfhi(h0.x) + bfhi(h1.x), bflo(h0.y) + bflo(h1.y), bfhi(h0.y) + bfhi(h1.y)}; }
            ow[hd] = *(const u32x2*)(Y + (size_t)row * NPAD + C_MO + hd * 256 + 4 * lane); zw[hd] = *(const u32x2*)(Y + (size_t)row * NPAD + C_MZ + hd * 256 + 4 * lane); }
#pragma unroll
        for (int hd = 0; hd < 4; ++hd) {
            float ss = v[hd][0] * v[hd][0] + v[hd][1] * v[hd][1] + v[hd][2] * v[hd][2] + v[hd][3] * v[hd][3];
#pragma unroll
            for (int o = 32; o >= 1; o >>= 1) ss += __shfl_xor(ss, o);
            const float rstd = rsqrtf(ss * (1.0f / 256.0f) + EPS);
            const f32x4 g = *(const f32x4*)(gain + hd * 256 + 4 * lane);
            const float o0 = bflo(ow[hd].x), o1 = bfhi(ow[hd].x), o2 = bflo(ow[hd].y), o3 = bfhi(ow[hd].y), z0 = bflo(zw[hd].x), z1 = bfhi(zw[hd].x), z2 = bflo(zw[hd].y), z3 = bfhi(zw[hd].y);
            u32x2 w; w.x = cvt_pk_bf16(v[hd][0] * rstd * g[0] * o0 * z0, v[hd][1] * rstd * g[1] * o1 * z1); w.y = cvt_pk_bf16(v[hd][2] * rstd * g[2] * o2 * z2, v[hd][3] * rstd * g[3] * o3 * z3);
            *(u32x2*)(Y + (size_t)row * NPAD + C_MO + hd * 256 + 4 * lane) = w;
        }
    }
}

#define XB_TMO      128
#define XB_XCNT(j)  (256  + 64 * (j))
#define XB_XSUB(j)  (1280 + 64 * (j))
#define XB_XGEN(j)  (2304 + 64 * (j))
#define XB_TOP      3328
#define XB_TOPGEN   3392
#define XCD_BAR_WORDS 3456
#define XB_SPIN_CAP (1u << 18)
__device__ __forceinline__ unsigned xb_ld(unsigned* p)              { return __hip_atomic_load(p, __ATOMIC_RELAXED, __HIP_MEMORY_SCOPE_AGENT); }
__device__ __forceinline__ unsigned xb_add(unsigned* p, unsigned v) { return __hip_atomic_fetch_add(p, v, __ATOMIC_RELAXED, __HIP_MEMORY_SCOPE_AGENT); }
__device__ __forceinline__ unsigned xb_xcc_id() { return (unsigned)__builtin_amdgcn_s_getreg((3 << 11) | 20) & 0xFu; }
#define XB_SPIN(cond, bar) do { unsigned _sp = 0; while (cond) { __builtin_amdgcn_s_sleep(1); \
    if ((++_sp & 255u) == 0u) { if (xb_ld(&(bar)[XB_TMO])) break; if (_sp > XB_SPIN_CAP) { atomicAdd(&(bar)[XB_TMO], 1u); break; } } } } while (0)
struct XcdBarrier { unsigned* bar; unsigned x; volatile LAS unsigned* st; };
__device__ __forceinline__ XcdBarrier xcd_barrier_post(unsigned* bar, volatile LAS unsigned* st) {
    XcdBarrier b; b.bar = bar; b.x = xb_xcc_id(); b.st = st;
    if (threadIdx.x == 0) (void)xb_add(&bar[XB_XCNT(b.x)], 1u);
    return b;
}
__device__ __forceinline__ void xcd_barrier_complete(unsigned* bar, unsigned x, unsigned& nloc, unsigned& nx) {
    const unsigned G = gridDim.x * gridDim.y * gridDim.z;
    unsigned sum, cnt, mine, sp = 0u;
    for (;;) {
        sum = 0u; cnt = 0u; mine = 0u;
#pragma unroll
        for (unsigned j = 0; j < 16; ++j) { const unsigned c = xb_ld(&bar[XB_XCNT(j)]); sum += c; cnt += (c > 0u) ? 1u : 0u; mine = (j == x) ? c : mine; }
        if (sum == G) break;
        __builtin_amdgcn_s_sleep(1);
        if ((++sp & 255u) == 0u) { if (xb_ld(&bar[XB_TMO])) break; if (sp > XB_SPIN_CAP) { atomicAdd(&bar[XB_TMO], 1u); break; } }
    }
    nloc = mine > 0u ? mine : 1u; nx = cnt > 0u ? cnt : 1u;
}
__device__ __forceinline__ void xcd_barrier(const XcdBarrier& b) {
    asm volatile("s_waitcnt vmcnt(0)" ::: "memory");
    __syncthreads();
    if (threadIdx.x == 0) {
        unsigned* bar = b.bar;
        __builtin_amdgcn_s_waitcnt(0);
        unsigned nloc = b.st[0], nx = b.st[1];
        if (nloc == 0u) { xcd_barrier_complete(bar, b.x, nloc, nx); b.st[0] = nloc; b.st[1] = nx; }
        const unsigned old = xb_add(&bar[XB_XSUB(b.x)], 1u);
        const unsigned gen = old / nloc;
        if (old + 1u == (gen + 1u) * nloc) {
            __builtin_amdgcn_fence(__ATOMIC_RELEASE, "agent");
            asm volatile("s_waitcnt vmcnt(0)" ::: "memory");
            const unsigned og = xb_add(&bar[XB_TOP], 1u);
            const unsigned tg = og / nx;
            if (og + 1u == (tg + 1u) * nx) xb_add(&bar[XB_TOPGEN], 1u);
            else XB_SPIN(xb_ld(&bar[XB_TOPGEN]) == tg, bar);
            __builtin_amdgcn_fence(__ATOMIC_ACQUIRE, "agent");
            xb_add(&bar[XB_XGEN(b.x)], 1u);
            asm volatile("s_waitcnt vmcnt(0)" ::: "memory");
        } else {
            XB_SPIN(xb_ld(&bar[XB_XGEN(b.x)]) == gen, bar);
            __builtin_amdgcn_fence(__ATOMIC_ACQUIRE, "agent");
            asm volatile("s_waitcnt vmcnt(0)" ::: "memory");
        }
    }
    __syncthreads();
}

constexpr int NPHASE = 16;
__device__ void run_phase(const Params& p, int ph, unsigned char* smem, bool dost = true) {
#ifndef NO_PREP
    if (ph == 0) { phase_prep(p, smem); return; }
#endif
#ifndef NO_FINAL
    if (ph == NPHASE - 1) { phase_final(p); return; }
#endif
    const int l = (ph - 1) / 7, s = (ph - 1) % 7;
    bf16_t* Y = (bf16_t*)(p.ws + WS_Y);
    switch (s) {
#ifndef NO_NORM
    case 0: phase_norm(p, l); break;
#endif
#ifndef NO_GIN
    case 1: { EpiIn E; E.Y = Y; E.G32 = (float*)(p.ws + WS_G32); E.dost = dost;
              { SchedIn S; S.A = (const char*)(p.ws + WS_H); S.Bt = (const char*)(p.ws + WS_WIN) + (size_t)l * NPAD * DM * 2; S.G = gridDim.x; S.c = blockIdx.x; S.trim = (l == 1); S.part = 0;
                E.ps = 1.0f; pg8::Gemm g; g.lda = DM; g.ldb = DM; g.K = DM;
#ifndef T_NO_P0
                pg8::gemm_phase<EpiIn, SchedIn, false>((LAS unsigned char*)smem, g, S, E);
#endif
              }
              __syncthreads();
              { SchedIn S; S.A = (const char*)(p.ws + WS_H8); S.Bt = (const char*)(p.ws + WS_W8) + (size_t)l * NT8 * 256 * DM; S.G = gridDim.x; S.c = gridDim.x - 1 - blockIdx.x;     S.trim = (l == 1); S.part = 1;
                EpiGate8 E8; E8.Y = Y; pg8::Gemm g; g.lda = DM / 2; g.ldb = DM / 2; g.K = DM / 2;
#ifndef T_NO_P1
                pg8::gemm_phase<EpiGate8, SchedIn, true>((LAS unsigned char*)smem, g, S, E8);
#endif
              } } break;
#endif
#ifndef NO_MIX1
    case 2: phase_mix1(p, l, smem); break;
#endif
#ifndef NO_MIX2
    case 3: phase_mix2(p, l, smem); break;
#endif
#ifndef NO_MIX3
    case 4: phase_mix3(p, l); break;
#endif
#ifndef NO_MERGE
    case 5: { SchedMerge S; S.Y = (const char*)Y; S.Wbr = (const char*)(p.ws + WS_WBR) + (size_t)l * 4 * DM * BRW * 2; S.G = gridDim.x; S.c = blockIdx.x; S.nM = l == 0 ? 68 : 64;
              EpiMerge E; E.Y = Y; E.accb = (bf16_t*)(p.ws + WS_H);
              pg8::Gemm g; g.lda = NPAD; g.ldb = BRW; g.K = BRW;
              pg8::gemm_phase((LAS unsigned char*)smem, g, S, E);
              if (l == 0 && (int)blockIdx.x >= 32) { __syncthreads(); for (int u = blockIdx.x - 32; u < U_CONV1; u += gridDim.x - 32) conv_unit(p, 1, u, smem); } } break;
#endif
#ifndef NO_OUT
    case 6: { SchedOut S; S.A = (const char*)(p.ws + WS_H); S.Bt = (const char*)(p.ws + WS_WOUT) + (size_t)l * DM * DM * 2; S.G = gridDim.x; S.c = blockIdx.x; S.nM = l == 0 ? 68 : 64;
              EpiOut E; E.xin = p.x; E.ctxin = p.ctx; E.mod = (const float*)(p.ws + WS_MOD) + (size_t)l * 5 * 6144; E.X1 = (bf16_t*)(p.ws + WS_X1); E.first = (l == 0);
              pg8::Gemm g; g.lda = DM; g.ldb = DM; g.K = DM;
              pg8::gemm_phase((LAS unsigned char*)smem, g, S, E); } break;
#endif
    }
}

__global__ void __launch_bounds__(512, 2) hybrid_fwd(Params p) {
    extern __shared__ __attribute__((aligned(16))) unsigned char smem[];
    volatile LAS unsigned* st = (volatile LAS unsigned*)((LAS unsigned char*)smem + (LDS_BYTES - 16));
    if (threadIdx.x == 0) { st[0] = 0u; st[1] = 0u; }
    __syncthreads();
    const XcdBarrier xbar = xcd_barrier_post((unsigned*)(p.ws + WS_BAR), st);
    for (int ph = p.ph_lo; ph < p.ph_hi; ++ph) {
        int reps = 1;
#ifdef PROBE_REP_MASK
        if (ph > 0 && ph < NPHASE - 1 && ((PROBE_REP_MASK >> ((ph - 1) % 7)) & 1)) reps = 2;
        if (ph == 0 && (PROBE_REP_MASK & 128)) reps = 2;
#endif
        for (int r = 0; r < reps; ++r) { run_phase(p, ph, smem, r + 1 == reps || p.ph_hi > 1000); if (r + 1 < reps) xcd_barrier(xbar); }
        if (ph + 1 < p.ph_hi) { if (p.ph_hi > NPHASE) cg::this_grid().sync(); else xcd_barrier(xbar); }
#ifdef PROBE_EXTRA_SYNC
        if (ph + 1 < p.ph_hi) { for (int q = 0; q < PROBE_EXTRA_SYNC; ++q) cg::this_grid().sync(); }
#endif
    }
}


#ifdef DBG_STOP
__global__ void dbg_dump(Params p) {
    const bf16_t* Y = (const bf16_t*)(p.ws + WS_Y); const float* HM = (const float*)(p.ws + WS_HM); const bf16_t* H = (const bf16_t*)(p.ws + WS_H);
    for (size_t i = (size_t)blockIdx.x * blockDim.x + threadIdx.x; i < (size_t)NB * TL * DM; i += (size_t)gridDim.x * blockDim.x) {
        const size_t row = i / DM; const int c = (int)(i % DM);
        float s = 0.f;
#if DBG_WHAT & 1
        for (int j = 0; j < 11; ++j) { const int col = c + 2048 * j; if (col < 22016) s += bf2f(Y[row * NPAD + col]); }
#endif
#if DBG_WHAT & 2
        { const size_t k = i % ((size_t)MROWS * BRW); s += HM[k] + HM[k + (size_t)MROWS * BRW]; }
#endif
#if DBG_WHAT & 4
        s += bf2f(H[i]);
#endif
        p.out[i] = s;
    }
}
#endif
extern "C" void kernel_launch(void* const* d_in, const int* in_sizes, int n_in, void* d_out, int out_size, void* d_ws, size_t ws_size, hipStream_t stream) {
    static int grid = 0;
    if (grid == 0) {
        if (n_in != 18 || ws_size < WS_END) { fprintf(stderr, "kernel_launch: n_in %d ws %zu (need %zu)\n", n_in, ws_size, (size_t)WS_END); grid = -1; return; }
        if (hipFuncSetAttribute((const void*)hybrid_fwd, hipFuncAttributeMaxDynamicSharedMemorySize, LDS_BYTES) != hipSuccess) { fprintf(stderr, "kernel_launch: hipFuncSetAttribute failed\n"); grid = -1; return; }
        int dev = 0, cus = 0, per_cu = 0;
        hipGetDevice(&dev); hipDeviceGetAttribute(&cus, hipDeviceAttributeMultiprocessorCount, dev);
        hipOccupancyMaxActiveBlocksPerMultiprocessor(&per_cu, (const void*)hybrid_fwd, 512, LDS_BYTES);
        if (per_cu < 1) { fprintf(stderr, "kernel_launch: occupancy query says %d blocks per CU\n", per_cu); per_cu = 1; }
        (void)hipGetLastError();
        grid = cus;
    }
    if (grid < 0) return;
    Params p{};
    p.x = (const float*)d_in[0]; p.c = (const float*)d_in[1]; p.ctx = (const float*)d_in[2]; p.c_ctx = (const float*)d_in[3]; p.norm_gain = (const float*)d_in[4];
    p.w_mod = (const float*)d_in[5]; p.b_mod = (const float*)d_in[6]; p.w_in = (const float*)d_in[7]; p.q_gain = (const float*)d_in[8]; p.k_gain = (const float*)d_in[9];
    p.gate_bias = (const float*)d_in[10]; p.m_gain = (const float*)d_in[11]; p.conv_w = (const float*)d_in[12]; p.pool_w = (const float*)d_in[13]; p.pool_scale = (const float*)d_in[14];
    p.w_branch = (const float*)d_in[15]; p.w_out = (const float*)d_in[16]; p.final_gain = (const float*)d_in[17];
    p.out = (float*)d_out; p.ws = (unsigned char*)d_ws;
#ifdef DBG_STOP
    for (int ph = 0; ph < DBG_STOP; ++ph) { p.ph_lo = ph; p.ph_hi = ph + 1; hipLaunchKernelGGL(hybrid_fwd, dim3(grid), dim3(512), LDS_BYTES, stream, p); }
    hipLaunchKernelGGL(dbg_dump, dim3(2048), dim3(256), 0, stream, p);
#elif MK_PER_PHASE
    for (int ph = 0; ph < NPHASE; ++ph) {
        p.ph_lo = ph; p.ph_hi = ph + 1;
        hipLaunchKernelGGL(hybrid_fwd, dim3(grid), dim3(512), LDS_BYTES, stream, p);
    }
#else
    p.ph_lo = 0; p.ph_hi = NPHASE;
    if (hipMemsetAsync((char*)d_ws + WS_BAR, 0, 16384, stream) != hipSuccess) { fprintf(stderr, "kernel_launch: memset of barrier words failed\n"); return; }
    void* args[] = {&p};
    hipError_t e = hipLaunchCooperativeKernel((const void*)hybrid_fwd, dim3(grid), dim3(512), args, LDS_BYTES, stream);
    if (e != hipSuccess) fprintf(stderr, "cooperative launch failed: %s (grid %d)\n", hipGetErrorString(e), grid);
#endif
}
```

```cpp
#include <hip/hip_runtime.h>
#include <hip/hip_cooperative_groups.h>
#include <cstdio>
#include <cstdint>
namespace cg = cooperative_groups;

#ifndef MK_PER_PHASE
#define MK_PER_PHASE 0
#endif

#define LAS __attribute__((address_space(3)))
typedef unsigned short bf16_t;
typedef short bf16x8 __attribute__((ext_vector_type(8)));
typedef short s16x4 __attribute__((ext_vector_type(4)));
typedef float f32x4 __attribute__((ext_vector_type(4)));
typedef float f32x8 __attribute__((ext_vector_type(8)));
typedef float f32x16 __attribute__((ext_vector_type(16)));
typedef unsigned u32x4 __attribute__((ext_vector_type(4)));
typedef unsigned u32x2 __attribute__((ext_vector_type(2)));

constexpr int DM = 2048, NB = 4, TL = 4096, LC = 256, RPB = TL + LC  , MROWS = NB * RPB  ;
constexpr int NIN = 22032, NPAD = 22272, BRW = 1024;
constexpr int C_AQ = 0, C_AK = 1024, C_AV = 1280, C_AZ = 1536, C_MQ = 2560, C_MK = 3584, C_MV = 4608, C_MO = 5632, C_MZ = 6656,
              C_CU = 7680, C_CB = 8704, C_CC = 9728, C_CZ = 10752, C_PU = 11776, C_PZ = 12800, C_GM = 13824, C_MG = 22016;
constexpr int NCHUNK = RPB / 64;
constexpr float EPS = 1e-6f;

constexpr size_t WS_WIN = 0;
constexpr size_t WS_WBR = WS_WIN + (size_t)2 * NPAD * DM * 2;
constexpr size_t WS_WOUT = WS_WBR + (size_t)2 * 4 * DM * BRW * 2;
constexpr size_t WS_POOLW = WS_WOUT + (size_t)2 * DM * DM * 2;
constexpr size_t WS_MOD = WS_POOLW + (size_t)2 * 4 * 256 * 256 * 2;
constexpr size_t WS_H = WS_MOD + (size_t)2 * 5 * 6144 * 4;
constexpr size_t WS_Y = WS_H + (size_t)MROWS * DM * 2;
constexpr size_t WS_X1 = WS_Y + (size_t)MROWS * NPAD * 2;
constexpr size_t WS_H8 = WS_X1 + (size_t)MROWS * DM * 2;
constexpr size_t WS_HM = WS_X1 + (size_t)MROWS * DM * 4;
static_assert(WS_H8 + (size_t)MROWS * DM <= WS_HM, "the fp8 copy of h must fit in the free half of the X1 slot");
constexpr size_t WS_G32 = WS_HM + (size_t)2 * MROWS * BRW * 4;
constexpr size_t WS_GT4 = WS_G32 + (size_t)MROWS * 16 * 4;
constexpr size_t WS_GW = WS_GT4 + (size_t)32 * RPB * 16;
constexpr size_t WS_GD = WS_GW + (size_t)32 * RPB * 4;
constexpr size_t WS_BAR = WS_GD + (size_t)32 * 128 * 4;
constexpr int NT8 = 42;
constexpr size_t WS_W8 = WS_BAR + 16384;
constexpr size_t WS_K8 = WS_W8 + (size_t)2 * NT8 * 256 * DM;
constexpr size_t WS_V8 = WS_K8 + (size_t)MROWS * 256;
constexpr size_t WS_END = WS_V8 + (size_t)MROWS * 256;
__host__ __device__ __forceinline__ constexpr int pn_of_q8(int q) { return q < 6 ? q : (q < 10 ? 18 + (q - 6) : 54 + (q - 10)); }
__host__ __device__ __forceinline__ constexpr int pn_of_p16(int p) { return p < 12 ? 6 + p : (p < 44 ? 22 + (p - 12) : 86); }

constexpr int LDS_BYTES = 155648;

struct Params {
    const float* x; const float* c; const float* ctx; const float* c_ctx; const float* norm_gain; const float* w_mod; const float* b_mod; const float* w_in;
    const float* q_gain; const float* k_gain; const float* gate_bias; const float* m_gain; const float* conv_w; const float* pool_w; const float* pool_scale;
    const float* w_branch; const float* w_out; const float* final_gain;
    float* out; unsigned char* ws;
    int ph_lo, ph_hi;
};

__device__ __forceinline__ int otid() { int t = threadIdx.x; asm volatile("" : "+v"(t)); return t; }
__device__ __forceinline__ int obid() { int t = blockIdx.x; asm volatile("" : "+s"(t)); return t; }
typedef __bf16 bf16x2_t __attribute__((ext_vector_type(2)));
typedef float f32x2_t __attribute__((ext_vector_type(2)));
__device__ __forceinline__ unsigned cvt_pk_bf16(float lo, float hi) { f32x2_t v = {lo, hi}; bf16x2_t r = __builtin_convertvector(v, bf16x2_t); return *reinterpret_cast<unsigned*>(&r); }
__device__ __forceinline__ bf16_t f2bf(float f) { return (bf16_t)(cvt_pk_bf16(f, 0.f) & 0xffffu); }
__device__ __forceinline__ float bf2f(bf16_t b) { return __uint_as_float(((unsigned)b) << 16); }
__device__ __forceinline__ float bflo(unsigned w) { return __uint_as_float(w << 16); }
__device__ __forceinline__ float bfhi(unsigned w) { return __uint_as_float(w & 0xffff0000u); }
__device__ __forceinline__ float sigmoidf_(float x) { return __builtin_amdgcn_rcpf(1.0f + __builtin_amdgcn_exp2f(-1.4426950408889634f * x)); }
__device__ __forceinline__ float siluf_(float x) { return x * sigmoidf_(x); }
__device__ __forceinline__ float fexp(float x) { return __builtin_amdgcn_exp2f(1.4426950408889634f * x); }
__device__ __forceinline__ void unpack8(const u32x4 w, float (&f)[8]) { f[0] = bflo(w.x); f[1] = bfhi(w.x); f[2] = bflo(w.y); f[3] = bfhi(w.y); f[4] = bflo(w.z); f[5] = bfhi(w.z); f[6] = bflo(w.w); f[7] = bfhi(w.w); }
__device__ __forceinline__ u32x4 pack8(const float (&f)[8]) { u32x4 w; w.x = cvt_pk_bf16(f[0], f[1]); w.y = cvt_pk_bf16(f[2], f[3]); w.z = cvt_pk_bf16(f[4], f[5]); w.w = cvt_pk_bf16(f[6], f[7]); return w; }

namespace pg8 {
constexpr int BM = 256, BK = 64, HALF = 128, HTB = HALF * BK * 2, STAGE_BYTES = 8 * HTB, NXCD = 8, WGM = 8;
__host__ __device__ __forceinline__ int lds_byte(int r, int c) { const int st = (r >> 4) * 2 + (c >> 5), rr = r & 15, cc = c & 31, ob = rr * 64 + cc * 2; return st * 1024 + (ob ^ (((ob >> 9) & 1) << 5)); }
__host__ __device__ __forceinline__ void stage_rc(int b, int& R, int& C) { const int st = b / 1024, sb = b % 1024, swz = sb ^ (((sb >> 9) & 1) << 5); R = (st >> 1) * 16 + swz / 64; C = (st & 1) * 32 + (swz % 64) / 2; }
__host__ __device__ __forceinline__ int perm32(int rho) { const int n = rho >> 4, i = rho & 15; return 8 * (i >> 2) + 4 * n + (i & 3); }

struct Unit { const char* a; const char* b; int pm, pn, tag; };
struct Gemm { int lda, ldb, K; };

__device__ __forceinline__ bool static_tile(int nM, int nN, long L, int& pm, int& pn) {
    const int nwg = nM * nN; if (L >= nwg) return false;
    int wgid = (int)L; { const int q = nwg / NXCD, r = nwg % NXCD, xcd = wgid % NXCD, off = wgid / NXCD; wgid = (xcd < r ? xcd * (q + 1) : r * (q + 1) + (xcd - r) * q) + off; }
    const int nig = WGM * nN, gid = wgid / nig, fm = gid * WGM, gsz = (nM - fm) < WGM ? (nM - fm) : WGM;
    pm = fm + ((wgid % nig) % gsz); pn = (wgid % nig) / gsz; return true;
}

typedef int v4i_t __attribute__((ext_vector_type(4)));
typedef int v8i_t __attribute__((ext_vector_type(8)));
template <bool F8> struct Frag;
template <> struct Frag<false> { bf16x8 h[2]; __device__ __forceinline__ void set(int k, bf16x8 x) { h[k] = x; } };
template <> struct Frag<true>  { v8i_t v;     __device__ __forceinline__ void set(int k, bf16x8 x) { const v4i_t q = __builtin_bit_cast(v4i_t, x); if (k == 0) v.lo = q; else v.hi = q; } };
template <class Epi, class Sched, bool FP8 = false>
__device__ __forceinline__ void gemm_phase(LAS unsigned char* lds, const Gemm g, const Sched& S, const Epi& E) {
    const int tid = otid(), wid = __builtin_amdgcn_readfirstlane(tid >> 6), lane = tid & 63, wr = wid >> 2, wc = wid & 3, fr = lane & 15, fq = lane >> 4;
    const int K = g.K, nt = K / BK;
    unsigned voffA[2], voffB[2];
#pragma unroll
    for (int i = 0; i < 2; ++i) { int R, C; stage_rc(tid * 16 + i * 8192, R, C); const int Rb = Epi::PERM ? ((R & ~31) + perm32(R & 31)) : R;
        voffA[i] = (unsigned)(R * g.lda + C) * 2u; voffB[i] = (unsigned)(Rb * g.ldb + C) * 2u; }
    const size_t kstep = (size_t)(BK * 2);
    const size_t hstepA = (size_t)HALF * g.lda * 2, hstepB = (size_t)HALF * g.ldb * 2;
    const unsigned ldsw = (unsigned)wid * 1024u;
    const int aoff = lds_byte(wr * 64 + fr, fq * 8), boff = lds_byte(wc * 32 + fr, fq * 8);
#define PG8_SA(b, h) (((b) * 2 + (h)) * HTB)
#define PG8_SB(b, h) ((4 + (b) * 2 + (h)) * HTB)
#define PG8_STAGE(bufoff, gbase, voff) do { _Pragma("unroll") for (int _i = 0; _i < 2; ++_i) \
        __builtin_amdgcn_global_load_lds((const unsigned*)((const char*)(gbase) + (voff)[_i]), (LAS unsigned*)(lds + (bufoff) + ldsw + _i * 8192), 16, 0, 0); } while (0)
#define PG8_LDA(dst, b, h) do { _Pragma("unroll") for (int m = 0; m < 4; ++m) _Pragma("unroll") for (int k = 0; k < 2; ++k) dst[m].set(k, *(const LAS bf16x8*)(lds + PG8_SA(b, h) + aoff + m * 2048 + k * 1024)); } while (0)
#define PG8_LDB(dst, b, h) do { _Pragma("unroll") for (int n = 0; n < 2; ++n) _Pragma("unroll") for (int k = 0; k < 2; ++k) dst[n].set(k, *(const LAS bf16x8*)(lds + PG8_SB(b, h) + boff + n * 2048 + k * 1024)); } while (0)
#define PG8_MMA(ai, bj, At, Bt) do { __builtin_amdgcn_s_setprio(1); _Pragma("unroll") for (int m = 0; m < 4; ++m) _Pragma("unroll") for (int n = 0; n < 2; ++n) { \
        if constexpr (FP8)   \
            asm volatile("v_mfma_f32_16x16x128_f8f6f4 %0, %1, %2, %0" : "+v"(acc[ai][bj][m][n]) : "v"(Bt[n].v), "v"(At[m].v));   \
        else { _Pragma("unroll") for (int k = 0; k < 2; ++k) acc[ai][bj][m][n] = __builtin_amdgcn_mfma_f32_16x16x32_bf16(Bt[n].h[k], At[m].h[k], acc[ai][bj][m][n], 0, 0, 0); } } \
        __builtin_amdgcn_s_setprio(0); } while (0)
#define PG8_WAIT_V(n) asm volatile("s_waitcnt vmcnt(" #n ")" ::: "memory")
#define PG8_WAIT_L(n) asm volatile("s_waitcnt lgkmcnt(" #n ")" ::: "memory")
#define PG8_BAR __builtin_amdgcn_s_barrier()
#define PG8_SCHED __builtin_amdgcn_sched_barrier(0)
    Unit cur, nxt; int ui = 0;
    if (!S.next(0, cur)) return;
    f32x4 acc[2][2][4][2];
#pragma unroll
    for (int a = 0; a < 2; ++a)
#pragma unroll
        for (int b = 0; b < 2; ++b)
#pragma unroll
            for (int m = 0; m < 4; ++m)
#pragma unroll
                for (int n = 0; n < 2; ++n) acc[a][b][m][n] = (f32x4){0.f, 0.f, 0.f, 0.f};
    Frag<FP8> At[4], B0[2], B1[2];
    const char* cA = cur.a; const char* cB = cur.b;
    PG8_STAGE(PG8_SB(0, 0), cB, voffB); PG8_STAGE(PG8_SA(0, 0), cA, voffA); PG8_STAGE(PG8_SB(0, 1), cB + hstepB, voffB); PG8_STAGE(PG8_SA(0, 1), cA + hstepA, voffA);
    if (wr == 1) PG8_BAR;
    PG8_WAIT_V(4); PG8_BAR;
    PG8_STAGE(PG8_SB(1, 0), cB + kstep, voffB); PG8_STAGE(PG8_SA(1, 0), cA + kstep, voffA); PG8_STAGE(PG8_SB(1, 1), cB + hstepB + kstep, voffB);
    PG8_WAIT_V(6); PG8_BAR;
    for (;;) {
        const bool has_next = S.next(ui + 1, nxt);
        const char* nA = has_next ? nxt.a : cA; const char* nB = has_next ? nxt.b : cB;
        for (int t = 0; t < nt; t += 2) {
            const bool last = (t == nt - 2);
            const char* a1 = cA + (size_t)(t + 1) * kstep;
            const char* a2 = last ? nA : cA + (size_t)(t + 2) * kstep; const char* b2 = last ? nB : cB + (size_t)(t + 2) * kstep;
            const char* a3 = a2 + kstep; const char* b3 = b2 + kstep;
            PG8_LDB(B0, 0, 0); PG8_SCHED; PG8_LDA(At, 0, 0); PG8_STAGE(PG8_SA(1, 1), a1 + hstepA, voffA);
            PG8_WAIT_L(8); PG8_BAR; PG8_WAIT_L(0); PG8_MMA(0, 0, At, B0); PG8_BAR; PG8_SCHED;
            PG8_LDB(B1, 0, 1); PG8_STAGE(PG8_SB(0, 0), b2, voffB);
            PG8_BAR; PG8_WAIT_L(0); PG8_MMA(0, 1, At, B1); PG8_BAR;
            PG8_LDA(At, 0, 1); PG8_STAGE(PG8_SA(0, 0), a2, voffA);
            PG8_BAR; PG8_WAIT_L(0); PG8_MMA(1, 0, At, B0); PG8_BAR; PG8_SCHED;
            PG8_STAGE(PG8_SB(0, 1), b2 + hstepB, voffB);
            PG8_WAIT_V(6); PG8_BAR; PG8_MMA(1, 1, At, B1); PG8_BAR;
            PG8_LDB(B0, 1, 0); PG8_SCHED; PG8_LDA(At, 1, 0); PG8_STAGE(PG8_SA(0, 1), a2 + hstepA, voffA);
            PG8_WAIT_L(8); PG8_BAR; PG8_WAIT_L(0); PG8_MMA(0, 0, At, B0); PG8_BAR; PG8_SCHED;
            PG8_LDB(B1, 1, 1); PG8_STAGE(PG8_SB(1, 0), b3, voffB);
            PG8_BAR; PG8_WAIT_L(0); PG8_MMA(0, 1, At, B1); PG8_BAR;
            PG8_LDA(At, 1, 1); PG8_STAGE(PG8_SA(1, 0), a3, voffA);
            PG8_BAR; PG8_WAIT_L(0); PG8_MMA(1, 0, At, B0); PG8_BAR; PG8_SCHED;
            PG8_STAGE(PG8_SB(1, 1), b3 + hstepB, voffB);
            PG8_WAIT_V(6); PG8_BAR; PG8_MMA(1, 1, At, B1); PG8_BAR;
        }
        if constexpr (FP8) asm volatile("s_nop 15\n\ts_nop 15" ::: "memory");
        E(acc, cur, wr, wc, fr, fq);
        if (!has_next) break;
#pragma unroll
        for (int a = 0; a < 2; ++a)
#pragma unroll
            for (int b = 0; b < 2; ++b)
#pragma unroll
                for (int m = 0; m < 4; ++m)
#pragma unroll
                    for (int n = 0; n < 2; ++n) acc[a][b][m][n] = (f32x4){0.f, 0.f, 0.f, 0.f};
        cur = nxt; cA = nA; cB = nB; ++ui;
    }
    PG8_WAIT_V(0);
    if (wr == 0) PG8_BAR;
    PG8_BAR;
#undef PG8_SA
#undef PG8_SB
#undef PG8_STAGE
#undef PG8_LDA
#undef PG8_LDB
#undef PG8_MMA
#undef PG8_WAIT_V
#undef PG8_WAIT_L
#undef PG8_BAR
#undef PG8_SCHED
}
}


struct SchedIn {
    const char* A; const char* Bt; int G, c, trim, part;
    __device__ __forceinline__ bool next(int i, pg8::Unit& u) const {
        int pm, pn, q = 0; const long L = (long)i * G + c;
        const int nN = part ? NT8 : 45, nM = trim ? 64 : MROWS / 256;
        if (L < (long)nM * nN) { pg8::static_tile(nM, nN, L, pm, pn); if (trim) pm += pm / 16; q = pn; pn = part ? pn_of_q8(pn) : pn_of_p16(pn); }
        else { if (!trim) return false; const int idx = (int)(L - (long)nM * nN);
            if (part) { if (idx >= 4 * 6) return false; const int k = idx % 6; pm = 17 * (idx / 6) + 16; q = 4 + k; pn = pn_of_q8(q); }
            else { if (idx >= 4 * 9) return false; const int k = idx % 9; pm = 17 * (idx / 9) + 16; pn = k < 8 ? 10 + k : 86; } }
        u.pm = pm; u.pn = pn; u.tag = 0;
        if (part) { u.a = A + (size_t)pm * 256 * DM; u.b = Bt + (size_t)q * 256 * DM; }
        else { u.a = A + (size_t)pm * 256 * DM * 2; u.b = Bt + (size_t)pn * 256 * DM * 2; }
        return true; }
};
struct EpiIn {
    static constexpr bool PERM = true;
    bf16_t* Y; float* G32; bool dost; float ps;
    __device__ __forceinline__ void operator()(const f32x4 (&acc)[2][2][4][2], const pg8::Unit& u, int wr, int wc, int fr, int fq) const {
        if (!dost) return;
        const int pn = u.pn;
        int opq = 0; asm volatile("" : "+v"(opq));
        const int row0 = u.pm * 256 + wr * 64 + fr + opq;
        if (pn == 86) {
            if (wc == 0 && fq < 2) {
#pragma unroll
                for (int ai = 0; ai < 2; ++ai)
#pragma unroll
                    for (int m = 0; m < 4; ++m) { float* gp = G32 + (size_t)(row0 + ai * 128 + m * 16) * 16 + 8 * fq;
                        *(f32x4*)gp = acc[ai][0][m][0]; *(f32x4*)(gp + 4) = acc[ai][0][m][1]; }
            }
            return;
        }
        int act = 0;
        if ((pn >= 6 && pn < 10) || (pn >= 26 && pn < 30) || (pn >= 42 && pn < 46) || (pn >= 50 && pn < 54)) act = 1;
        else if ((pn >= 22 && pn < 26) || pn >= 54) act = 2;
        const int col0 = pn * 256 + wc * 32 + 8 * fq;
#pragma unroll
        for (int ai = 0; ai < 2; ++ai)
#pragma unroll
            for (int m = 0; m < 4; ++m) { bf16_t* rowp = Y + (size_t)(row0 + ai * 128 + m * 16) * NPAD + col0;
#pragma unroll
                for (int bj = 0; bj < 2; ++bj) { f32x4 v0 = acc[ai][bj][m][0], v1 = acc[ai][bj][m][1];
                    if (act == 1) {
#pragma unroll
                        for (int j = 0; j < 4; ++j) { v0[j] = siluf_(v0[j]); v1[j] = siluf_(v1[j]); } }
                    else if (act == 2) {
#pragma unroll
                        for (int j = 0; j < 4; ++j) { v0[j] = sigmoidf_(v0[j] * ps); v1[j] = sigmoidf_(v1[j] * ps); } }
                    u32x4 w; w.x = cvt_pk_bf16(v0[0], v0[1]); w.y = cvt_pk_bf16(v0[2], v0[3]); w.z = cvt_pk_bf16(v1[0], v1[1]); w.w = cvt_pk_bf16(v1[2], v1[3]);
                    *(u32x4*)(rowp + bj * 128) = w; } }
    }
};

struct EpiGate8 {
    static constexpr bool PERM = true;
    bf16_t* Y;
    __device__ __forceinline__ void operator()(const f32x4 (&acc)[2][2][4][2], const pg8::Unit& u, int wr, int wc, int fr, int fq) const {
        int opq = 0; asm volatile("" : "+v"(opq));
        const int row0 = u.pm * 256 + wr * 64 + fr + opq, col0 = u.pn * 256 + wc * 32 + 8 * fq; const bool gate = u.pn >= 54;
#pragma unroll
        for (int ai = 0; ai < 2; ++ai)
#pragma unroll
            for (int m = 0; m < 4; ++m) { bf16_t* rowp = Y + (size_t)(row0 + ai * 128 + m * 16) * NPAD + col0;
#pragma unroll
                for (int bj = 0; bj < 2; ++bj) { float o[8];
#pragma unroll
                    for (int j = 0; j < 4; ++j) { const float x0 = acc[ai][bj][m][0][j] * (1.0f / 64.0f), x1 = acc[ai][bj][m][1][j] * (1.0f / 64.0f); o[j] = gate ? sigmoidf_(x0) : x0; o[4 + j] = gate ? sigmoidf_(x1) : x1; }
                    *(u32x4*)(rowp + bj * 128) = pack8(o); } }
    }
};
struct SchedPool {
    const char* A; const char* Bt; int G, c, i0;
    __device__ __forceinline__ bool next(int i, pg8::Unit& u) const {
        const long L = (long)i * G + c; if (L >= (MROWS / 256) * 4) return false;
        const int pm = (int)(L >> 2), g = (int)(L & 3);
        u.pm = pm; u.pn = g; u.tag = 0; u.a = A + ((size_t)pm * 256 * BRW + g * 256) * 2; u.b = Bt + (size_t)g * 256 * 256 * 2; return true; }
};
struct EpiPool {
    static constexpr bool PERM = true;
    bf16_t* Y;
    __device__ __forceinline__ void operator()(const f32x4 (&acc)[2][2][4][2], const pg8::Unit& u, int wr, int wc, int fr, int fq) const {
        int opq = 0; asm volatile("" : "+v"(opq));
        const int row0 = u.pm * 256 + wr * 64 + fr + opq, colc = u.pn * 256 + wc * 32 + 8 * fq;
#pragma unroll
        for (int ai = 0; ai < 2; ++ai) {
            u32x4 zw[4][2];
#pragma unroll
            for (int m = 0; m < 4; ++m)
#pragma unroll
                for (int bj = 0; bj < 2; ++bj) zw[m][bj] = *(const u32x4*)(Y + (size_t)(row0 + ai * 128 + m * 16) * NPAD + C_PZ + colc + bj * 128);
#pragma unroll
            for (int m = 0; m < 4; ++m)
#pragma unroll
                for (int bj = 0; bj < 2; ++bj) { float z[8]; unpack8(zw[m][bj], z);
                    const f32x4 v0 = acc[ai][bj][m][0], v1 = acc[ai][bj][m][1]; float o[8];
#pragma unroll
                    for (int j = 0; j < 4; ++j) { o[j] = v0[j] * z[j]; o[4 + j] = v1[j] * z[4 + j]; }
                    *(u32x4*)(Y + (size_t)(row0 + ai * 128 + m * 16) * NPAD + C_PZ + colc + bj * 128) = pack8(o); }
            asm volatile("" ::: "memory"); }
    }
};

struct SchedMerge {
    const char* Y; const char* Wbr; int G, c, nM;
    __device__ __forceinline__ bool next(int i, pg8::Unit& u) const {
        const long L = (long)(i >> 2) * G + c; const int br = i & 3; if (L >= (long)nM * 8) return false;
        const int pm = (int)(L >> 3), pn = (int)(L & 7);
        const int pmr = (nM == 64) ? (pm + pm / 16) : pm;
        const int coff = br == 0 ? C_AQ : (br == 1 ? C_MO : (br == 2 ? C_CZ : C_PZ));
        u.pm = pmr; u.pn = pn; u.tag = br; u.a = Y + ((size_t)pmr * 256 * NPAD + coff) * 2; u.b = Wbr + ((size_t)br * DM * BRW + (size_t)pn * 256 * BRW) * 2; return true; }
};
struct EpiMerge {
    static constexpr bool PERM = true;
    const bf16_t* Y; bf16_t* accb;
    __device__ __forceinline__ void operator()(const f32x4 (&acc)[2][2][4][2], const pg8::Unit& u, int wr, int wc, int fr, int fq) const {
        int opq = 0; asm volatile("" : "+v"(opq));
        const int row0 = u.pm * 256 + wr * 64 + fr + opq, col0 = u.pn * 256 + wc * 32 + 8 * fq, tag = u.tag;
#pragma unroll
        for (int ai = 0; ai < 2; ++ai) {
            u32x4 gw[4][2], pw[4][2];
#pragma unroll
            for (int m = 0; m < 4; ++m) { const size_t row = (size_t)(row0 + ai * 128 + m * 16);
#pragma unroll
                for (int bj = 0; bj < 2; ++bj) { gw[m][bj] = *(const u32x4*)(Y + row * NPAD + C_GM + tag * DM + col0 + bj * 128);
                    pw[m][bj] = tag != 0 ? *(const u32x4*)(accb + row * DM + col0 + bj * 128) : (u32x4){0u, 0u, 0u, 0u}; } }
#pragma unroll
            for (int m = 0; m < 4; ++m) { const size_t row = (size_t)(row0 + ai * 128 + m * 16);
#pragma unroll
                for (int bj = 0; bj < 2; ++bj) { float gt[8], pv[8]; unpack8(gw[m][bj], gt); unpack8(pw[m][bj], pv);
                    const f32x4 v0 = acc[ai][bj][m][0], v1 = acc[ai][bj][m][1]; float o[8];
#pragma unroll
                    for (int j = 0; j < 4; ++j) { o[j] = v0[j] * gt[j] + pv[j]; o[4 + j] = v1[j] * gt[4 + j] + pv[4 + j]; }
                    *(u32x4*)(accb + row * DM + col0 + bj * 128) = pack8(o); } }
            asm volatile("" ::: "memory"); }
    }
};

struct SchedOut {
    const char* A; const char* Bt; int G, c, nM;
    __device__ __forceinline__ bool next(int i, pg8::Unit& u) const {
        const long L = (long)i * G + c; if (L >= (long)nM * 8) return false;
        const int pm = (int)(L >> 3), pn = (int)(L & 7);
        const int pmr = (nM == 64) ? (pm + pm / 16) : pm;
        u.pm = pmr; u.pn = pn; u.tag = 0; u.a = A + (size_t)pmr * 256 * DM * 2; u.b = Bt + (size_t)pn * 256 * DM * 2; return true; }
};
struct EpiOut {
    static constexpr bool PERM = false;
    const float* xin; const float* ctxin;
    const float* mod;
    bf16_t* X1; int first;
    __device__ __forceinline__ void operator()(const f32x4 (&acc)[2][2][4][2], const pg8::Unit& u, int wr, int wc, int fr, int fq) const {
        const int b = u.pm / 17, j = u.pm % 17; const bool isctx = (j == 16);
        int opq = 0; asm volatile("" : "+v"(opq));
        const int rin = wr * 64 + fr + opq;
        const int col0 = u.pn * 256 + wc * 32 + 4 * fq;
        const float* gtp = mod + (size_t)(isctx ? 4 : b) * 6144 + 4096 + col0;
        const float* resb = isctx ? ctxin + (size_t)b * LC * DM : xin + ((size_t)b * TL + (size_t)j * 256) * DM;
        bf16_t* xb = X1 + (size_t)u.pm * 256 * DM;
        f32x4 gv[2][2];
#pragma unroll
        for (int bj = 0; bj < 2; ++bj)
#pragma unroll
            for (int n = 0; n < 2; ++n) gv[bj][n] = *(const f32x4*)(gtp + bj * 128 + n * 16);
#pragma unroll
        for (int ai = 0; ai < 2; ++ai) {
            f32x4 rv[4][2][2];
#pragma unroll
            for (int m = 0; m < 4; ++m) { const size_t off = (size_t)(rin + ai * 128 + m * 16) * DM + col0;
#pragma unroll
                for (int bj = 0; bj < 2; ++bj)
#pragma unroll
                    for (int n = 0; n < 2; ++n) {
                        if (first) rv[m][bj][n] = *(const f32x4*)(resb + off + bj * 128 + n * 16);
                        else { const u32x2 w = *(const u32x2*)(xb + off + bj * 128 + n * 16); rv[m][bj][n] = (f32x4){bflo(w.x), bfhi(w.x), bflo(w.y), bfhi(w.y)}; } } }
#pragma unroll
            for (int m = 0; m < 4; ++m) { const size_t off = (size_t)(rin + ai * 128 + m * 16) * DM + col0;
#pragma unroll
                for (int bj = 0; bj < 2; ++bj)
#pragma unroll
                    for (int n = 0; n < 2; ++n) { const f32x4 o = rv[m][bj][n] + gv[bj][n] * acc[ai][bj][m][n];
                        u32x2 w; w.x = cvt_pk_bf16(o[0], o[1]); w.y = cvt_pk_bf16(o[2], o[3]); *(u32x2*)(xb + off + bj * 128 + n * 16) = w; } }
            asm volatile("" ::: "memory"); }
    }
};

namespace att {
using pg8::v4i_t; using pg8::v8i_t;
constexpr int D = 128, NW = 8, QBLK = 32, KVBLK = 64;
constexpr float SCALE = 0.088388347648318440f;
constexpr float THR = 5.f;
constexpr int LDQ = NPAD, LDK = NPAD;
constexpr size_t SHM_V = KVBLK * D * 2, SHM_K = KVBLK * D * 2, SHM_ATTN = 2 * SHM_V + 2 * SHM_K + NW * 64 * 4;
#define KSWZ(row, colB) ((row) * 256 + ((colB) ^ (((row) & 7) << 4)))
#define SBAR() __builtin_amdgcn_sched_barrier(0)
__device__ __forceinline__ int crow(int r, int hi) { return (r & 3) + 8 * (r >> 2) + 4 * hi; }
__device__ __forceinline__ void partialSM(f32x16& p0, f32x16& p1, float& m_reg, float& mn, float& alpha) {
  constexpr float C = SCALE * 1.4426950408889634f;
  float pmax = p0[0]; for (int r = 1; r < 16; ++r) pmax = fmaxf(pmax, p0[r]); for (int r = 0; r < 16; ++r) pmax = fmaxf(pmax, p1[r]);
  { auto rr = __builtin_amdgcn_permlane32_swap(__float_as_uint(pmax), __float_as_uint(pmax), false, false);
    pmax = fmaxf(__uint_as_float(rr[0]), __uint_as_float(rr[1])); }
  if (__builtin_expect(__all(pmax - m_reg <= THR / SCALE), 1)) { mn = m_reg; alpha = 1.f; }
  else { mn = fmaxf(m_reg, pmax); alpha = __builtin_amdgcn_exp2f((m_reg - mn) * C); m_reg = mn; }
  float mnC = -mn * C;
  for (int r = 0; r < 16; ++r) p0[r] = fmaf(p0[r], C, mnC); for (int r = 0; r < 16; ++r) p1[r] = fmaf(p1[r], C, mnC);
  for (int r = 0; r < 16; ++r) p0[r] = __builtin_amdgcn_exp2f(p0[r]);
}
__device__ __forceinline__ void finishSM(f32x16& p0, f32x16& p1, float alpha, float& l_reg, v8i_t& p8) {
  for (int r = 0; r < 16; ++r) p1[r] = __builtin_amdgcn_exp2f(p1[r]);
  float ps = 0; for (int r = 0; r < 16; ++r) ps += p0[r]; for (int r = 0; r < 16; ++r) ps += p1[r];
  { auto rr = __builtin_amdgcn_permlane32_swap(__float_as_uint(ps), __float_as_uint(ps), false, false);
    ps = __uint_as_float(rr[0]) + __uint_as_float(rr[1]); }
  l_reg = l_reg * alpha + ps;
#pragma unroll
  for (int i = 0; i < 4; ++i) { int w = __builtin_amdgcn_cvt_pk_fp8_f32(p0[4 * i], p0[4 * i + 1], 0, false); w = __builtin_amdgcn_cvt_pk_fp8_f32(p0[4 * i + 2], p0[4 * i + 3], w, true); p8[i] = w;
    int v = __builtin_amdgcn_cvt_pk_fp8_f32(p1[4 * i], p1[4 * i + 1], 0, false); v = __builtin_amdgcn_cvt_pk_fp8_f32(p1[4 * i + 2], p1[4 * i + 3], v, true); p8[4 + i] = v; }
}
#define KSWZ8(row, colB) ((row) * 128 + ((colB) ^ (((row) & 7) << 4)))
__device__ __forceinline__ u32x2 bf8x_to_fp8(bf16x8 x) {
  const u32x4 w = __builtin_bit_cast(u32x4, x);
  int lo = __builtin_amdgcn_cvt_pk_fp8_f32(bflo(w.x), bfhi(w.x), 0, false); lo = __builtin_amdgcn_cvt_pk_fp8_f32(bflo(w.y), bfhi(w.y), lo, true);
  int hi = __builtin_amdgcn_cvt_pk_fp8_f32(bflo(w.z), bfhi(w.z), 0, false); hi = __builtin_amdgcn_cvt_pk_fp8_f32(bflo(w.w), bfhi(w.w), hi, true);
  return (u32x2){(unsigned)lo, (unsigned)hi};
}
__device__ __forceinline__ void qkt(f32x16& p0, f32x16& p1, const char* Ks, const v8i_t* q8, int r32, int hi) {
  const int c0 = 32 * hi, c1 = 64 + 32 * hi;
  const v8i_t a00 = __builtin_shufflevector(*(const v4i_t*)(Ks + KSWZ8(r32, c0)), *(const v4i_t*)(Ks + KSWZ8(r32, c0 + 16)), 0, 1, 2, 3, 4, 5, 6, 7);
  const v8i_t a10 = __builtin_shufflevector(*(const v4i_t*)(Ks + KSWZ8(32 + r32, c0)), *(const v4i_t*)(Ks + KSWZ8(32 + r32, c0 + 16)), 0, 1, 2, 3, 4, 5, 6, 7);
  const v8i_t a01 = __builtin_shufflevector(*(const v4i_t*)(Ks + KSWZ8(r32, c1)), *(const v4i_t*)(Ks + KSWZ8(r32, c1 + 16)), 0, 1, 2, 3, 4, 5, 6, 7);
  const v8i_t a11 = __builtin_shufflevector(*(const v4i_t*)(Ks + KSWZ8(32 + r32, c1)), *(const v4i_t*)(Ks + KSWZ8(32 + r32, c1 + 16)), 0, 1, 2, 3, 4, 5, 6, 7);
  asm volatile("v_mfma_f32_32x32x64_f8f6f4 %0, %1, %2, 0" : "=&v"(p0) : "v"(a00), "v"(q8[0]));
  asm volatile("v_mfma_f32_32x32x64_f8f6f4 %0, %1, %2, 0" : "=&v"(p1) : "v"(a10), "v"(q8[0]));
  asm volatile("v_mfma_f32_32x32x64_f8f6f4 %0, %1, %2, %0" : "+v"(p0) : "v"(a01), "v"(q8[1]));
  asm volatile("v_mfma_f32_32x32x64_f8f6f4 %0, %1, %2, %0\n\ts_nop 15\n\ts_nop 15" : "+v"(p1) : "v"(a11), "v"(q8[1]));
}
__device__ __forceinline__ int v_st(int k, int c) { const int kk = (k & ~0xC) | ((k & 4) << 1) | ((k & 8) >> 1); return ((kk >> 3) * 4 + (c >> 5)) * 512 + ((kk & 7) * 32 + (c & 31)) * 2; }
__device__ __forceinline__ int v_rd_base(int lane) { return ((lane & 3) << 3) | (((lane >> 2) & 3) << 6) | (((lane >> 4) & 1) << 5) | (((lane >> 5) & 1) << 8); }
constexpr int v_rd_off(int d0, int ks, int half) { return d0 * 512 + ks * 4096 + half * 2048; }
template <int OFF> __device__ __forceinline__ s16x4 tr_read(int vb) {
  s16x4 r; asm volatile("ds_read_b64_tr_b16 %0, %1 offset:%2" : "=&v"(r) : "v"(vb), "i"(OFF) : "memory"); return r;
}
__device__ __forceinline__ void pv_d0(f32x16* o, const char* Vs, v8i_t p8, int r32, int hi) {
  v8i_t vb[4];
#pragma unroll
  for (int d0 = 0; d0 < 4; ++d0) { const char* vp = Vs + (32 * d0 + r32) * 80 + 32 * hi;
    vb[d0] = __builtin_shufflevector(*(const v4i_t*)vp, *(const v4i_t*)(vp + 16), 0, 1, 2, 3, 4, 5, 6, 7); }
  asm volatile("s_nop 4\n\tv_mfma_f32_32x32x64_f8f6f4 %0, %1, %2, %0" : "+v"(o[0]) : "v"(p8), "v"(vb[0]));
  asm volatile("v_mfma_f32_32x32x64_f8f6f4 %0, %1, %2, %0" : "+v"(o[1]) : "v"(p8), "v"(vb[1]));
  asm volatile("v_mfma_f32_32x32x64_f8f6f4 %0, %1, %2, %0" : "+v"(o[2]) : "v"(p8), "v"(vb[2]));
  asm volatile("v_mfma_f32_32x32x64_f8f6f4 %0, %1, %2, %0\n\ts_nop 15\n\ts_nop 15" : "+v"(o[3]) : "v"(p8), "v"(vb[3]));
}
__device__ __forceinline__ void attn_dense_body(bf16_t* __restrict__ Qb, const unsigned char* __restrict__ K8h, const unsigned char* __restrict__ V8t, const bf16_t* __restrict__ Zb, int seq, char* lds) {
  const int tid = otid(), wid = tid >> 6, lane = tid & 63, r32 = lane & 31, hi = lane >> 5;
  bf16_t* V_lds = (bf16_t*)lds; bf16_t* K_lds = (bf16_t*)(lds + 2 * SHM_V);
  float* ws = (float*)(lds + 2 * SHM_V + 2 * SHM_K) + wid * 64; float* li_l = ws; float* al_l = ws + 32;
  float m_reg = -1e30f, l_reg = 0; f32x16 o[4] = {}; v8i_t qr[2];
  const bf16_t* Qw = Qb + (long)(wid * QBLK + r32) * LDQ + hi * 32;
#pragma unroll
  for (int j = 0; j < 2; ++j) { u32x2 c[4];
#pragma unroll
    for (int e = 0; e < 4; ++e) c[e] = bf8x_to_fp8(*reinterpret_cast<const bf16x8*>(Qw + j * 64 + e * 8));
    qr[j] = (v8i_t){(int)c[0].x, (int)c[0].y, (int)c[1].x, (int)c[1].y, (int)c[2].x, (int)c[2].y, (int)c[3].x, (int)c[3].y}; }
  const int sr = tid >> 4, sc = (tid & 15) * 8;
  struct { u32x4 vs0; u32x2 ks0, ks1; } sr_[2];
#define SLOAD(i, k0) do { sr_[i].vs0 = *reinterpret_cast<const u32x4*>(V8t + (long)((k0) >> 6) * 8192 + tid * 16); \
    sr_[i].ks0 = *reinterpret_cast<const u32x2*>(K8h + (long)((k0) + sr) * 256 + sc); sr_[i].ks1 = *reinterpret_cast<const u32x2*>(K8h + (long)((k0) + 32 + sr) * 256 + sc); } while (0)
#define SWRITE(b, i) do { *(u32x4*)((char*)V_lds + (b) * SHM_V + (tid >> 2) * 80 + (tid & 3) * 16) = sr_[i].vs0;          \
    *(u32x2*)((char*)K_lds + (b) * SHM_K + KSWZ8(sr, sc)) = sr_[i].ks0;                       \
    *(u32x2*)((char*)K_lds + (b) * SHM_K + KSWZ8(32 + sr, sc)) = sr_[i].ks1; } while (0)
#define SWAIT() do { asm volatile("s_waitcnt vmcnt(3)" ::: "memory"); } while (0)
#define RESC(a) do { if (__any((a) < 1.f)) { if (hi == 0) al_l[r32] = (a); asm volatile("s_waitcnt lgkmcnt(0)" ::: "memory"); \
    for (int d = 0; d < 4; ++d) for (int r = 0; r < 16; ++r) o[d][r] *= al_l[crow(r, hi)]; } } while (0)
  f32x16 pA0, pA1, pB0, pB1; float mnA, mnB, alA, alB; v8i_t p8; const int NT = seq / KVBLK;
  constexpr int SE = 0, SO = 1;
  SLOAD(SE, 0); asm volatile("s_waitcnt vmcnt(0)" ::: "memory"); SWRITE(0, SE); __syncthreads();
  qkt(pA0, pA1, (const char*)K_lds, qr, r32, hi); partialSM(pA0, pA1, m_reg, mnA, alA);
  SLOAD(SO, KVBLK); { if (2 < NT) SLOAD(SE, 2 * KVBLK); }
  SWAIT(); SWRITE(1, SO); __syncthreads();
  for (int j = 1; j + 1 < NT; j += 2) {
    SBAR(); qkt(pB0, pB1, (const char*)K_lds + SHM_K, qr, r32, hi);
    finishSM(pA0, pA1, alA, l_reg, p8); SBAR();
    SLOAD(SO, (j + 2) * KVBLK); SBAR();
    pv_d0(o, (const char*)V_lds, p8, r32, hi); partialSM(pB0, pB1, m_reg, mnB, alB);
    __syncthreads(); SWAIT(); SWRITE(0, SE);
    RESC(alB); __syncthreads();
    SBAR(); qkt(pA0, pA1, (const char*)K_lds, qr, r32, hi);
    finishSM(pB0, pB1, alB, l_reg, p8); SBAR();
    if (j + 3 < NT) SLOAD(SE, (j + 3) * KVBLK); SBAR();
    pv_d0(o, (const char*)V_lds + SHM_V, p8, r32, hi); partialSM(pA0, pA1, m_reg, mnA, alA);
    __syncthreads(); SWAIT(); SWRITE(1, SO);
    RESC(alA); __syncthreads();
  }
  SBAR(); qkt(pB0, pB1, (const char*)K_lds + SHM_K, qr, r32, hi);
  finishSM(pA0, pA1, alA, l_reg, p8); SBAR();
  pv_d0(o, (const char*)V_lds, p8, r32, hi); partialSM(pB0, pB1, m_reg, mnB, alB);
  __syncthreads(); RESC(alB);
  finishSM(pB0, pB1, alB, l_reg, p8); SBAR();
  pv_d0(o, (const char*)V_lds + SHM_V, p8, r32, hi);
  if (hi == 0) li_l[r32] = l_reg; asm volatile("s_waitcnt lgkmcnt(0)" ::: "memory");
  float rli[16];
#pragma unroll
  for (int r = 0; r < 16; ++r) rli[r] = __builtin_amdgcn_rcpf(li_l[crow(r, hi)]);
  bf16_t* Ol = (bf16_t*)(lds + SHM_ATTN) + wid * (32 * 136);
#pragma unroll
  for (int r = 0; r < 16; ++r) { const int row = crow(r, hi);
#pragma unroll
    for (int d0 = 0; d0 < 4; ++d0) Ol[row * 136 + 32 * d0 + r32] = f2bf(o[d0][r] * rli[r]); }
  asm volatile("s_waitcnt lgkmcnt(0)" ::: "memory");
  int opq = 0; asm volatile("" : "+v"(opq));
  const long gbase = (long)(wid * QBLK + opq) * LDQ;
  u32x4 ov[8], zv[8];
#pragma unroll
  for (int it = 0; it < 8; ++it) { const int chunk = it * 64 + lane, row = chunk >> 4, c8 = (chunk & 15) * 8;
    ov[it] = *(const u32x4*)(Ol + row * 136 + c8); zv[it] = *(const u32x4*)(Zb + gbase + (long)row * LDQ + c8); }
#pragma unroll
  for (int it = 0; it < 8; ++it) { const int chunk = it * 64 + lane, row = chunk >> 4, c8 = (chunk & 15) * 8;
    float of[8], zf[8], rf[8]; unpack8(ov[it], of); unpack8(zv[it], zf);
#pragma unroll
    for (int e = 0; e < 8; ++e) rf[e] = of[e] * zf[e];
    *(u32x4*)(Qb + gbase + (long)row * LDQ + c8) = pack8(rf); }
#undef SLOAD
#undef SWRITE
#undef SWAIT
#undef RESC
}
}

template <int KT>
__device__ __forceinline__ void tconv_tile(const float* __restrict__ src, int ld, int K, bool remap, bf16_t* __restrict__ dst, int n0, int k0, unsigned char* smem, const float* __restrict__ nscale = nullptr) {
    const int tid = otid(), kk = tid >> 4, n4 = (tid & 15) * 4;
    constexpr int LDT = KT + 8, NJ = KT / 32;
    bf16_t* tile = (bf16_t*)smem;
    const int n = n0 + n4; int sc = n; bool zero = false;
    if (remap) { if (n < 7680) sc = n; else if (n < 22016) sc = n + 16; else if (n < 22032) sc = 7680 + (n - 22016); else zero = true; }
    f32x4 v[NJ];
    const f32x4 nsc = nscale ? *(const f32x4*)(nscale + n) : (f32x4){1.f, 1.f, 1.f, 1.f};
#pragma unroll
    for (int j = 0; j < NJ; ++j) v[j] = zero ? (f32x4){0.f, 0.f, 0.f, 0.f} : *(const f32x4*)(src + (size_t)(k0 + kk + 32 * j) * ld + sc) * nsc;
#pragma unroll
    for (int j = 0; j < NJ; ++j)
#pragma unroll
        for (int i = 0; i < 4; ++i) tile[(n4 + i) * LDT + kk + 32 * j] = f2bf(v[j][i]);
    __syncthreads();
#pragma unroll
    for (int j = 0; j < KT / 64; ++j) { const int idx = tid + 512 * j, nn = idx / (KT / 8), k8 = (idx % (KT / 8)) * 8;
        *(u32x4*)(dst + (size_t)(n0 + nn) * K + k0 + k8) = *(const u32x4*)(tile + nn * LDT + k8); }
    __syncthreads();
}
__device__ __forceinline__ void mod_unit(const Params& p, int l, int cb, unsigned char* smem) {
    const int tid = otid();
    float* sc = (float*)smem; float* red = sc + 5 * 2048;
    for (int i = tid; i < 5 * 2048; i += 512) { const int r = i >> 11, k = i & 2047; const float v = r < 4 ? p.c[r * 2048 + k] : p.c_ctx[k]; sc[i] = siluf_(v); }
    __syncthreads();
    const int col4 = (tid & 15) * 4, ks = tid >> 4;
    f32x4 a0 = {0, 0, 0, 0}, a1 = a0, a2 = a0, a3 = a0, a4 = a0;
    const float* wp = p.w_mod + (size_t)l * 2048 * 6144 + (size_t)(ks * 64) * 6144 + cb * 64 + col4;
#pragma unroll 8
    for (int kk = 0; kk < 64; ++kk) { const f32x4 w = *(const f32x4*)(wp + (size_t)kk * 6144); const int k = ks * 64 + kk;
        a0 += sc[k] * w; a1 += sc[2048 + k] * w; a2 += sc[4096 + k] * w; a3 += sc[6144 + k] * w; a4 += sc[8192 + k] * w; }
    *(f32x4*)(red + (ks * 5 + 0) * 64 + col4) = a0; *(f32x4*)(red + (ks * 5 + 1) * 64 + col4) = a1; *(f32x4*)(red + (ks * 5 + 2) * 64 + col4) = a2;
    *(f32x4*)(red + (ks * 5 + 3) * 64 + col4) = a3; *(f32x4*)(red + (ks * 5 + 4) * 64 + col4) = a4;
    __syncthreads();
    if (tid < 320) { const int r = tid >> 6, cc = tid & 63; float s = p.b_mod[l * 6144 + cb * 64 + cc];
        for (int q = 0; q < 32; ++q) s += red[(q * 5 + r) * 64 + cc];
        ((float*)(p.ws + WS_MOD))[(size_t)(l * 5 + r) * 6144 + cb * 64 + cc] = s; }
    __syncthreads();
}
__device__ __forceinline__ void tconv8_tile(const float* __restrict__ src, int ld, int col0, unsigned char* __restrict__ dst, int n0, int k0, unsigned char* smem) {
    const int tid = otid(), kk = tid >> 4, n4 = (tid & 15) * 4;
    constexpr int LDT = 512 + 16;
    unsigned char* tile = smem;
    f32x4 v[16];
#pragma unroll
    for (int j = 0; j < 16; ++j) v[j] = *(const f32x4*)(src + (size_t)(k0 + kk + 32 * j) * ld + col0 + n0 + n4) * 64.0f;
#pragma unroll
    for (int j = 0; j < 16; ++j) { const int w01 = __builtin_amdgcn_cvt_pk_fp8_f32(v[j][0], v[j][1], 0, false), w23 = __builtin_amdgcn_cvt_pk_fp8_f32(v[j][2], v[j][3], 0, false);
        tile[(n4 + 0) * LDT + kk + 32 * j] = (unsigned char)(w01 & 0xff); tile[(n4 + 1) * LDT + kk + 32 * j] = (unsigned char)((w01 >> 8) & 0xff);
        tile[(n4 + 2) * LDT + kk + 32 * j] = (unsigned char)(w23 & 0xff); tile[(n4 + 3) * LDT + kk + 32 * j] = (unsigned char)((w23 >> 8) & 0xff); }
    __syncthreads();
#pragma unroll
    for (int j = 0; j < 4; ++j) { const int idx = tid + 512 * j, nn = idx >> 5, k16 = (idx & 31) * 16;
        *(u32x4*)(dst + (size_t)(n0 + nn) * DM + k0 + k16) = *(const u32x4*)(tile + nn * LDT + k16); }
    __syncthreads();
}
constexpr int U_WINB = 196 * 4, U_W8 = NT8 * 4 * 4, U_WIN1 = U_WINB + U_W8, U_WBR1 = 4 * 32 * 2, U_WOUT1 = 32 * 4, U_POOL1 = 4 * 4, U_CONV1 = U_WIN1 + U_WBR1 + U_WOUT1 + U_POOL1;
__device__ __forceinline__ void conv_unit(const Params& p, int l, int v, unsigned char* smem) {
    if (v < U_WINB) { const int t = v >> 2, nt = t < 192 ? t + 24 : t + 152, kt = v & 3;
        tconv_tile<512>(p.w_in + (size_t)l * DM * NIN, NIN, DM, true, (bf16_t*)(p.ws + WS_WIN) + (size_t)l * NPAD * DM, nt * 64, kt * 512, smem); return; }
    if (v < U_WIN1) { const int w = v - U_WINB, nt = w >> 2, kt = w & 3, q = nt >> 2, col = pn_of_q8(q) * 256 + (nt & 3) * 64;
        tconv8_tile(p.w_in + (size_t)l * DM * NIN, NIN, (col < 7680 ? col : col + 16) - nt * 64, p.ws + WS_W8 + (size_t)l * NT8 * 256 * DM, nt * 64, kt * 512, smem); return; }
    v -= U_WIN1;
    if (v < U_WBR1) { const int mat = l * 4 + (v >> 6), r = v & 63, nt = r >> 1, kt = r & 1;
        tconv_tile<512>(p.w_branch + (size_t)mat * BRW * DM, DM, BRW, false, (bf16_t*)(p.ws + WS_WBR) + (size_t)mat * DM * BRW, nt * 64, kt * 512, smem); return; }
    v -= U_WBR1;
    if (v < U_WOUT1) { const int nt = v >> 2, kt = v & 3;
        tconv_tile<512>(p.w_out + (size_t)l * DM * DM, DM, DM, false, (bf16_t*)(p.ws + WS_WOUT) + (size_t)l * DM * DM, nt * 64, kt * 512, smem); return; }
    v -= U_WOUT1;
    { const int mat = l * 4 + (v >> 2), nt = v & 3;
        tconv_tile<256>(p.pool_w + (size_t)mat * 256 * 256, 256, 256, false, (bf16_t*)(p.ws + WS_POOLW) + (size_t)mat * 256 * 256, nt * 64, 0, smem, p.pool_scale + (size_t)mat * 256); }
}
__device__ void phase_prep(const Params& p, unsigned char* smem) {
    constexpr int U_MOD = 192;
    for (int u = blockIdx.x; u < U_MOD + U_CONV1; u += gridDim.x) {
        if (u < U_MOD) mod_unit(p, u / 96, u % 96, smem); else conv_unit(p, 0, u - U_MOD, smem);
    }
}

__device__ void phase_norm(const Params& p, int l) {
    const int tid = otid(), lane = tid & 63, wv = obid() * 8 + (tid >> 6), nwv = gridDim.x * 8;
    const float* mod = (const float*)(p.ws + WS_MOD) + (size_t)l * 5 * 6144;
    const float* gain = p.norm_gain + l * DM;
    bf16_t* H = (bf16_t*)(p.ws + WS_H);
    for (int row = wv; row < MROWS; row += nwv) {
        const int b = row / RPB, tt = row % RPB; const bool isctx = tt >= TL;
        const float* xr = isctx ? p.ctx + ((size_t)b * LC + (tt - TL)) * DM : p.x + ((size_t)b * TL + tt) * DM;
        const bf16_t* xb = (const bf16_t*)(p.ws + WS_X1) + (size_t)row * DM;
        const float* mr = mod + (size_t)(isctx ? 4 : b) * 6144;
        f32x4 v[8]; float ss = 0.f;
#pragma unroll
        for (int j = 0; j < 8; ++j) {
            if (l == 0) v[j] = *(const f32x4*)(xr + 256 * j + 4 * lane);
            else { const u32x2 w = *(const u32x2*)(xb + 256 * j + 4 * lane); v[j] = (f32x4){bflo(w.x), bfhi(w.x), bflo(w.y), bfhi(w.y)}; }
            ss += v[j][0] * v[j][0] + v[j][1] * v[j][1] + v[j][2] * v[j][2] + v[j][3] * v[j][3]; }
#pragma unroll
        for (int o = 32; o >= 1; o >>= 1) ss += __shfl_xor(ss, o);
        const float rstd = rsqrtf(ss * (1.0f / DM) + EPS);
#pragma unroll
        for (int j = 0; j < 8; ++j) { const int cidx = 256 * j + 4 * lane;
            const f32x4 g = *(const f32x4*)(gain + cidx), sh = *(const f32x4*)(mr + cidx), sc = *(const f32x4*)(mr + 2048 + cidx);
            f32x4 y = v[j] * rstd * g * (1.0f + sc) + sh;
            u32x2 w; w.x = cvt_pk_bf16(y[0], y[1]); w.y = cvt_pk_bf16(y[2], y[3]);
            *(u32x2*)(H + (size_t)row * DM + cidx) = w;
            int w8 = __builtin_amdgcn_cvt_pk_fp8_f32(y[0], y[1], 0, false); w8 = __builtin_amdgcn_cvt_pk_fp8_f32(y[2], y[3], w8, true);
            *(int*)(p.ws + WS_H8 + (size_t)row * DM + cidx) = w8; }
    }
}
__device__ void phase_final(const Params& p) {
    const int tid = otid(), lane = tid & 63, wv = obid() * 8 + (tid >> 6), nwv = gridDim.x * 8;
    for (int row = wv; row < NB * TL; row += nwv) {
        const int b = row / TL, t = row % TL;
        const bf16_t* xb = (const bf16_t*)(p.ws + WS_X1) + (size_t)(b * RPB + t) * DM;
        float* xr = p.out + (size_t)row * DM;
        f32x4 v[8]; float ss = 0.f;
#pragma unroll
        for (int j = 0; j < 8; ++j) { const u32x2 w = *(const u32x2*)(xb + 256 * j + 4 * lane); v[j] = (f32x4){bflo(w.x), bfhi(w.x), bflo(w.y), bfhi(w.y)};
            ss += v[j][0] * v[j][0] + v[j][1] * v[j][1] + v[j][2] * v[j][2] + v[j][3] * v[j][3]; }
#pragma unroll
        for (int o = 32; o >= 1; o >>= 1) ss += __shfl_xor(ss, o);
        const float rstd = rsqrtf(ss * (1.0f / DM) + EPS);
#pragma unroll
        for (int j = 0; j < 8; ++j) { const int cidx = 256 * j + 4 * lane; const f32x4 g = *(const f32x4*)(p.final_gain + cidx); *(f32x4*)(xr + cidx) = v[j] * rstd * g; }
    }
}

__device__ __forceinline__ int seq_row(int b, int dir, int pos  ) {
    if (pos < LC) { const int o = dir ? (LC - 1 - pos) : pos; return b * RPB + TL + o; }
    const int q = pos - LC; const int o = dir ? (TL - 1 - q) : q; return b * RPB + o;
}
__device__ void phase_mix1(const Params& p, int l, unsigned char* smem) {
    const int tid = otid(), lane = tid & 63, wv = obid() * 8 + (tid >> 6), nwv = gridDim.x * 8;
    bf16_t* Y = (bf16_t*)(p.ws + WS_Y);
    if ((int)blockIdx.x >= (int)gridDim.x - 32) {
        const int sq = blockIdx.x - (gridDim.x - 32), dir = sq & 1, hd = (sq >> 1) & 3, b = sq >> 3, wid = tid >> 6;
        const float* G32 = (const float*)(p.ws + WS_G32);
        f32x4* GT4 = (f32x4*)(p.ws + WS_GT4) + (size_t)sq * RPB; float* GW = (float*)(p.ws + WS_GW) + (size_t)sq * RPB; float* GD = (float*)(p.ws + WS_GD) + sq * 128;
        const float bi = p.gate_bias[l * 16 + (dir ? 8 : 0) + hd], bfv = p.gate_bias[l * 16 + (dir ? 12 : 4) + hd];
        float* sAq = (float*)smem; float* sCm = sAq + RPB; float* sB = sCm + RPB; float* sB63 = sB + RPB; float* sC63 = sB63 + 128; float* sMc = sC63 + 128;
        for (int ci = wid; ci < NCHUNK; ci += 8) {
            const int pos = ci * 64 + lane, row = seq_row(b, dir, pos);
            const float gi = G32[(size_t)row * 16 + (dir ? 8 : 0) + hd] + bi, gf = G32[(size_t)row * 16 + (dir ? 12 : 4) + hd] + bfv;
            const float lf = fminf(gf, 0.f) - log1pf(__expf(-fabsf(gf)));
            float bsum = lf;
#pragma unroll
            for (int o = 1; o < 64; o <<= 1) { const float t = __shfl_up(bsum, o); if (lane >= o) bsum += t; }
            const float a = gi - bsum; float cm = a;
#pragma unroll
            for (int o = 1; o < 64; o <<= 1) { const float t = __shfl_up(cm, o); if (lane >= o) cm = fmaxf(cm, t); }
            sAq[pos] = a; sCm[pos] = cm; sB[pos] = bsum;
            if (lane == 63) { sB63[ci] = bsum; sC63[ci] = cm; }
        }
        __syncthreads();
        if (tid == 0) { float m = -1e30f; for (int ci = 0; ci < NCHUNK; ++ci) { sMc[ci] = m; m = sB63[ci] + fmaxf(m, sC63[ci]); } }
        __syncthreads();
        for (int pos = tid; pos < RPB; pos += 512) {
            const int ci = pos >> 6; const float m = sMc[ci], M = fmaxf(m, sCm[pos]), M63 = fmaxf(m, sC63[ci]), a = sAq[pos], bsum = sB[pos];
            GT4[pos] = (f32x4){a, M, fexp(m - M), fexp(-(bsum + M))}; GW[pos] = fexp(a - M63); if ((pos & 63) == 0) GD[ci] = fexp(m - M63);
        }
        return;
    }
    const int nw2 = nwv - 32 * 8;
    {
        const float* qg = p.q_gain + l * 128; const float* kg = p.k_gain + l * 128;
        const int j = lane & 31, hw = lane >> 5;
        const bool second = (j >> 3) & 1, colpart = j >= 16;
        float frq[4];
#pragma unroll
        for (int e = 0; e < 4; ++e) frq[e] = __builtin_amdgcn_exp2f(-(float)(4 * (j & 7) + e) * (13.287712379549449f / 32.0f));
        const f32x4 qg4 = *(const f32x4*)(qg + 4 * j), kg4 = *(const f32x4*)(kg + 4 * j);
        for (int row = wv; row < MROWS; row += nw2) {
            const int tt = row % RPB; const bool lat = tt < TL;
            float cs[4], sn[4];
            const float pos = lat ? (float)(colpart ? (tt & 63) : (tt >> 6)) : 0.f;
#pragma unroll
            for (int e = 0; e < 4; ++e) { const float ang = pos * frq[e]; cs[e] = __cosf(ang); sn[e] = __sinf(ang); }
            bf16_t* rb = Y + (size_t)row * NPAD + 4 * j;
            u32x2 raw[5];
#pragma unroll
            for (int it = 0; it < 5; ++it) { const int hh = it * 2 + hw; raw[it] = *(const u32x2*)(rb + (hh < 8 ? C_AQ + hh * 128 : C_AK + (hh - 8) * 128)); }
#pragma unroll
            for (int it = 0; it < 5; ++it) { const int hh = it * 2 + hw;
                float x[4] = {bflo(raw[it].x), bfhi(raw[it].x), bflo(raw[it].y), bfhi(raw[it].y)};
                float ss = x[0] * x[0] + x[1] * x[1] + x[2] * x[2] + x[3] * x[3];
#pragma unroll
                for (int o = 16; o >= 1; o >>= 1) ss += __shfl_xor(ss, o);
                const float rstd = rsqrtf(ss * (1.0f / 128.0f) + EPS);
                const f32x4 gn = hh < 8 ? qg4 : kg4;
                float y[4];
#pragma unroll
                for (int e = 0; e < 4; ++e) { x[e] *= rstd * gn[e]; }
#pragma unroll
                for (int e = 0; e < 4; ++e) { const float pr = __shfl_xor(x[e], 8); y[e] = second ? (x[e] * cs[e] + pr * sn[e]) : (x[e] * cs[e] - pr * sn[e]); }
                u32x2 w; w.x = cvt_pk_bf16(y[0], y[1]); w.y = cvt_pk_bf16(y[2], y[3]);
                if (hh < 8) *(u32x2*)(rb + C_AQ + hh * 128) = w;
                if (hh >= 8) { int k8 = __builtin_amdgcn_cvt_pk_fp8_f32(y[0], y[1], 0, false); k8 = __builtin_amdgcn_cvt_pk_fp8_f32(y[2], y[3], k8, true);
                    *(int*)(p.ws + WS_K8 + (size_t)row * 256 + (hh - 8) * 128 + 4 * j) = k8; }
            }
        }
    }
    {
        const int nth = nw2 * 64, th = wv * 64 + lane;
        for (int task = th; task < NB * 2 * NCHUNK * 128 * 8; task += nth) {
            const int d = task & 127, g = (task >> 7) & 7, T = (task >> 10) % NCHUNK, bk = (task >> 10) / NCHUNK, kvh = bk & 1, bb = bk >> 1;
            const bf16_t* vsrc = Y + (size_t)(bb * RPB + T * 64) * NPAD + C_AV + kvh * 128 + d;
            float f[8];
#pragma unroll
            for (int e = 0; e < 8; ++e) { const int pos = 8 * g + e, hi_ = pos >> 5, bq = pos & 31, half = bq >> 4, r = bq & 15, key = 32 * half + (r & 3) + 8 * (r >> 2) + 4 * hi_;
                f[e] = bf2f(vsrc[(size_t)key * NPAD]); }
            int w0 = __builtin_amdgcn_cvt_pk_fp8_f32(f[0], f[1], 0, false); w0 = __builtin_amdgcn_cvt_pk_fp8_f32(f[2], f[3], w0, true);
            int w1 = __builtin_amdgcn_cvt_pk_fp8_f32(f[4], f[5], 0, false); w1 = __builtin_amdgcn_cvt_pk_fp8_f32(f[6], f[7], w1, true);
            *(u32x2*)(p.ws + WS_V8 + ((size_t)bk * NCHUNK + T) * 8192 + d * 64 + 8 * g) = (u32x2){(unsigned)w0, (unsigned)w1};
        }
    }
    {
        bf16_t* DMB = (bf16_t*)(p.ws + WS_H);
        const float* cw = p.conv_w + (size_t)l * 3 * BRW;
        const int nth = nw2 * 64, th = wv * 64 + lane;
        for (int task = th; task < MROWS * 128; task += nth) {
            const int row = task >> 7, c8 = (task & 127) * 8;
            const int tt = row % RPB; const bool lat = tt < TL; const int t = lat ? tt : tt - TL, T = lat ? TL : LC;
            const bf16_t* yr = Y + (size_t)row * NPAD;
            u32x4 convw;
            {
                float a0[8], a1[8], a2[8], u[8], g[8];
                unpack8(*(const u32x4*)(yr + C_CU + c8), u); unpack8(*(const u32x4*)(yr + C_CC + c8), g);
#pragma unroll
                for (int i = 0; i < 8; ++i) a1[i] = u[i] * g[i];
                if (t > 0) { unpack8(*(const u32x4*)(yr - NPAD + C_CU + c8), u); unpack8(*(const u32x4*)(yr - NPAD + C_CC + c8), g);
#pragma unroll
                    for (int i = 0; i < 8; ++i) a0[i] = u[i] * g[i]; }
                else {
#pragma unroll
                    for (int i = 0; i < 8; ++i) a0[i] = 0.f; }
                if (t < T - 1) { unpack8(*(const u32x4*)(yr + NPAD + C_CU + c8), u); unpack8(*(const u32x4*)(yr + NPAD + C_CC + c8), g);
#pragma unroll
                    for (int i = 0; i < 8; ++i) a2[i] = u[i] * g[i]; }
                else {
#pragma unroll
                    for (int i = 0; i < 8; ++i) a2[i] = 0.f; }
                float bg[8], z[8], o[8];
                unpack8(*(const u32x4*)(yr + C_CB + c8), bg); unpack8(*(const u32x4*)(yr + C_CZ + c8), z);
#pragma unroll
                for (int i = 0; i < 8; ++i) o[i] = bg[i] * (cw[c8 + i] * a0[i] + cw[BRW + c8 + i] * a1[i] + cw[2 * BRW + c8 + i] * a2[i]) * z[i];
                convw = pack8(o);
            }
            {
                const int g = c8 >> 8, w = 2 << g;
                int lo = t - (w >> 1); if (lo < 0) lo = 0; int hi = t + w - (w >> 1); if (hi > T) hi = T;
                float s[8], u0[8];
#pragma unroll
                for (int i = 0; i < 8; ++i) s[i] = 0.f;
                u32x4 tap[16];
#pragma unroll
                for (int k = 0; k < 16; ++k) { const int q = t - (w >> 1) + k; const bool ok = (k < w) && (q >= 0) && (q < T);
                    tap[k] = ok ? *(const u32x4*)(yr + (long)(q - t) * NPAD + C_PU + c8) : (u32x4){0u, 0u, 0u, 0u}; }
#pragma unroll
                for (int k = 0; k < 16; ++k) { float u[8]; unpack8(tap[k], u);
#pragma unroll
                    for (int i = 0; i < 8; ++i) s[i] += u[i]; }
                unpack8(*(const u32x4*)(yr + C_PU + c8), u0);
                const float inv = 1.0f / (float)(hi - lo);
                float o[8];
#pragma unroll
                for (int i = 0; i < 8; ++i) o[i] = s[i] * inv - u0[i];
                *(u32x4*)(DMB + (size_t)row * BRW + c8) = pack8(o);
                *(u32x4*)(Y + (size_t)row * NPAD + C_CZ + c8) = convw;
            }
        }
    }
}

__device__ __forceinline__ f32x4 mfma16(bf16x8 a, bf16x8 b, f32x4 c) { return __builtin_amdgcn_mfma_f32_16x16x32_bf16(a, b, c, 0, 0, 0); }
__device__ void mlstm_item(const Params& p, int item, unsigned char* smem) {
    const int tid = otid(), wid = tid >> 6, lane = tid & 63, fr = lane & 15, kq = lane >> 4;
    const int ep = item & 3, dir = (item >> 2) & 1, hd = (item >> 3) & 3, b = item >> 5;
    const int sq = (b * 4 + hd) * 2 + dir;
    const bf16_t* Y = (const bf16_t*)(p.ws + WS_Y);
    bf16_t* HM = (bf16_t*)(p.ws + WS_HM) + (size_t)dir * MROWS * BRW;
    const f32x4* GT4 = (const f32x4*)(p.ws + WS_GT4) + (size_t)sq * RPB; const float* GW = (const float*)(p.ws + WS_GW) + (size_t)sq * RPB; const float* GD = (const float*)(p.ws + WS_GD) + sq * 128;
    bf16_t* Ks = (bf16_t*)(smem); bf16_t* KTs = (bf16_t*)(smem + 33792);
    bf16_t* VTs = (bf16_t*)(smem + 70656); bf16_t* VWTs = (bf16_t*)(smem + 82176); bf16_t* CTs = (bf16_t*)(smem + 93696); bf16_t* Ss = (bf16_t*)(smem + 135936);
    float* sA = (float*)(smem + 145152); float* sM = sA + 64; float* sI = sA + 128; float* sE = sA + 192;
    for (int i = tid; i < 80 * 72; i += 512) { VTs[i] = 0; VWTs[i] = 0; }
    for (int i = tid; i < 80 * 264; i += 512) CTs[i] = 0;
    __syncthreads();
    if (tid < 64) VTs[64 * 72 + tid] = 0x3F80;
    f32x4 Cacc[2][5];
#pragma unroll
    for (int a = 0; a < 2; ++a)
#pragma unroll
        for (int c = 0; c < 5; ++c) Cacc[a][c] = (f32x4){0.f, 0.f, 0.f, 0.f};
    const int rg = wid >> 1, ch = wid & 1;
    u32x4 kreg[4], vreg; f32x4 g4; float wv_ = 0.f, wtok = 0.f, decay = 0.f;
    bf16x8 qf[8];
    const int dkp = tid & 127, sg = tid >> 7;
    const int vs = tid & 63, ve8 = (tid >> 6) * 8;
#define ML_LOAD(ci) do { \
        _Pragma("unroll") for (int j = 0; j < 4; ++j) { const int idx = tid + 512 * j, rr = idx >> 5, c8 = (idx & 31) * 8; \
            kreg[j] = *(const u32x4*)(Y + (size_t)seq_row(b, dir, (ci) * 64 + rr) * NPAD + C_MK + hd * 256 + c8); } \
        vreg = *(const u32x4*)(Y + (size_t)seq_row(b, dir, (ci) * 64 + vs) * NPAD + C_MV + hd * 256 + ep * 64 + ve8); wv_ = GW[(ci) * 64 + vs]; \
        g4 = GT4[(ci) * 64 + (tid & 63)]; wtok = GW[(ci) * 64 + (tid & 63)]; \
        decay = GD[(ci)]; } while (0)
#define ML_QLOAD(ci) do { const bf16_t* qrow = Y + (size_t)seq_row(b, dir, (ci) * 64 + 16 * rg + fr) * NPAD + C_MQ + hd * 256 + 8 * kq; \
        _Pragma("unroll") for (int ks = 0; ks < 8; ++ks) qf[ks] = *(const bf16x8*)(qrow + 32 * ks); } while (0)
    ML_LOAD(0); ML_QLOAD(0);
    for (int ci = 0; ci < NCHUNK; ++ci) {
#pragma unroll
        for (int j = 0; j < 4; ++j) { const int idx = tid + 512 * j, rr = idx >> 5, c8 = (idx & 31) * 8; *(u32x4*)(Ks + rr * 264 + c8) = kreg[j]; }
        { float vf[8]; unpack8(vreg, vf); const float ws_ = wv_ * 0.0625f;
#pragma unroll
            for (int i = 0; i < 8; ++i) { VTs[(ve8 + i) * 72 + vs] = f2bf(vf[i]); VWTs[(ve8 + i) * 72 + vs] = f2bf(vf[i] * ws_); } }
        if (tid < 64) { sA[tid] = g4[0]; sM[tid] = g4[1]; sI[tid] = g4[2]; sE[tid] = g4[3]; VWTs[64 * 72 + tid] = f2bf(wtok * 0.0625f); }
        const float dec = decay;
        __syncthreads();
        const int cn = ci + 1 < NCHUNK ? ci + 1 : NCHUNK - 1;
        ML_LOAD(cn);
        {
            const int t = 16 * rg + fr; const float Mt = sM[t];
#pragma unroll
            for (int s2 = 0; s2 < 2; ++s2) { const int st = 2 * ch + s2; f32x4 acc = {0.f, 0.f, 0.f, 0.f};
#pragma unroll
                for (int ks = 0; ks < 8; ++ks) { const bf16x8 kf = *(const bf16x8*)(Ks + (16 * st + fr) * 264 + 32 * ks + 8 * kq); acc = mfma16(kf, qf[ks], acc); }
                float o[4];
#pragma unroll
                for (int i = 0; i < 4; ++i) { const int s = 16 * st + 4 * kq + i; o[i] = (s <= t) ? acc[i] * fexp(sA[s] - Mt) * 0.0625f : 0.f; }
                u32x2 w; w.x = cvt_pk_bf16(o[0], o[1]); w.y = cvt_pk_bf16(o[2], o[3]);
                *(u32x2*)(Ss + t * 72 + 16 * st + 4 * kq) = w; }
        }
#pragma unroll
        for (int j = 0; j < 2; ++j) { const int s0 = 8 * (sg + 4 * j); unsigned kt[8]; u32x4 lo, hi;
#pragma unroll
            for (int jj = 0; jj < 8; ++jj) kt[jj] = *(const unsigned*)(Ks + (s0 + jj) * 264 + 2 * dkp);
            lo.x = (kt[0] & 0xffffu) | (kt[1] << 16); lo.y = (kt[2] & 0xffffu) | (kt[3] << 16); lo.z = (kt[4] & 0xffffu) | (kt[5] << 16); lo.w = (kt[6] & 0xffffu) | (kt[7] << 16);
            hi.x = (kt[0] >> 16) | (kt[1] & 0xffff0000u); hi.y = (kt[2] >> 16) | (kt[3] & 0xffff0000u); hi.z = (kt[4] >> 16) | (kt[5] & 0xffff0000u); hi.w = (kt[6] >> 16) | (kt[7] & 0xffff0000u);
            *(u32x4*)(KTs + (2 * dkp) * 72 + s0) = lo; *(u32x4*)(KTs + (2 * dkp + 1) * 72 + s0) = hi; }
        __syncthreads();
        {
            f32x4 aN0 = {0.f, 0.f, 0.f, 0.f}, aN1 = aN0, aD = aN0;
#pragma unroll
            for (int ks = 0; ks < 8; ++ks) { const bf16x8 c0 = *(const bf16x8*)(CTs + (32 * ch + fr) * 264 + 32 * ks + 8 * kq), c1 = *(const bf16x8*)(CTs + (32 * ch + 16 + fr) * 264 + 32 * ks + 8 * kq),
                                                     c2 = *(const bf16x8*)(CTs + (64 + fr) * 264 + 32 * ks + 8 * kq);
                aN0 = mfma16(qf[ks], c0, aN0); aN1 = mfma16(qf[ks], c1, aN1); aD = mfma16(qf[ks], c2, aD); }
            ML_QLOAD(cn);
            float it4[4], en4[4];
#pragma unroll
            for (int i = 0; i < 4; ++i) { it4[i] = sI[16 * rg + 4 * kq + i]; en4[i] = sE[16 * rg + 4 * kq + i]; aN0[i] *= it4[i]; aN1[i] *= it4[i]; aD[i] *= it4[i]; }
#pragma unroll
            for (int ks = 0; ks < 2; ++ks) { const bf16x8 sf = *(const bf16x8*)(Ss + (16 * rg + fr) * 72 + 32 * ks + 8 * kq);
                const bf16x8 v0 = *(const bf16x8*)(VTs + (32 * ch + fr) * 72 + 32 * ks + 8 * kq), v1 = *(const bf16x8*)(VTs + (32 * ch + 16 + fr) * 72 + 32 * ks + 8 * kq), v2 = *(const bf16x8*)(VTs + (64 + fr) * 72 + 32 * ks + 8 * kq);
                aN0 = mfma16(sf, v0, aN0); aN1 = mfma16(sf, v1, aN1); aD = mfma16(sf, v2, aD); }
#pragma unroll
            for (int i = 0; i < 4; ++i) { const float den = __shfl(aD[i], lane & 48); const float rd = 1.0f / fmaxf(fabsf(den), en4[i]);
                const int row = seq_row(b, dir, ci * 64 + 16 * rg + 4 * kq + i);
                bf16_t* hp = HM + (size_t)row * BRW + hd * 256 + ep * 64 + 32 * ch + fr;
                hp[0] = f2bf(aN0[i] * rd); hp[16] = f2bf(aN1[i] * rd); }
        }
#pragma unroll
        for (int rt = 0; rt < 2; ++rt)
#pragma unroll
            for (int ct = 0; ct < 5; ++ct) { f32x4 cacc = Cacc[rt][ct] * dec;
#pragma unroll
                for (int ks = 0; ks < 2; ++ks) { const bf16x8 af = *(const bf16x8*)(KTs + (32 * wid + 16 * rt + fr) * 72 + 32 * ks + 8 * kq), bv = *(const bf16x8*)(VWTs + (16 * ct + fr) * 72 + 32 * ks + 8 * kq);
                    cacc = mfma16(af, bv, cacc); }
                Cacc[rt][ct] = cacc; }
        __syncthreads();
#pragma unroll
        for (int rt = 0; rt < 2; ++rt)
#pragma unroll
            for (int ct = 0; ct < 5; ++ct) { u32x2 w; w.x = cvt_pk_bf16(Cacc[rt][ct][0], Cacc[rt][ct][1]); w.y = cvt_pk_bf16(Cacc[rt][ct][2], Cacc[rt][ct][3]);
                *(u32x2*)(CTs + (16 * ct + fr) * 264 + 32 * wid + 16 * rt + 4 * kq) = w; }
    }
#undef ML_LOAD
#undef ML_QLOAD
    __syncthreads();
}

__device__ void phase_mix2(const Params& p, int l, unsigned char* smem) {
    bf16_t* Y = (bf16_t*)(p.ws + WS_Y);
#ifndef NO_MLSTM
    if ((int)blockIdx.x < 128) mlstm_item(p, blockIdx.x, smem);
#endif
#ifndef NO_ATT
    const int natt = 512 + (l == 0 ? 32 : 0);
    unsigned* ctr = (unsigned*)(p.ws + WS_BAR + 14336) + l * 64;
    volatile unsigned* sidx = (volatile unsigned*)(smem + LDS_BYTES - 32);
    for (;;) {
        __syncthreads();
        if (threadIdx.x == 0) *sidx = atomicAdd(ctr, 1u);
        __syncthreads();
        const int it = __builtin_amdgcn_readfirstlane((int)*sidx);
        if (it >= natt + (MROWS / 256) * 4) break;
        if (it >= natt) {
            SchedPool S; S.A = (const char*)(p.ws + WS_H); S.Bt = (const char*)(p.ws + WS_POOLW) + (size_t)l * 4 * 256 * 256 * 2; S.G = 1 << 20; S.c = it - natt; S.i0 = 0;
            EpiPool E; E.Y = Y;
            pg8::Gemm g; g.lda = BRW; g.ldb = 256; { int kk = 256; asm volatile("" : "+s"(kk)); g.K = kk; }
            pg8::gemm_phase(( LAS unsigned char*)smem, g, S, E);
            continue; }
        int b, head, qrow, krow, seq;
        if (it < 512) { const int qb = it & 15; head = (it >> 4) & 7; b = it >> 7; qrow = b * RPB + qb * 256; krow = b * RPB; seq = RPB; }
        else { const int i2 = it - 512; head = i2 & 7; b = i2 >> 3; qrow = b * RPB + TL; krow = qrow; seq = LC; }
        const int kvh = head >> 2;
        bf16_t* rowq = Y + (size_t)qrow * NPAD; const bf16_t* rowk = Y + (size_t)krow * NPAD;
        att::attn_dense_body(rowq + C_AQ + head * 128, p.ws + WS_K8 + (size_t)krow * 256 + kvh * 128, p.ws + WS_V8 + ((size_t)(b * 2 + kvh) * NCHUNK + (krow - b * RPB) / 64) * 8192, rowq + C_AZ + head * 128, seq, (char*)smem);
    }
#endif
    __syncthreads();
    __syncthreads();
}

__device__ void phase_mix3(const Params& p, int l) {
    const int tid = otid(), lane = tid & 63, wv = obid() * 8 + (tid >> 6), nwv = gridDim.x * 8;
    bf16_t* Y = (bf16_t*)(p.ws + WS_Y);
    const bf16_t* HM0 = (const bf16_t*)(p.ws + WS_HM); const bf16_t* HM1 = HM0 + (size_t)MROWS * BRW;
    const float* gain = p.m_gain + l * BRW;
    for (int row = wv; row < MROWS; row += nwv) {
        f32x4 v[4]; u32x2 ow[4], zw[4];
#pragma unroll
        for (int hd = 0; hd < 4; ++hd) { const size_t off = (size_t)row * BRW + hd * 256 + 4 * lane;
            { const u32x2 h0 = *(const u32x2*)(HM0 + off), h1 = *(const u32x2*)(HM1 + off);
              v[hd] = (f32x4){bflo(h0.x) + bflo(h1.x), bfhi(h0.x) + bfhi(h1.x), bflo(h0.y) + bflo(h1.y), bfhi(h0.y) + bfhi(h1.y)}; }
            ow[hd] = *(const u32x2*)(Y + (size_t)row * NPAD + C_MO + hd * 256 + 4 * lane); zw[hd] = *(const u32x2*)(Y + (size_t)row * NPAD + C_MZ + hd * 256 + 4 * lane); }
#pragma unroll
        for (int hd = 0; hd < 4; ++hd) {
            float ss = v[hd][0] * v[hd][0] + v[hd][1] * v[hd][1] + v[hd][2] * v[hd][2] + v[hd][3] * v[hd][3];
#pragma unroll
            for (int o = 32; o >= 1; o >>= 1) ss += __shfl_xor(ss, o);
            const float rstd = rsqrtf(ss * (1.0f / 256.0f) + EPS);
            const f32x4 g = *(const f32x4*)(gain + hd * 256 + 4 * lane);
            const float o0 = bflo(ow[hd].x), o1 = bfhi(ow[hd].x), o2 = bflo(ow[hd].y), o3 = bfhi(ow[hd].y), z0 = bflo(zw[hd].x), z1 = bfhi(zw[hd].x), z2 = bflo(zw[hd].y), z3 = bfhi(zw[hd].y);
            u32x2 w; w.x = cvt_pk_bf16(v[hd][0] * rstd * g[0] * o0 * z0, v[hd][1] * rstd * g[1] * o1 * z1); w.y = cvt_pk_bf16(v[hd][2] * rstd * g[2] * o2 * z2, v[hd][3] * rstd * g[3] * o3 * z3);
            *(u32x2*)(Y + (size_t)row * NPAD + C_MO + hd * 256 + 4 * lane) = w;
        }
    }
}

#define XB_TMO      128
#define XB_XCNT(j)  (256  + 64 * (j))
#define XB_XSUB(j)  (1280 + 64 * (j))
#define XB_XGEN(j)  (2304 + 64 * (j))
#define XB_TOP      3328
#define XB_TOPGEN   3392
#define XCD_BAR_WORDS 3456
#define XB_SPIN_CAP (1u << 18)
__device__ __forceinline__ unsigned xb_ld(unsigned* p)              { return __hip_atomic_load(p, __ATOMIC_RELAXED, __HIP_MEMORY_SCOPE_AGENT); }
__device__ __forceinline__ unsigned xb_add(unsigned* p, unsigned v) { return __hip_atomic_fetch_add(p, v, __ATOMIC_RELAXED, __HIP_MEMORY_SCOPE_AGENT); }
__device__ __forceinline__ unsigned xb_xcc_id() { return (unsigned)__builtin_amdgcn_s_getreg((3 << 11) | 20) & 0xFu; }
#define XB_SPIN(cond, bar) do { unsigned _sp = 0; while (cond) { __builtin_amdgcn_s_sleep(1); \
    if ((++_sp & 255u) == 0u) { if (xb_ld(&(bar)[XB_TMO])) break; if (_sp > XB_SPIN_CAP) { atomicAdd(&(bar)[XB_TMO], 1u); break; } } } } while (0)
struct XcdBarrier { unsigned* bar; unsigned x; volatile LAS unsigned* st; };
__device__ __forceinline__ XcdBarrier xcd_barrier_post(unsigned* bar, volatile LAS unsigned* st) {
    XcdBarrier b; b.bar = bar; b.x = xb_xcc_id(); b.st = st;
    if (threadIdx.x == 0) (void)xb_add(&bar[XB_XCNT(b.x)], 1u);
    return b;
}
__device__ __forceinline__ void xcd_barrier_complete(unsigned* bar, unsigned x, unsigned& nloc, unsigned& nx) {
    const unsigned G = gridDim.x * gridDim.y * gridDim.z;
    unsigned sum, cnt, mine, sp = 0u;
    for (;;) {
        sum = 0u; cnt = 0u; mine = 0u;
#pragma unroll
        for (unsigned j = 0; j < 16; ++j) { const unsigned c = xb_ld(&bar[XB_XCNT(j)]); sum += c; cnt += (c > 0u) ? 1u : 0u; mine = (j == x) ? c : mine; }
        if (sum == G) break;
        __builtin_amdgcn_s_sleep(1);
        if ((++sp & 255u) == 0u) { if (xb_ld(&bar[XB_TMO])) break; if (sp > XB_SPIN_CAP) { atomicAdd(&bar[XB_TMO], 1u); break; } }
    }
    nloc = mine > 0u ? mine : 1u; nx = cnt > 0u ? cnt : 1u;
}
__device__ __forceinline__ void xcd_barrier(const XcdBarrier& b) {
    asm volatile("s_waitcnt vmcnt(0)" ::: "memory");
    __syncthreads();
    if (threadIdx.x == 0) {
        unsigned* bar = b.bar;
        __builtin_amdgcn_s_waitcnt(0);
        unsigned nloc = b.st[0], nx = b.st[1];
        if (nloc == 0u) { xcd_barrier_complete(bar, b.x, nloc, nx); b.st[0] = nloc; b.st[1] = nx; }
        const unsigned old = xb_add(&bar[XB_XSUB(b.x)], 1u);
        const unsigned gen = old / nloc;
        if (old + 1u == (gen + 1u) * nloc) {
            __builtin_amdgcn_fence(__ATOMIC_RELEASE, "agent");
            asm volatile("s_waitcnt vmcnt(0)" ::: "memory");
            const unsigned og = xb_add(&bar[XB_TOP], 1u);
            const unsigned tg = og / nx;
            if (og + 1u == (tg + 1u) * nx) xb_add(&bar[XB_TOPGEN], 1u);
            else XB_SPIN(xb_ld(&bar[XB_TOPGEN]) == tg, bar);
            __builtin_amdgcn_fence(__ATOMIC_ACQUIRE, "agent");
            xb_add(&bar[XB_XGEN(b.x)], 1u);
            asm volatile("s_waitcnt vmcnt(0)" ::: "memory");
        } else {
            XB_SPIN(xb_ld(&bar[XB_XGEN(b.x)]) == gen, bar);
            __builtin_amdgcn_fence(__ATOMIC_ACQUIRE, "agent");
            asm volatile("s_waitcnt vmcnt(0)" ::: "memory");
        }
    }
    __syncthreads();
}

constexpr int NPHASE = 16;
__device__ void run_phase(const Params& p, int ph, unsigned char* smem, bool dost = true) {
#ifndef NO_PREP
    if (ph == 0) { phase_prep(p, smem); return; }
#endif
#ifndef NO_FINAL
    if (ph == NPHASE - 1) { phase_final(p); return; }
#endif
    const int l = (ph - 1) / 7, s = (ph - 1) % 7;
    bf16_t* Y = (bf16_t*)(p.ws + WS_Y);
    switch (s) {
#ifndef NO_NORM
    case 0: phase_norm(p, l); break;
#endif
#ifndef NO_GIN
    case 1: { EpiIn E; E.Y = Y; E.G32 = (float*)(p.ws + WS_G32); E.dost = dost;
              { SchedIn S; S.A = (const char*)(p.ws + WS_H); S.Bt = (const char*)(p.ws + WS_WIN) + (size_t)l * NPAD * DM * 2; S.G = gridDim.x; S.c = blockIdx.x; S.trim = (l == 1); S.part = 0;
                E.ps = 1.0f; pg8::Gemm g; g.lda = DM; g.ldb = DM; g.K = DM;
#ifndef T_NO_P0
                pg8::gemm_phase<EpiIn, SchedIn, false>((LAS unsigned char*)smem, g, S, E);
#endif
              }
              __syncthreads();
              { SchedIn S; S.A = (const char*)(p.ws + WS_H8); S.Bt = (const char*)(p.ws + WS_W8) + (size_t)l * NT8 * 256 * DM; S.G = gridDim.x; S.c = gridDim.x - 1 - blockIdx.x;     S.trim = (l == 1); S.part = 1;
                EpiGate8 E8; E8.Y = Y; pg8::Gemm g; g.lda = DM / 2; g.ldb = DM / 2; g.K = DM / 2;
#ifndef T_NO_P1
                pg8::gemm_phase<EpiGate8, SchedIn, true>((LAS unsigned char*)smem, g, S, E8);
#endif
              } } break;
#endif
#ifndef NO_MIX1
    case 2: phase_mix1(p, l, smem); break;
#endif
#ifndef NO_MIX2
    case 3: phase_mix2(p, l, smem); break;
#endif
#ifndef NO_MIX3
    case 4: phase_mix3(p, l); break;
#endif
#ifndef NO_MERGE
    case 5: { SchedMerge S; S.Y = (const char*)Y; S.Wbr = (const char*)(p.ws + WS_WBR) + (size_t)l * 4 * DM * BRW * 2; S.G = gridDim.x; S.c = blockIdx.x; S.nM = l == 0 ? 68 : 64;
              EpiMerge E; E.Y = Y; E.accb = (bf16_t*)(p.ws + WS_H);
              pg8::Gemm g; g.lda = NPAD; g.ldb = BRW; g.K = BRW;
              pg8::gemm_phase((LAS unsigned char*)smem, g, S, E);
              if (l == 0 && (int)blockIdx.x >= 32) { __syncthreads(); for (int u = blockIdx.x - 32; u < U_CONV1; u += gridDim.x - 32) conv_unit(p, 1, u, smem); } } break;
#endif
#ifndef NO_OUT
    case 6: { SchedOut S; S.A = (const char*)(p.ws + WS_H); S.Bt = (const char*)(p.ws + WS_WOUT) + (size_t)l * DM * DM * 2; S.G = gridDim.x; S.c = blockIdx.x; S.nM = l == 0 ? 68 : 64;
              EpiOut E; E.xin = p.x; E.ctxin = p.ctx; E.mod = (const float*)(p.ws + WS_MOD) + (size_t)l * 5 * 6144; E.X1 = (bf16_t*)(p.ws + WS_X1); E.first = (l == 0);
              pg8::Gemm g; g.lda = DM; g.ldb = DM; g.K = DM;
              pg8::gemm_phase((LAS unsigned char*)smem, g, S, E); } break;
#endif
    }
}

__global__ void __launch_bounds__(512, 2) hybrid_fwd(Params p) {
    extern __shared__ __attribute__((aligned(16))) unsigned char smem[];
    volatile LAS unsigned* st = (volatile LAS unsigned*)((LAS unsigned char*)smem + (LDS_BYTES - 16));
    if (threadIdx.x == 0) { st[0] = 0u; st[1] = 0u; }
    __syncthreads();
    const XcdBarrier xbar = xcd_barrier_post((unsigned*)(p.ws + WS_BAR), st);
    for (int ph = p.ph_lo; ph < p.ph_hi; ++ph) {
        int reps = 1;
#ifdef PROBE_REP_MASK
        if (ph > 0 && ph < NPHASE - 1 && ((PROBE_REP_MASK >> ((ph - 1) % 7)) & 1)) reps = 2;
        if (ph == 0 && (PROBE_REP_MASK & 128)) reps = 2;
#endif
        for (int r = 0; r < reps; ++r) { run_phase(p, ph, smem, r + 1 == reps || p.ph_hi > 1000); if (r + 1 < reps) xcd_barrier(xbar); }
        if (ph + 1 < p.ph_hi) { if (p.ph_hi > NPHASE) cg::this_grid().sync(); else xcd_barrier(xbar); }
#ifdef PROBE_EXTRA_SYNC
        if (ph + 1 < p.ph_hi) { for (int q = 0; q < PROBE_EXTRA_SYNC; ++q) cg::this_grid().sync(); }
#endif
    }
}


#ifdef DBG_STOP
__global__ void dbg_dump(Params p) {
    const bf16_t* Y = (const bf16_t*)(p.ws + WS_Y); const float* HM = (const float*)(p.ws + WS_HM); const bf16_t* H = (const bf16_t*)(p.ws + WS_H);
    for (size_t i = (size_t)blockIdx.x * blockDim.x + threadIdx.x; i < (size_t)NB * TL * DM; i += (size_t)gridDim.x * blockDim.x) {
        const size_t row = i / DM; const int c = (int)(i % DM);
        float s = 0.f;
#if DBG_WHAT & 1
        for (int j = 0; j < 11; ++j) { const int col = c + 2048 * j; if (col < 22016) s += bf2f(Y[row * NPAD + col]); }
#endif
#if DBG_WHAT & 2
        { const size_t k = i % ((size_t)MROWS * BRW); s += HM[k] + HM[k + (size_t)MROWS * BRW]; }
#endif
#if DBG_WHAT & 4
        s += bf2f(H[i]);
#endif
        p.out[i] = s;
    }
}
#endif
extern "C" void kernel_launch(void* const* d_in, const int* in_sizes, int n_in, void* d_out, int out_size, void* d_ws, size_t ws_size, hipStream_t stream) {
    static int grid = 0;
    if (grid == 0) {
        if (n_in != 18 || ws_size < WS_END) { fprintf(stderr, "kernel_launch: n_in %d ws %zu (need %zu)\n", n_in, ws_size, (size_t)WS_END); grid = -1; return; }
        if (hipFuncSetAttribute((const void*)hybrid_fwd, hipFuncAttributeMaxDynamicSharedMemorySize, LDS_BYTES) != hipSuccess) { fprintf(stderr, "kernel_launch: hipFuncSetAttribute failed\n"); grid = -1; return; }
        int dev = 0, cus = 0, per_cu = 0;
        hipGetDevice(&dev); hipDeviceGetAttribute(&cus, hipDeviceAttributeMultiprocessorCount, dev);
        hipOccupancyMaxActiveBlocksPerMultiprocessor(&per_cu, (const void*)hybrid_fwd, 512, LDS_BYTES);
        if (per_cu < 1) { fprintf(stderr, "kernel_launch: occupancy query says %d blocks per CU\n", per_cu); per_cu = 1; }
        (void)hipGetLastError();
        grid = cus;
    }
    if (grid < 0) return;
    Params p{};
    p.x = (const float*)d_in[0]; p.c = (const float*)d_in[1]; p.ctx = (const float*)d_in[2]; p.c_ctx = (const float*)d_in[3]; p.norm_gain = (const float*)d_in[4];
    p.w_mod = (const float*)d_in[5]; p.b_mod = (const float*)d_in[6]; p.w_in = (const float*)d_in[7]; p.q_gain = (const float*)d_in[8]; p.k_gain = (const float*)d_in[9];
    p.gate_bias = (const float*)d_in[10]; p.m_gain = (const float*)d_in[11]; p.conv_w = (const float*)d_in[12]; p.pool_w = (const float*)d_in[13]; p.pool_scale = (const float*)d_in[14];
    p.w_branch = (const float*)d_in[15]; p.w_out = (const float*)d_in[16]; p.final_gain = (const float*)d_in[17];
    p.out = (float*)d_out; p.ws = (unsigned char*)d_ws;
#ifdef DBG_STOP
    for (int ph = 0; ph < DBG_STOP; ++ph) { p.ph_lo = ph; p.ph_hi = ph + 1; hipLaunchKernelGGL(hybrid_fwd, dim3(grid), dim3(512), LDS_BYTES, stream, p); }
    hipLaunchKernelGGL(dbg_dump, dim3(2048), dim3(256), 0, stream, p);
#elif MK_PER_PHASE
    for (int ph = 0; ph < NPHASE; ++ph) {
        p.ph_lo = ph; p.ph_hi = ph + 1;
        hipLaunchKernelGGL(hybrid_fwd, dim3(grid), dim3(512), LDS_BYTES, stream, p);
    }
#else
    p.ph_lo = 0; p.ph_hi = NPHASE;
    if (hipMemsetAsync((char*)d_ws + WS_BAR, 0, 16384, stream) != hipSuccess) { fprintf(stderr, "kernel_launch: memset of barrier words failed\n"); return; }
    void* args[] = {&p};
    hipError_t e = hipLaunchCooperativeKernel((const void*)hybrid_fwd, dim3(grid), dim3(512), args, LDS_BYTES, stream);
    if (e != hipSuccess) fprintf(stderr, "cooperative launch failed: %s (grid %d)\n", hipGetErrorString(e), grid);
#endif
}
```

```cpp
#include <hip/hip_runtime.h>
#include <hip/hip_cooperative_groups.h>
#include <cstdio>
#include <cstdint>
namespace cg = cooperative_groups;

#ifndef MK_PER_PHASE
#define MK_PER_PHASE 0
#endif

#define LAS __attribute__((address_space(3)))
typedef unsigned short bf16_t;
typedef short bf16x8 __attribute__((ext_vector_type(8)));
typedef short s16x4 __attribute__((ext_vector_type(4)));
typedef float f32x4 __attribute__((ext_vector_type(4)));
typedef float f32x8 __attribute__((ext_vector_type(8)));
typedef float f32x16 __attribute__((ext_vector_type(16)));
typedef unsigned u32x4 __attribute__((ext_vector_type(4)));
typedef unsigned u32x2 __attribute__((ext_vector_type(2)));

constexpr int DM = 2048, NB = 4, TL = 4096, LC = 256, RPB = TL + LC  , MROWS = NB * RPB  ;
constexpr int NIN = 22032, NPAD = 22272, BRW = 1024;
constexpr int C_AQ = 0, C_AK = 1024, C_AV = 1280, C_AZ = 1536, C_MQ = 2560, C_MK = 3584, C_MV = 4608, C_MO = 5632, C_MZ = 6656,
              C_CU = 7680, C_CB = 8704, C_CC = 9728, C_CZ = 10752, C_PU = 11776, C_PZ = 12800, C_GM = 13824, C_MG = 22016;
constexpr int NCHUNK = RPB / 64;
constexpr float EPS = 1e-6f;

constexpr size_t WS_WIN = 0;
constexpr size_t WS_WBR = WS_WIN + (size_t)2 * NPAD * DM * 2;
constexpr size_t WS_WOUT = WS_WBR + (size_t)2 * 4 * DM * BRW * 2;
constexpr size_t WS_POOLW = WS_WOUT + (size_t)2 * DM * DM * 2;
constexpr size_t WS_MOD = WS_POOLW + (size_t)2 * 4 * 256 * 256 * 2;
constexpr size_t WS_H = WS_MOD + (size_t)2 * 5 * 6144 * 4;
constexpr size_t WS_Y = WS_H + (size_t)MROWS * DM * 2;
constexpr size_t WS_X1 = WS_Y + (size_t)MROWS * NPAD * 2;
constexpr size_t WS_H8 = WS_X1 + (size_t)MROWS * DM * 2;
constexpr size_t WS_HM = WS_X1 + (size_t)MROWS * DM * 4;
static_assert(WS_H8 + (size_t)MROWS * DM <= WS_HM, "the fp8 copy of h must fit in the free half of the X1 slot");
constexpr size_t WS_G32 = WS_HM + (size_t)2 * MROWS * BRW * 4;
constexpr size_t WS_GT4 = WS_G32 + (size_t)MROWS * 16 * 4;
constexpr size_t WS_GW = WS_GT4 + (size_t)32 * RPB * 16;
constexpr size_t WS_GD = WS_GW + (size_t)32 * RPB * 4;
constexpr size_t WS_BAR = WS_GD + (size_t)32 * 128 * 4;
constexpr int NT8 = 42;
constexpr size_t WS_W8 = WS_BAR + 16384;
constexpr size_t WS_K8 = WS_W8 + (size_t)2 * NT8 * 256 * DM;
constexpr size_t WS_V8 = WS_K8 + (size_t)MROWS * 256;
constexpr size_t WS_END = WS_V8 + (size_t)MROWS * 256;
__host__ __device__ __forceinline__ constexpr int pn_of_q8(int q) { return q < 6 ? q : (q < 10 ? 18 + (q - 6) : 54 + (q - 10)); }
__host__ __device__ __forceinline__ constexpr int pn_of_p16(int p) { return p < 12 ? 6 + p : (p < 44 ? 22 + (p - 12) : 86); }

constexpr int LDS_BYTES = 155648;

struct Params {
    const float* x; const float* c; const float* ctx; const float* c_ctx; const float* norm_gain; const float* w_mod; const float* b_mod; const float* w_in;
    const float* q_gain; const float* k_gain; const float* gate_bias; const float* m_gain; const float* conv_w; const float* pool_w; const float* pool_scale;
    const float* w_branch; const float* w_out; const float* final_gain;
    float* out; unsigned char* ws;
    int ph_lo, ph_hi;
};

__device__ __forceinline__ int otid() { int t = threadIdx.x; asm volatile("" : "+v"(t)); return t; }
__device__ __forceinline__ int obid() { int t = blockIdx.x; asm volatile("" : "+s"(t)); return t; }
typedef __bf16 bf16x2_t __attribute__((ext_vector_type(2)));
typedef float f32x2_t __attribute__((ext_vector_type(2)));
__device__ __forceinline__ unsigned cvt_pk_bf16(float lo, float hi) { f32x2_t v = {lo, hi}; bf16x2_t r = __builtin_convertvector(v, bf16x2_t); return *reinterpret_cast<unsigned*>(&r); }
__device__ __forceinline__ bf16_t f2bf(float f) { return (bf16_t)(cvt_pk_bf16(f, 0.f) & 0xffffu); }
__device__ __forceinline__ float bf2f(bf16_t b) { return __uint_as_float(((unsigned)b) << 16); }
__device__ __forceinline__ float bflo(unsigned w) { return __uint_as_float(w << 16); }
__device__ __forceinline__ float bfhi(unsigned w) { return __uint_as_float(w & 0xffff0000u); }
__device__ __forceinline__ float sigmoidf_(float x) { return __builtin_amdgcn_rcpf(1.0f + __builtin_amdgcn_exp2f(-1.4426950408889634f * x)); }
__device__ __forceinline__ float siluf_(float x) { return x * sigmoidf_(x); }
__device__ __forceinline__ float fexp(float x) { return __builtin_amdgcn_exp2f(1.4426950408889634f * x); }
__device__ __forceinline__ void unpack8(const u32x4 w, float (&f)[8]) { f[0] = bflo(w.x); f[1] = bfhi(w.x); f[2] = bflo(w.y); f[3] = bfhi(w.y); f[4] = bflo(w.z); f[5] = bfhi(w.z); f[6] = bflo(w.w); f[7] = bfhi(w.w); }
__device__ __forceinline__ u32x4 pack8(const float (&f)[8]) { u32x4 w; w.x = cvt_pk_bf16(f[0], f[1]); w.y = cvt_pk_bf16(f[2], f[3]); w.z = cvt_pk_bf16(f[4], f[5]); w.w = cvt_pk_bf16(f[6], f[7]); return w; }

namespace pg8 {
constexpr int BM = 256, BK = 64, HALF = 128, HTB = HALF * BK * 2, STAGE_BYTES = 8 * HTB, NXCD = 8, WGM = 8;
__host__ __device__ __forceinline__ int lds_byte(int r, int c) { const int st = (r >> 4) * 2 + (c >> 5), rr = r & 15, cc = c & 31, ob = rr * 64 + cc * 2; return st * 1024 + (ob ^ (((ob >> 9) & 1) << 5)); }
__host__ __device__ __forceinline__ void stage_rc(int b, int& R, int& C) { const int st = b / 1024, sb = b % 1024, swz = sb ^ (((sb >> 9) & 1) << 5); R = (st >> 1) * 16 + swz / 64; C = (st & 1) * 32 + (swz % 64) / 2; }
__host__ __device__ __forceinline__ int perm32(int rho) { const int n = rho >> 4, i = rho & 15; return 8 * (i >> 2) + 4 * n + (i & 3); }

struct Unit { const char* a; const char* b; int pm, pn, tag; };
struct Gemm { int lda, ldb, K; };

__device__ __forceinline__ bool static_tile(int nM, int nN, long L, int& pm, int& pn) {
    const int nwg = nM * nN; if (L >= nwg) return false;
    int wgid = (int)L; { const int q = nwg / NXCD, r = nwg % NXCD, xcd = wgid % NXCD, off = wgid / NXCD; wgid = (xcd < r ? xcd * (q + 1) : r * (q + 1) + (xcd - r) * q) + off; }
    const int nig = WGM * nN, gid = wgid / nig, fm = gid * WGM, gsz = (nM - fm) < WGM ? (nM - fm) : WGM;
    pm = fm + ((wgid % nig) % gsz); pn = (wgid % nig) / gsz; return true;
}

typedef int v4i_t __attribute__((ext_vector_type(4)));
typedef int v8i_t __attribute__((ext_vector_type(8)));
template <bool F8> struct Frag;
template <> struct Frag<false> { bf16x8 h[2]; __device__ __forceinline__ void set(int k, bf16x8 x) { h[k] = x; } };
template <> struct Frag<true>  { v8i_t v;     __device__ __forceinline__ void set(int k, bf16x8 x) { const v4i_t q = __builtin_bit_cast(v4i_t, x); if (k == 0) v.lo = q; else v.hi = q; } };
template <class Epi, class Sched, bool FP8 = false>
__device__ __forceinline__ void gemm_phase(LAS unsigned char* lds, const Gemm g, const Sched& S, const Epi& E) {
    const int tid = otid(), wid = __builtin_amdgcn_readfirstlane(tid >> 6), lane = tid & 63, wr = wid >> 2, wc = wid & 3, fr = lane & 15, fq = lane >> 4;
    const int K = g.K, nt = K / BK;
    unsigned voffA[2], voffB[2];
#pragma unroll
    for (int i = 0; i < 2; ++i) { int R, C; stage_rc(tid * 16 + i * 8192, R, C); const int Rb = Epi::PERM ? ((R & ~31) + perm32(R & 31)) : R;
        voffA[i] = (unsigned)(R * g.lda + C) * 2u; voffB[i] = (unsigned)(Rb * g.ldb + C) * 2u; }
    const size_t kstep = (size_t)(BK * 2);
    const size_t hstepA = (size_t)HALF * g.lda * 2, hstepB = (size_t)HALF * g.ldb * 2;
    const unsigned ldsw = (unsigned)wid * 1024u;
    const int aoff = lds_byte(wr * 64 + fr, fq * 8), boff = lds_byte(wc * 32 + fr, fq * 8);
#define PG8_SA(b, h) (((b) * 2 + (h)) * HTB)
#define PG8_SB(b, h) ((4 + (b) * 2 + (h)) * HTB)
#define PG8_STAGE(bufoff, gbase, voff) do { _Pragma("unroll") for (int _i = 0; _i < 2; ++_i) \
        __builtin_amdgcn_global_load_lds((const unsigned*)((const char*)(gbase) + (voff)[_i]), (LAS unsigned*)(lds + (bufoff) + ldsw + _i * 8192), 16, 0, 0); } while (0)
#define PG8_LDA(dst, b, h) do { _Pragma("unroll") for (int m = 0; m < 4; ++m) _Pragma("unroll") for (int k = 0; k < 2; ++k) dst[m].set(k, *(const LAS bf16x8*)(lds + PG8_SA(b, h) + aoff + m * 2048 + k * 1024)); } while (0)
#define PG8_LDB(dst, b, h) do { _Pragma("unroll") for (int n = 0; n < 2; ++n) _Pragma("unroll") for (int k = 0; k < 2; ++k) dst[n].set(k, *(const LAS bf16x8*)(lds + PG8_SB(b, h) + boff + n * 2048 + k * 1024)); } while (0)
#define PG8_MMA(ai, bj, At, Bt) do { __builtin_amdgcn_s_setprio(1); _Pragma("unroll") for (int m = 0; m < 4; ++m) _Pragma("unroll") for (int n = 0; n < 2; ++n) { \
        if constexpr (FP8)   \
            asm volatile("v_mfma_f32_16x16x128_f8f6f4 %0, %1, %2, %0" : "+v"(acc[ai][bj][m][n]) : "v"(Bt[n].v), "v"(At[m].v));   \
        else { _Pragma("unroll") for (int k = 0; k < 2; ++k) acc[ai][bj][m][n] = __builtin_amdgcn_mfma_f32_16x16x32_bf16(Bt[n].h[k], At[m].h[k], acc[ai][bj][m][n], 0, 0, 0); } } \
        __builtin_amdgcn_s_setprio(0); } while (0)
#define PG8_WAIT_V(n) asm volatile("s_waitcnt vmcnt(" #n ")" ::: "memory")
#define PG8_WAIT_L(n) asm volatile("s_waitcnt lgkmcnt(" #n ")" ::: "memory")
#define PG8_BAR __builtin_amdgcn_s_barrier()
#define PG8_SCHED __builtin_amdgcn_sched_barrier(0)
    Unit cur, nxt; int ui = 0;
    if (!S.next(0, cur)) return;
    f32x4 acc[2][2][4][2];
#pragma unroll
    for (int a = 0; a < 2; ++a)
#pragma unroll
        for (int b = 0; b < 2; ++b)
#pragma unroll
            for (int m = 0; m < 4; ++m)
#pragma unroll
                for (int n = 0; n < 2; ++n) acc[a][b][m][n] = (f32x4){0.f, 0.f, 0.f, 0.f};
    Frag<FP8> At[4], B0[2], B1[2];
    const char* cA = cur.a; const char* cB = cur.b;
    PG8_STAGE(PG8_SB(0, 0), cB, voffB); PG8_STAGE(PG8_SA(0, 0), cA, voffA); PG8_STAGE(PG8_SB(0, 1), cB + hstepB, voffB); PG8_STAGE(PG8_SA(0, 1), cA + hstepA, voffA);
    if (wr == 1) PG8_BAR;
    PG8_WAIT_V(4); PG8_BAR;
    PG8_STAGE(PG8_SB(1, 0), cB + kstep, voffB); PG8_STAGE(PG8_SA(1, 0), cA + kstep, voffA); PG8_STAGE(PG8_SB(1, 1), cB + hstepB + kstep, voffB);
    PG8_WAIT_V(6); PG8_BAR;
    for (;;) {
        const bool has_next = S.next(ui + 1, nxt);
        const char* nA = has_next ? nxt.a : cA; const char* nB = has_next ? nxt.b : cB;
        for (int t = 0; t < nt; t += 2) {
            const bool last = (t == nt - 2);
            const char* a1 = cA + (size_t)(t + 1) * kstep;
            const char* a2 = last ? nA : cA + (size_t)(t + 2) * kstep; const char* b2 = last ? nB : cB + (size_t)(t + 2) * kstep;
            const char* a3 = a2 + kstep; const char* b3 = b2 + kstep;
            PG8_LDB(B0, 0, 0); PG8_SCHED; PG8_LDA(At, 0, 0); PG8_STAGE(PG8_SA(1, 1), a1 + hstepA, voffA);
            PG8_WAIT_L(8); PG8_BAR; PG8_WAIT_L(0); PG8_MMA(0, 0, At, B0); PG8_BAR; PG8_SCHED;
            PG8_LDB(B1, 0, 1); PG8_STAGE(PG8_SB(0, 0), b2, voffB);
            PG8_BAR; PG8_WAIT_L(0); PG8_MMA(0, 1, At, B1); PG8_BAR;
            PG8_LDA(At, 0, 1); PG8_STAGE(PG8_SA(0, 0), a2, voffA);
            PG8_BAR; PG8_WAIT_L(0); PG8_MMA(1, 0, At, B0); PG8_BAR; PG8_SCHED;
            PG8_STAGE(PG8_SB(0, 1), b2 + hstepB, voffB);
            PG8_WAIT_V(6); PG8_BAR; PG8_MMA(1, 1, At, B1); PG8_BAR;
            PG8_LDB(B0, 1, 0); PG8_SCHED; PG8_LDA(At, 1, 0); PG8_STAGE(PG8_SA(0, 1), a2 + hstepA, voffA);
            PG8_WAIT_L(8); PG8_BAR; PG8_WAIT_L(0); PG8_MMA(0, 0, At, B0); PG8_BAR; PG8_SCHED;
            PG8_LDB(B1, 1, 1); PG8_STAGE(PG8_SB(1, 0), b3, voffB);
            PG8_BAR; PG8_WAIT_L(0); PG8_MMA(0, 1, At, B1); PG8_BAR;
            PG8_LDA(At, 1, 1); PG8_STAGE(PG8_SA(1, 0), a3, voffA);
            PG8_BAR; PG8_WAIT_L(0); PG8_MMA(1, 0, At, B0); PG8_BAR; PG8_SCHED;
            PG8_STAGE(PG8_SB(1, 1), b3 + hstepB, voffB);
            PG8_WAIT_V(6); PG8_BAR; PG8_MMA(1, 1, At, B1); PG8_BAR;
        }
        if constexpr (FP8) asm volatile("s_nop 15\n\ts_nop 15" ::: "memory");
        E(acc, cur, wr, wc, fr, fq);
        if (!has_next) break;
#pragma unroll
        for (int a = 0; a < 2; ++a)
#pragma unroll
            for (int b = 0; b < 2; ++b)
#pragma unroll
                for (int m = 0; m < 4; ++m)
#pragma unroll
                    for (int n = 0; n < 2; ++n) acc[a][b][m][n] = (f32x4){0.f, 0.f, 0.f, 0.f};
        cur = nxt; cA = nA; cB = nB; ++ui;
    }
    PG8_WAIT_V(0);
    if (wr == 0) PG8_BAR;
    PG8_BAR;
#undef PG8_SA
#undef PG8_SB
#undef PG8_STAGE
#undef PG8_LDA
#undef PG8_LDB
#undef PG8_MMA
#undef PG8_WAIT_V
#undef PG8_WAIT_L
#undef PG8_BAR
#undef PG8_SCHED
}
}


struct SchedIn {
    const char* A; const char* Bt; int G, c, trim, part;
    __device__ __forceinline__ bool next(int i, pg8::Unit& u) const {
        int pm, pn, q = 0; const long L = (long)i * G + c;
        const int nN = part ? NT8 : 45, nM = trim ? 64 : MROWS / 256;
        if (L < (long)nM * nN) { pg8::static_tile(nM, nN, L, pm, pn); if (trim) pm += pm / 16; q = pn; pn = part ? pn_of_q8(pn) : pn_of_p16(pn); }
        else { if (!trim) return false; const int idx = (int)(L - (long)nM * nN);
            if (part) { if (idx >= 4 * 6) return false; const int k = idx % 6; pm = 17 * (idx / 6) + 16; q = 4 + k; pn = pn_of_q8(q); }
            else { if (idx >= 4 * 9) return false; const int k = idx % 9; pm = 17 * (idx / 9) + 16; pn = k < 8 ? 10 + k : 86; } }
        u.pm = pm; u.pn = pn; u.tag = 0;
        if (part) { u.a = A + (size_t)pm * 256 * DM; u.b = Bt + (size_t)q * 256 * DM; }
        else { u.a = A + (size_t)pm * 256 * DM * 2; u.b = Bt + (size_t)pn * 256 * DM * 2; }
        return true; }
};
struct EpiIn {
    static constexpr bool PERM = true;
    bf16_t* Y; float* G32; bool dost; float ps;
    __device__ __forceinline__ void operator()(const f32x4 (&acc)[2][2][4][2], const pg8::Unit& u, int wr, int wc, int fr, int fq) const {
        if (!dost) return;
        const int pn = u.pn;
        int opq = 0; asm volatile("" : "+v"(opq));
        const int row0 = u.pm * 256 + wr * 64 + fr + opq;
        if (pn == 86) {
            if (wc == 0 && fq < 2) {
#pragma unroll
                for (int ai = 0; ai < 2; ++ai)
#pragma unroll
                    for (int m = 0; m < 4; ++m) { float* gp = G32 + (size_t)(row0 + ai * 128 + m * 16) * 16 + 8 * fq;
                        *(f32x4*)gp = acc[ai][0][m][0]; *(f32x4*)(gp + 4) = acc[ai][0][m][1]; }
            }
            return;
        }
        int act = 0;
        if ((pn >= 6 && pn < 10) || (pn >= 26 && pn < 30) || (pn >= 42 && pn < 46) || (pn >= 50 && pn < 54)) act = 1;
        else if ((pn >= 22 && pn < 26) || pn >= 54) act = 2;
        const int col0 = pn * 256 + wc * 32 + 8 * fq;
#pragma unroll
        for (int ai = 0; ai < 2; ++ai)
#pragma unroll
            for (int m = 0; m < 4; ++m) { bf16_t* rowp = Y + (size_t)(row0 + ai * 128 + m * 16) * NPAD + col0;
#pragma unroll
                for (int bj = 0; bj < 2; ++bj) { f32x4 v0 = acc[ai][bj][m][0], v1 = acc[ai][bj][m][1];
                    if (act == 1) {
#pragma unroll
                        for (int j = 0; j < 4; ++j) { v0[j] = siluf_(v0[j]); v1[j] = siluf_(v1[j]); } }
                    else if (act == 2) {
#pragma unroll
                        for (int j = 0; j < 4; ++j) { v0[j] = sigmoidf_(v0[j] * ps); v1[j] = sigmoidf_(v1[j] * ps); } }
                    u32x4 w; w.x = cvt_pk_bf16(v0[0], v0[1]); w.y = cvt_pk_bf16(v0[2], v0[3]); w.z = cvt_pk_bf16(v1[0], v1[1]); w.w = cvt_pk_bf16(v1[2], v1[3]);
                    *(u32x4*)(rowp + bj * 128) = w; } }
    }
};

struct EpiGate8 {
    static constexpr bool PERM = true;
    bf16_t* Y;
    __device__ __forceinline__ void operator()(const f32x4 (&acc)[2][2][4][2], const pg8::Unit& u, int wr, int wc, int fr, int fq) const {
        int opq = 0; asm volatile("" : "+v"(opq));
        const int row0 = u.pm * 256 + wr * 64 + fr + opq, col0 = u.pn * 256 + wc * 32 + 8 * fq; const bool gate = u.pn >= 54;
#pragma unroll
        for (int ai = 0; ai < 2; ++ai)
#pragma unroll
            for (int m = 0; m < 4; ++m) { bf16_t* rowp = Y + (size_t)(row0 + ai * 128 + m * 16) * NPAD + col0;
#pragma unroll
                for (int bj = 0; bj < 2; ++bj) { float o[8];
#pragma unroll
                    for (int j = 0; j < 4; ++j) { const float x0 = acc[ai][bj][m][0][j] * (1.0f / 64.0f), x1 = acc[ai][bj][m][1][j] * (1.0f / 64.0f); o[j] = gate ? sigmoidf_(x0) : x0; o[4 + j] = gate ? sigmoidf_(x1) : x1; }
                    *(u32x4*)(rowp + bj * 128) = pack8(o); } }
    }
};
struct SchedPool {
    const char* A; const char* Bt; int G, c, i0;
    __device__ __forceinline__ bool next(int i, pg8::Unit& u) const {
        const long L = (long)i * G + c; if (L >= (MROWS / 256) * 4) return false;
        const int pm = (int)(L >> 2), g = (int)(L & 3);
        u.pm = pm; u.pn = g; u.tag = 0; u.a = A + ((size_t)pm * 256 * BRW + g * 256) * 2; u.b = Bt + (size_t)g * 256 * 256 * 2; return true; }
};
struct EpiPool {
    static constexpr bool PERM = true;
    bf16_t* Y;
    __device__ __forceinline__ void operator()(const f32x4 (&acc)[2][2][4][2], const pg8::Unit& u, int wr, int wc, int fr, int fq) const {
        int opq = 0; asm volatile("" : "+v"(opq));
        const int row0 = u.pm * 256 + wr * 64 + fr + opq, colc = u.pn * 256 + wc * 32 + 8 * fq;
#pragma unroll
        for (int ai = 0; ai < 2; ++ai) {
            u32x4 zw[4][2];
#pragma unroll
            for (int m = 0; m < 4; ++m)
#pragma unroll
                for (int bj = 0; bj < 2; ++bj) zw[m][bj] = *(const u32x4*)(Y + (size_t)(row0 + ai * 128 + m * 16) * NPAD + C_PZ + colc + bj * 128);
#pragma unroll
            for (int m = 0; m < 4; ++m)
#pragma unroll
                for (int bj = 0; bj < 2; ++bj) { float z[8]; unpack8(zw[m][bj], z);
                    const f32x4 v0 = acc[ai][bj][m][0], v1 = acc[ai][bj][m][1]; float o[8];
#pragma unroll
                    for (int j = 0; j < 4; ++j) { o[j] = v0[j] * z[j]; o[4 + j] = v1[j] * z[4 + j]; }
                    *(u32x4*)(Y + (size_t)(row0 + ai * 128 + m * 16) * NPAD + C_PZ + colc + bj * 128) = pack8(o); }
            asm volatile("" ::: "memory"); }
    }
};

struct SchedMerge {
    const char* Y; const char* Wbr; int G, c, nM;
    __device__ __forceinline__ bool next(int i, pg8::Unit& u) const {
        const long L = (long)(i >> 2) * G + c; const int br = i & 3; if (L >= (long)nM * 8) return false;
        const int pm = (int)(L >> 3), pn = (int)(L & 7);
        const int pmr = (nM == 64) ? (pm + pm / 16) : pm;
        const int coff = br == 0 ? C_AQ : (br == 1 ? C_MO : (br == 2 ? C_CZ : C_PZ));
        u.pm = pmr; u.pn = pn; u.tag = br; u.a = Y + ((size_t)pmr * 256 * NPAD + coff) * 2; u.b = Wbr + ((size_t)br * DM * BRW + (size_t)pn * 256 * BRW) * 2; return true; }
};
struct EpiMerge {
    static constexpr bool PERM = true;
    const bf16_t* Y; bf16_t* accb;
    __device__ __forceinline__ void operator()(const f32x4 (&acc)[2][2][4][2], const pg8::Unit& u, int wr, int wc, int fr, int fq) const {
        int opq = 0; asm volatile("" : "+v"(opq));
        const int row0 = u.pm * 256 + wr * 64 + fr + opq, col0 = u.pn * 256 + wc * 32 + 8 * fq, tag = u.tag;
#pragma unroll
        for (int ai = 0; ai < 2; ++ai) {
            u32x4 gw[4][2], pw[4][2];
#pragma unroll
            for (int m = 0; m < 4; ++m) { const size_t row = (size_t)(row0 + ai * 128 + m * 16);
#pragma unroll
                for (int bj = 0; bj < 2; ++bj) { gw[m][bj] = *(const u32x4*)(Y + row * NPAD + C_GM + tag * DM + col0 + bj * 128);
                    pw[m][bj] = tag != 0 ? *(const u32x4*)(accb + row * DM + col0 + bj * 128) : (u32x4){0u, 0u, 0u, 0u}; } }
#pragma unroll
            for (int m = 0; m < 4; ++m) { const size_t row = (size_t)(row0 + ai * 128 + m * 16);
#pragma unroll
                for (int bj = 0; bj < 2; ++bj) { float gt[8], pv[8]; unpack8(gw[m][bj], gt); unpack8(pw[m][bj], pv);
                    const f32x4 v0 = acc[ai][bj][m][0], v1 = acc[ai][bj][m][1]; float o[8];
#pragma unroll
                    for (int j = 0; j < 4; ++j) { o[j] = v0[j] * gt[j] + pv[j]; o[4 + j] = v1[j] * gt[4 + j] + pv[4 + j]; }
                    *(u32x4*)(accb + row * DM + col0 + bj * 128) = pack8(o); } }
            asm volatile("" ::: "memory"); }
    }
};

struct SchedOut {
    const char* A; const char* Bt; int G, c, nM;
    __device__ __forceinline__ bool next(int i, pg8::Unit& u) const {
        const long L = (long)i * G + c; if (L >= (long)nM * 8) return false;
        const int pm = (int)(L >> 3), pn = (int)(L & 7);
        const int pmr = (nM == 64) ? (pm + pm / 16) : pm;
        u.pm = pmr; u.pn = pn; u.tag = 0; u.a = A + (size_t)pmr * 256 * DM * 2; u.b = Bt + (size_t)pn * 256 * DM * 2; return true; }
};
struct EpiOut {
    static constexpr bool PERM = false;
    const float* xin; const float* ctxin;
    const float* mod;
    bf16_t* X1; int first;
    __device__ __forceinline__ void operator()(const f32x4 (&acc)[2][2][4][2], const pg8::Unit& u, int wr, int wc, int fr, int fq) const {
        const int b = u.pm / 17, j = u.pm % 17; const bool isctx = (j == 16);
        int opq = 0; asm volatile("" : "+v"(opq));
        const int rin = wr * 64 + fr + opq;
        const int col0 = u.pn * 256 + wc * 32 + 4 * fq;
        const float* gtp = mod + (size_t)(isctx ? 4 : b) * 6144 + 4096 + col0;
        const float* resb = isctx ? ctxin + (size_t)b * LC * DM : xin + ((size_t)b * TL + (size_t)j * 256) * DM;
        bf16_t* xb = X1 + (size_t)u.pm * 256 * DM;
        f32x4 gv[2][2];
#pragma unroll
        for (int bj = 0; bj < 2; ++bj)
#pragma unroll
            for (int n = 0; n < 2; ++n) gv[bj][n] = *(const f32x4*)(gtp + bj * 128 + n * 16);
#pragma unroll
        for (int ai = 0; ai < 2; ++ai) {
            f32x4 rv[4][2][2];
#pragma unroll
            for (int m = 0; m < 4; ++m) { const size_t off = (size_t)(rin + ai * 128 + m * 16) * DM + col0;
#pragma unroll
                for (int bj = 0; bj < 2; ++bj)
#pragma unroll
                    for (int n = 0; n < 2; ++n) {
                        if (first) rv[m][bj][n] = *(const f32x4*)(resb + off + bj * 128 + n * 16);
                        else { const u32x2 w = *(const u32x2*)(xb + off + bj * 128 + n * 16); rv[m][bj][n] = (f32x4){bflo(w.x), bfhi(w.x), bflo(w.y), bfhi(w.y)}; } } }
#pragma unroll
            for (int m = 0; m < 4; ++m) { const size_t off = (size_t)(rin + ai * 128 + m * 16) * DM + col0;
#pragma unroll
                for (int bj = 0; bj < 2; ++bj)
#pragma unroll
                    for (int n = 0; n < 2; ++n) { const f32x4 o = rv[m][bj][n] + gv[bj][n] * acc[ai][bj][m][n];
                        u32x2 w; w.x = cvt_pk_bf16(o[0], o[1]); w.y = cvt_pk_bf16(o[2], o[3]); *(u32x2*)(xb + off + bj * 128 + n * 16) = w; } }
            asm volatile("" ::: "memory"); }
    }
};

namespace att {
using pg8::v4i_t; using pg8::v8i_t;
constexpr int D = 128, NW = 8, QBLK = 32, KVBLK = 64;
constexpr float SCALE = 0.088388347648318440f;
constexpr float THR = 5.f;
constexpr int LDQ = NPAD, LDK = NPAD;
constexpr size_t SHM_V = KVBLK * D * 2, SHM_K = KVBLK * D * 2, SHM_ATTN = 2 * SHM_V + 2 * SHM_K + NW * 64 * 4;
#define KSWZ(row, colB) ((row) * 256 + ((colB) ^ (((row) & 7) << 4)))
#define SBAR() __builtin_amdgcn_sched_barrier(0)
__device__ __forceinline__ int crow(int r, int hi) { return (r & 3) + 8 * (r >> 2) + 4 * hi; }
__device__ __forceinline__ void partialSM(f32x16& p0, f32x16& p1, float& m_reg, float& mn, float& alpha) {
  constexpr float C = SCALE * 1.4426950408889634f;
  float pmax = p0[0]; for (int r = 1; r < 16; ++r) pmax = fmaxf(pmax, p0[r]); for (int r = 0; r < 16; ++r) pmax = fmaxf(pmax, p1[r]);
  { auto rr = __builtin_amdgcn_permlane32_swap(__float_as_uint(pmax), __float_as_uint(pmax), false, false);
    pmax = fmaxf(__uint_as_float(rr[0]), __uint_as_float(rr[1])); }
  if (__builtin_expect(__all(pmax - m_reg <= THR / SCALE), 1)) { mn = m_reg; alpha = 1.f; }
  else { mn = fmaxf(m_reg, pmax); alpha = __builtin_amdgcn_exp2f((m_reg - mn) * C); m_reg = mn; }
  float mnC = -mn * C;
  for (int r = 0; r < 16; ++r) p0[r] = fmaf(p0[r], C, mnC); for (int r = 0; r < 16; ++r) p1[r] = fmaf(p1[r], C, mnC);
  for (int r = 0; r < 16; ++r) p0[r] = __builtin_amdgcn_exp2f(p0[r]);
}
__device__ __forceinline__ void finishSM(f32x16& p0, f32x16& p1, float alpha, float& l_reg, v8i_t& p8) {
  for (int r = 0; r < 16; ++r) p1[r] = __builtin_amdgcn_exp2f(p1[r]);
  float ps = 0; for (int r = 0; r < 16; ++r) ps += p0[r]; for (int r = 0; r < 16; ++r) ps += p1[r];
  { auto rr = __builtin_amdgcn_permlane32_swap(__float_as_uint(ps), __float_as_uint(ps), false, false);
    ps = __uint_as_float(rr[0]) + __uint_as_float(rr[1]); }
  l_reg = l_reg * alpha + ps;
#pragma unroll
  for (int i = 0; i < 4; ++i) { int w = __builtin_amdgcn_cvt_pk_fp8_f32(p0[4 * i], p0[4 * i + 1], 0, false); w = __builtin_amdgcn_cvt_pk_fp8_f32(p0[4 * i + 2], p0[4 * i + 3], w, true); p8[i] = w;
    int v = __builtin_amdgcn_cvt_pk_fp8_f32(p1[4 * i], p1[4 * i + 1], 0, false); v = __builtin_amdgcn_cvt_pk_fp8_f32(p1[4 * i + 2], p1[4 * i + 3], v, true); p8[4 + i] = v; }
}
#define KSWZ8(row, colB) ((row) * 128 + ((colB) ^ (((row) & 7) << 4)))
__device__ __forceinline__ u32x2 bf8x_to_fp8(bf16x8 x) {
  const u32x4 w = __builtin_bit_cast(u32x4, x);
  int lo = __builtin_amdgcn_cvt_pk_fp8_f32(bflo(w.x), bfhi(w.x), 0, false); lo = __builtin_amdgcn_cvt_pk_fp8_f32(bflo(w.y), bfhi(w.y), lo, true);
  int hi = __builtin_amdgcn_cvt_pk_fp8_f32(bflo(w.z), bfhi(w.z), 0, false); hi = __builtin_amdgcn_cvt_pk_fp8_f32(bflo(w.w), bfhi(w.w), hi, true);
  return (u32x2){(unsigned)lo, (unsigned)hi};
}
__device__ __forceinline__ void qkt(f32x16& p0, f32x16& p1, const char* Ks, const v8i_t* q8, int r32, int hi) {
  const int c0 = 32 * hi, c1 = 64 + 32 * hi;
  const v8i_t a00 = __builtin_shufflevector(*(const v4i_t*)(Ks + KSWZ8(r32, c0)), *(const v4i_t*)(Ks + KSWZ8(r32, c0 + 16)), 0, 1, 2, 3, 4, 5, 6, 7);
  const v8i_t a10 = __builtin_shufflevector(*(const v4i_t*)(Ks + KSWZ8(32 + r32, c0)), *(const v4i_t*)(Ks + KSWZ8(32 + r32, c0 + 16)), 0, 1, 2, 3, 4, 5, 6, 7);
  const v8i_t a01 = __builtin_shufflevector(*(const v4i_t*)(Ks + KSWZ8(r32, c1)), *(const v4i_t*)(Ks + KSWZ8(r32, c1 + 16)), 0, 1, 2, 3, 4, 5, 6, 7);
  const v8i_t a11 = __builtin_shufflevector(*(const v4i_t*)(Ks + KSWZ8(32 + r32, c1)), *(const v4i_t*)(Ks + KSWZ8(32 + r32, c1 + 16)), 0, 1, 2, 3, 4, 5, 6, 7);
  asm volatile("v_mfma_f32_32x32x64_f8f6f4 %0, %1, %2, 0" : "=&v"(p0) : "v"(a00), "v"(q8[0]));
  asm volatile("v_mfma_f32_32x32x64_f8f6f4 %0, %1, %2, 0" : "=&v"(p1) : "v"(a10), "v"(q8[0]));
  asm volatile("v_mfma_f32_32x32x64_f8f6f4 %0, %1, %2, %0" : "+v"(p0) : "v"(a01), "v"(q8[1]));
  asm volatile("v_mfma_f32_32x32x64_f8f6f4 %0, %1, %2, %0\n\ts_nop 15\n\ts_nop 15" : "+v"(p1) : "v"(a11), "v"(q8[1]));
}
__device__ __forceinline__ int v_st(int k, int c) { const int kk = (k & ~0xC) | ((k & 4) << 1) | ((k & 8) >> 1); return ((kk >> 3) * 4 + (c >> 5)) * 512 + ((kk & 7) * 32 + (c & 31)) * 2; }
__device__ __forceinline__ int v_rd_base(int lane) { return ((lane & 3) << 3) | (((lane >> 2) & 3) << 6) | (((lane >> 4) & 1) << 5) | (((lane >> 5) & 1) << 8); }
constexpr int v_rd_off(int d0, int ks, int half) { return d0 * 512 + ks * 4096 + half * 2048; }
template <int OFF> __device__ __forceinline__ s16x4 tr_read(int vb) {
  s16x4 r; asm volatile("ds_read_b64_tr_b16 %0, %1 offset:%2" : "=&v"(r) : "v"(vb), "i"(OFF) : "memory"); return r;
}
__device__ __forceinline__ void pv_d0(f32x16* o, const char* Vs, v8i_t p8, int r32, int hi) {
  v8i_t vb[4];
#pragma unroll
  for (int d0 = 0; d0 < 4; ++d0) { const char* vp = Vs + (32 * d0 + r32) * 80 + 32 * hi;
    vb[d0] = __builtin_shufflevector(*(const v4i_t*)vp, *(const v4i_t*)(vp + 16), 0, 1, 2, 3, 4, 5, 6, 7); }
  asm volatile("s_nop 4\n\tv_mfma_f32_32x32x64_f8f6f4 %0, %1, %2, %0" : "+v"(o[0]) : "v"(p8), "v"(vb[0]));
  asm volatile("v_mfma_f32_32x32x64_f8f6f4 %0, %1, %2, %0" : "+v"(o[1]) : "v"(p8), "v"(vb[1]));
  asm volatile("v_mfma_f32_32x32x64_f8f6f4 %0, %1, %2, %0" : "+v"(o[2]) : "v"(p8), "v"(vb[2]));
  asm volatile("v_mfma_f32_32x32x64_f8f6f4 %0, %1, %2, %0\n\ts_nop 15\n\ts_nop 15" : "+v"(o[3]) : "v"(p8), "v"(vb[3]));
}
__device__ __forceinline__ void attn_dense_body(bf16_t* __restrict__ Qb, const unsigned char* __restrict__ K8h, const unsigned char* __restrict__ V8t, const bf16_t* __restrict__ Zb, int seq, char* lds) {
  const int tid = otid(), wid = tid >> 6, lane = tid & 63, r32 = lane & 31, hi = lane >> 5;
  bf16_t* V_lds = (bf16_t*)lds; bf16_t* K_lds = (bf16_t*)(lds + 2 * SHM_V);
  float* ws = (float*)(lds + 2 * SHM_V + 2 * SHM_K) + wid * 64; float* li_l = ws; float* al_l = ws + 32;
  float m_reg = -1e30f, l_reg = 0; f32x16 o[4] = {}; v8i_t qr[2];
  const bf16_t* Qw = Qb + (long)(wid * QBLK + r32) * LDQ + hi * 32;
#pragma unroll
  for (int j = 0; j < 2; ++j) { u32x2 c[4];
#pragma unroll
    for (int e = 0; e < 4; ++e) c[e] = bf8x_to_fp8(*reinterpret_cast<const bf16x8*>(Qw + j * 64 + e * 8));
    qr[j] = (v8i_t){(int)c[0].x, (int)c[0].y, (int)c[1].x, (int)c[1].y, (int)c[2].x, (int)c[2].y, (int)c[3].x, (int)c[3].y}; }
  const int sr = tid >> 4, sc = (tid & 15) * 8;
  struct { u32x4 vs0; u32x2 ks0, ks1; } sr_[2];
#define SLOAD(i, k0) do { sr_[i].vs0 = *reinterpret_cast<const u32x4*>(V8t + (long)((k0) >> 6) * 8192 + tid * 16); \
    sr_[i].ks0 = *reinterpret_cast<const u32x2*>(K8h + (long)((k0) + sr) * 256 + sc); sr_[i].ks1 = *reinterpret_cast<const u32x2*>(K8h + (long)((k0) + 32 + sr) * 256 + sc); } while (0)
#define SWRITE(b, i) do { *(u32x4*)((char*)V_lds + (b) * SHM_V + (tid >> 2) * 80 + (tid & 3) * 16) = sr_[i].vs0;          \
    *(u32x2*)((char*)K_lds + (b) * SHM_K + KSWZ8(sr, sc)) = sr_[i].ks0;                       \
    *(u32x2*)((char*)K_lds + (b) * SHM_K + KSWZ8(32 + sr, sc)) = sr_[i].ks1; } while (0)
#define SWAIT() do { asm volatile("s_waitcnt vmcnt(3)" ::: "memory"); } while (0)
#define RESC(a) do { if (__any((a) < 1.f)) { if (hi == 0) al_l[r32] = (a); asm volatile("s_waitcnt lgkmcnt(0)" ::: "memory"); \
    for (int d = 0; d < 4; ++d) for (int r = 0; r < 16; ++r) o[d][r] *= al_l[crow(r, hi)]; } } while (0)
  f32x16 pA0, pA1, pB0, pB1; float mnA, mnB, alA, alB; v8i_t p8; const int NT = seq / KVBLK;
  constexpr int SE = 0, SO = 1;
  SLOAD(SE, 0); asm volatile("s_waitcnt vmcnt(0)" ::: "memory"); SWRITE(0, SE); __syncthreads();
  qkt(pA0, pA1, (const char*)K_lds, qr, r32, hi); partialSM(pA0, pA1, m_reg, mnA, alA);
  SLOAD(SO, KVBLK); { if (2 < NT) SLOAD(SE, 2 * KVBLK); }
  SWAIT(); SWRITE(1, SO); __syncthreads();
  for (int j = 1; j + 1 < NT; j += 2) {
    SBAR(); qkt(pB0, pB1, (const char*)K_lds + SHM_K, qr, r32, hi);
    finishSM(pA0, pA1, alA, l_reg, p8); SBAR();
    SLOAD(SO, (j + 2) * KVBLK); SBAR();
    pv_d0(o, (const char*)V_lds, p8, r32, hi); partialSM(pB0, pB1, m_reg, mnB, alB);
    __syncthreads(); SWAIT(); SWRITE(0, SE);
    RESC(alB); __syncthreads();
    SBAR(); qkt(pA0, pA1, (const char*)K_lds, qr, r32, hi);
    finishSM(pB0, pB1, alB, l_reg, p8); SBAR();
    if (j + 3 < NT) SLOAD(SE, (j + 3) * KVBLK); SBAR();
    pv_d0(o, (const char*)V_lds + SHM_V, p8, r32, hi); partialSM(pA0, pA1, m_reg, mnA, alA);
    __syncthreads(); SWAIT(); SWRITE(1, SO);
    RESC(alA); __syncthreads();
  }
  SBAR(); qkt(pB0, pB1, (const char*)K_lds + SHM_K, qr, r32, hi);
  finishSM(pA0, pA1, alA, l_reg, p8); SBAR();
  pv_d0(o, (const char*)V_lds, p8, r32, hi); partialSM(pB0, pB1, m_reg, mnB, alB);
  __syncthreads(); RESC(alB);
  finishSM(pB0, pB1, alB, l_reg, p8); SBAR();
  pv_d0(o, (const char*)V_lds + SHM_V, p8, r32, hi);
  if (hi == 0) li_l[r32] = l_reg; asm volatile("s_waitcnt lgkmcnt(0)" ::: "memory");
  float rli[16];
#pragma unroll
  for (int r = 0; r < 16; ++r) rli[r] = __builtin_amdgcn_rcpf(li_l[crow(r, hi)]);
  bf16_t* Ol = (bf16_t*)(lds + SHM_ATTN) + wid * (32 * 136);
#pragma unroll
  for (int r = 0; r < 16; ++r) { const int row = crow(r, hi);
#pragma unroll
    for (int d0 = 0; d0 < 4; ++d0) Ol[row * 136 + 32 * d0 + r32] = f2bf(o[d0][r] * rli[r]); }
  asm volatile("s_waitcnt lgkmcnt(0)" ::: "memory");
  int opq = 0; asm volatile("" : "+v"(opq));
  const long gbase = (long)(wid * QBLK + opq) * LDQ;
  u32x4 ov[8], zv[8];
#pragma unroll
  for (int it = 0; it < 8; ++it) { const int chunk = it * 64 + lane, row = chunk >> 4, c8 = (chunk & 15) * 8;
    ov[it] = *(const u32x4*)(Ol + row * 136 + c8); zv[it] = *(const u32x4*)(Zb + gbase + (long)row * LDQ + c8); }
#pragma unroll
  for (int it = 0; it < 8; ++it) { const int chunk = it * 64 + lane, row = chunk >> 4, c8 = (chunk & 15) * 8;
    float of[8], zf[8], rf[8]; unpack8(ov[it], of); unpack8(zv[it], zf);
#pragma unroll
    for (int e = 0; e < 8; ++e) rf[e] = of[e] * zf[e];
    *(u32x4*)(Qb + gbase + (long)row * LDQ + c8) = pack8(rf); }
#undef SLOAD
#undef SWRITE
#undef SWAIT
#undef RESC
}
}

template <int KT>
__device__ __forceinline__ void tconv_tile(const float* __restrict__ src, int ld, int K, bool remap, bf16_t* __restrict__ dst, int n0, int k0, unsigned char* smem, const float* __restrict__ nscale = nullptr) {
    const int tid = otid(), kk = tid >> 4, n4 = (tid & 15) * 4;
    constexpr int LDT = KT + 8, NJ = KT / 32;
    bf16_t* tile = (bf16_t*)smem;
    const int n = n0 + n4; int sc = n; bool zero = false;
    if (remap) { if (n < 7680) sc = n; else if (n < 22016) sc = n + 16; else if (n < 22032) sc = 7680 + (n - 22016); else zero = true; }
    f32x4 v[NJ];
    const f32x4 nsc = nscale ? *(const f32x4*)(nscale + n) : (f32x4){1.f, 1.f, 1.f, 1.f};
#pragma unroll
    for (int j = 0; j < NJ; ++j) v[j] = zero ? (f32x4){0.f, 0.f, 0.f, 0.f} : *(const f32x4*)(src + (size_t)(k0 + kk + 32 * j) * ld + sc) * nsc;
#pragma unroll
    for (int j = 0; j < NJ; ++j)
#pragma unroll
        for (int i = 0; i < 4; ++i) tile[(n4 + i) * LDT + kk + 32 * j] = f2bf(v[j][i]);
    __syncthreads();
#pragma unroll
    for (int j = 0; j < KT / 64; ++j) { const int idx = tid + 512 * j, nn = idx / (KT / 8), k8 = (idx % (KT / 8)) * 8;
        *(u32x4*)(dst + (size_t)(n0 + nn) * K + k0 + k8) = *(const u32x4*)(tile + nn * LDT + k8); }
    __syncthreads();
}
__device__ __forceinline__ void mod_unit(const Params& p, int l, int cb, unsigned char* smem) {
    const int tid = otid();
    float* sc = (float*)smem; float* red = sc + 5 * 2048;
    for (int i = tid; i < 5 * 2048; i += 512) { const int r = i >> 11, k = i & 2047; const float v = r < 4 ? p.c[r * 2048 + k] : p.c_ctx[k]; sc[i] = siluf_(v); }
    __syncthreads();
    const int col4 = (tid & 15) * 4, ks = tid >> 4;
    f32x4 a0 = {0, 0, 0, 0}, a1 = a0, a2 = a0, a3 = a0, a4 = a0;
    const float* wp = p.w_mod + (size_t)l * 2048 * 6144 + (size_t)(ks * 64) * 6144 + cb * 64 + col4;
#pragma unroll 8
    for (int kk = 0; kk < 64; ++kk) { const f32x4 w = *(const f32x4*)(wp + (size_t)kk * 6144); const int k = ks * 64 + kk;
        a0 += sc[k] * w; a1 += sc[2048 + k] * w; a2 += sc[4096 + k] * w; a3 += sc[6144 + k] * w; a4 += sc[8192 + k] * w; }
    *(f32x4*)(red + (ks * 5 + 0) * 64 + col4) = a0; *(f32x4*)(red + (ks * 5 + 1) * 64 + col4) = a1; *(f32x4*)(red + (ks * 5 + 2) * 64 + col4) = a2;
    *(f32x4*)(red + (ks * 5 + 3) * 64 + col4) = a3; *(f32x4*)(red + (ks * 5 + 4) * 64 + col4) = a4;
    __syncthreads();
    if (tid < 320) { const int r = tid >> 6, cc = tid & 63; float s = p.b_mod[l * 6144 + cb * 64 + cc];
        for (int q = 0; q < 32; ++q) s += red[(q * 5 + r) * 64 + cc];
        ((float*)(p.ws + WS_MOD))[(size_t)(l * 5 + r) * 6144 + cb * 64 + cc] = s; }
    __syncthreads();
}
__device__ __forceinline__ void tconv8_tile(const float* __restrict__ src, int ld, int col0, unsigned char* __restrict__ dst, int n0, int k0, unsigned char* smem) {
    const int tid = otid(), kk = tid >> 4, n4 = (tid & 15) * 4;
    constexpr int LDT = 512 + 16;
    unsigned char* tile = smem;
    f32x4 v[16];
#pragma unroll
    for (int j = 0; j < 16; ++j) v[j] = *(const f32x4*)(src + (size_t)(k0 + kk + 32 * j) * ld + col0 + n0 + n4) * 64.0f;
#pragma unroll
    for (int j = 0; j < 16; ++j) { const int w01 = __builtin_amdgcn_cvt_pk_fp8_f32(v[j][0], v[j][1], 0, false), w23 = __builtin_amdgcn_cvt_pk_fp8_f32(v[j][2], v[j][3], 0, false);
        tile[(n4 + 0) * LDT + kk + 32 * j] = (unsigned char)(w01 & 0xff); tile[(n4 + 1) * LDT + kk + 32 * j] = (unsigned char)((w01 >> 8) & 0xff);
        tile[(n4 + 2) * LDT + kk + 32 * j] = (unsigned char)(w23 & 0xff); tile[(n4 + 3) * LDT + kk + 32 * j] = (unsigned char)((w23 >> 8) & 0xff); }
    __syncthreads();
#pragma unroll
    for (int j = 0; j < 4; ++j) { const int idx = tid + 512 * j, nn = idx >> 5, k16 = (idx & 31) * 16;
        *(u32x4*)(dst + (size_t)(n0 + nn) * DM + k0 + k16) = *(const u32x4*)(tile + nn * LDT + k16); }
    __syncthreads();
}
constexpr int U_WINB = 196 * 4, U_W8 = NT8 * 4 * 4, U_WIN1 = U_WINB + U_W8, U_WBR1 = 4 * 32 * 2, U_WOUT1 = 32 * 4, U_POOL1 = 4 * 4, U_CONV1 = U_WIN1 + U_WBR1 + U_WOUT1 + U_POOL1;
__device__ __forceinline__ void conv_unit(const Params& p, int l, int v, unsigned char* smem) {
    if (v < U_WINB) { const int t = v >> 2, nt = t < 192 ? t + 24 : t + 152, kt = v & 3;
        tconv_tile<512>(p.w_in + (size_t)l * DM * NIN, NIN, DM, true, (bf16_t*)(p.ws + WS_WIN) + (size_t)l * NPAD * DM, nt * 64, kt * 512, smem); return; }
    if (v < U_WIN1) { const int w = v - U_WINB, nt = w >> 2, kt = w & 3, q = nt >> 2, col = pn_of_q8(q) * 256 + (nt & 3) * 64;
        tconv8_tile(p.w_in + (size_t)l * DM * NIN, NIN, (col < 7680 ? col : col + 16) - nt * 64, p.ws + WS_W8 + (size_t)l * NT8 * 256 * DM, nt * 64, kt * 512, smem); return; }
    v -= U_WIN1;
    if (v < U_WBR1) { const int mat = l * 4 + (v >> 6), r = v & 63, nt = r >> 1, kt = r & 1;
        tconv_tile<512>(p.w_branch + (size_t)mat * BRW * DM, DM, BRW, false, (bf16_t*)(p.ws + WS_WBR) + (size_t)mat * DM * BRW, nt * 64, kt * 512, smem); return; }
    v -= U_WBR1;
    if (v < U_WOUT1) { const int nt = v >> 2, kt = v & 3;
        tconv_tile<512>(p.w_out + (size_t)l * DM * DM, DM, DM, false, (bf16_t*)(p.ws + WS_WOUT) + (size_t)l * DM * DM, nt * 64, kt * 512, smem); return; }
    v -= U_WOUT1;
    { const int mat = l * 4 + (v >> 2), nt = v & 3;
        tconv_tile<256>(p.pool_w + (size_t)mat * 256 * 256, 256, 256, false, (bf16_t*)(p.ws + WS_POOLW) + (size_t)mat * 256 * 256, nt * 64, 0, smem, p.pool_scale + (size_t)mat * 256); }
}
__device__ void phase_prep(const Params& p, unsigned char* smem) {
    constexpr int U_MOD = 192;
    for (int u = blockIdx.x; u < U_MOD + U_CONV1; u += gridDim.x) {
        if (u < U_MOD) mod_unit(p, u / 96, u % 96, smem); else conv_unit(p, 0, u - U_MOD, smem);
    }
}

__device__ void phase_norm(const Params& p, int l) {
    const int tid = otid(), lane = tid & 63, wv = obid() * 8 + (tid >> 6), nwv = gridDim.x * 8;
    const float* mod = (const float*)(p.ws + WS_MOD) + (size_t)l * 5 * 6144;
    const float* gain = p.norm_gain + l * DM;
    bf16_t* H = (bf16_t*)(p.ws + WS_H);
    for (int row = wv; row < MROWS; row += nwv) {
        const int b = row / RPB, tt = row % RPB; const bool isctx = tt >= TL;
        const float* xr = isctx ? p.ctx + ((size_t)b * LC + (tt - TL)) * DM : p.x + ((size_t)b * TL + tt) * DM;
        const bf16_t* xb = (const bf16_t*)(p.ws + WS_X1) + (size_t)row * DM;
        const float* mr = mod + (size_t)(isctx ? 4 : b) * 6144;
        f32x4 v[8]; float ss = 0.f;
#pragma unroll
        for (int j = 0; j < 8; ++j) {
            if (l == 0) v[j] = *(const f32x4*)(xr + 256 * j + 4 * lane);
            else { const u32x2 w = *(const u32x2*)(xb + 256 * j + 4 * lane); v[j] = (f32x4){bflo(w.x), bfhi(w.x), bflo(w.y), bfhi(w.y)}; }
            ss += v[j][0] * v[j][0] + v[j][1] * v[j][1] + v[j][2] * v[j][2] + v[j][3] * v[j][3]; }
#pragma unroll
        for (int o = 32; o >= 1; o >>= 1) ss += __shfl_xor(ss, o);
        const float rstd = rsqrtf(ss * (1.0f / DM) + EPS);
#pragma unroll
        for (int j = 0; j < 8; ++j) { const int cidx = 256 * j + 4 * lane;
            const f32x4 g = *(const f32x4*)(gain + cidx), sh = *(const f32x4*)(mr + cidx), sc = *(const f32x4*)(mr + 2048 + cidx);
            f32x4 y = v[j] * rstd * g * (1.0f + sc) + sh;
            u32x2 w; w.x = cvt_pk_bf16(y[0], y[1]); w.y = cvt_pk_bf16(y[2], y[3]);
            *(u32x2*)(H + (size_t)row * DM + cidx) = w;
            int w8 = __builtin_amdgcn_cvt_pk_fp8_f32(y[0], y[1], 0, false); w8 = __builtin_amdgcn_cvt_pk_fp8_f32(y[2], y[3], w8, true);
            *(int*)(p.ws + WS_H8 + (size_t)row * DM + cidx) = w8; }
    }
}
__device__ void phase_final(const Params& p) {
    const int tid = otid(), lane = tid & 63, wv = obid() * 8 + (tid >> 6), nwv = gridDim.x * 8;
    for (int row = wv; row < NB * TL; row += nwv) {
        const int b = row / TL, t = row % TL;
        const bf16_t* xb = (const bf16_t*)(p.ws + WS_X1) + (size_t)(b * RPB + t) * DM;
        float* xr = p.out + (size_t)row * DM;
        f32x4 v[8]; float ss = 0.f;
#pragma unroll
        for (int j = 0; j < 8; ++j) { const u32x2 w = *(const u32x2*)(xb + 256 * j + 4 * lane); v[j] = (f32x4){bflo(w.x), bfhi(w.x), bflo(w.y), bfhi(w.y)};
            ss += v[j][0] * v[j][0] + v[j][1] * v[j][1] + v[j][2] * v[j][2] + v[j][3] * v[j][3]; }
#pragma unroll
        for (int o = 32; o >= 1; o >>= 1) ss += __shfl_xor(ss, o);
        const float rstd = rsqrtf(ss * (1.0f / DM) + EPS);
#pragma unroll
        for (int j = 0; j < 8; ++j) { const int cidx = 256 * j + 4 * lane; const f32x4 g = *(const f32x4*)(p.final_gain + cidx); *(f32x4*)(xr + cidx) = v[j] * rstd * g; }
    }
}

__device__ __forceinline__ int seq_row(int b, int dir, int pos  ) {
    if (pos < LC) { const int o = dir ? (LC - 1 - pos) : pos; return b * RPB + TL + o; }
    const int q = pos - LC; const int o = dir ? (TL - 1 - q) : q; return b * RPB + o;
}
__device__ void phase_mix1(const Params& p, int l, unsigned char* smem) {
    const int tid = otid(), lane = tid & 63, wv = obid() * 8 + (tid >> 6), nwv = gridDim.x * 8;
    bf16_t* Y = (bf16_t*)(p.ws + WS_Y);
    if ((int)blockIdx.x >= (int)gridDim.x - 32) {
        const int sq = blockIdx.x - (gridDim.x - 32), dir = sq & 1, hd = (sq >> 1) & 3, b = sq >> 3, wid = tid >> 6;
        const float* G32 = (const float*)(p.ws + WS_G32);
        f32x4* GT4 = (f32x4*)(p.ws + WS_GT4) + (size_t)sq * RPB; float* GW = (float*)(p.ws + WS_GW) + (size_t)sq * RPB; float* GD = (float*)(p.ws + WS_GD) + sq * 128;
        const float bi = p.gate_bias[l * 16 + (dir ? 8 : 0) + hd], bfv = p.gate_bias[l * 16 + (dir ? 12 : 4) + hd];
        float* sAq = (float*)smem; float* sCm = sAq + RPB; float* sB = sCm + RPB; float* sB63 = sB + RPB; float* sC63 = sB63 + 128; float* sMc = sC63 + 128;
        for (int ci = wid; ci < NCHUNK; ci += 8) {
            const int pos = ci * 64 + lane, row = seq_row(b, dir, pos);
            const float gi = G32[(size_t)row * 16 + (dir ? 8 : 0) + hd] + bi, gf = G32[(size_t)row * 16 + (dir ? 12 : 4) + hd] + bfv;
            const float lf = fminf(gf, 0.f) - log1pf(__expf(-fabsf(gf)));
            float bsum = lf;
#pragma unroll
            for (int o = 1; o < 64; o <<= 1) { const float t = __shfl_up(bsum, o); if (lane >= o) bsum += t; }
            const float a = gi - bsum; float cm = a;
#pragma unroll
            for (int o = 1; o < 64; o <<= 1) { const float t = __shfl_up(cm, o); if (lane >= o) cm = fmaxf(cm, t); }
            sAq[pos] = a; sCm[pos] = cm; sB[pos] = bsum;
            if (lane == 63) { sB63[ci] = bsum; sC63[ci] = cm; }
        }
        __syncthreads();
        if (tid == 0) { float m = -1e30f; for (int ci = 0; ci < NCHUNK; ++ci) { sMc[ci] = m; m = sB63[ci] + fmaxf(m, sC63[ci]); } }
        __syncthreads();
        for (int pos = tid; pos < RPB; pos += 512) {
            const int ci = pos >> 6; const float m = sMc[ci], M = fmaxf(m, sCm[pos]), M63 = fmaxf(m, sC63[ci]), a = sAq[pos], bsum = sB[pos];
            GT4[pos] = (f32x4){a, M, fexp(m - M), fexp(-(bsum + M))}; GW[pos] = fexp(a - M63); if ((pos & 63) == 0) GD[ci] = fexp(m - M63);
        }
        return;
    }
    const int nw2 = nwv - 32 * 8;
    {
        const float* qg = p.q_gain + l * 128; const float* kg = p.k_gain + l * 128;
        const int j = lane & 31, hw = lane >> 5;
        const bool second = (j >> 3) & 1, colpart = j >= 16;
        float frq[4];
#pragma unroll
        for (int e = 0; e < 4; ++e) frq[e] = __builtin_amdgcn_exp2f(-(float)(4 * (j & 7) + e) * (13.287712379549449f / 32.0f));
        const f32x4 qg4 = *(const f32x4*)(qg + 4 * j), kg4 = *(const f32x4*)(kg + 4 * j);
        for (int row = wv; row < MROWS; row += nw2) {
            const int tt = row % RPB; const bool lat = tt < TL;
            float cs[4], sn[4];
            const float pos = lat ? (float)(colpart ? (tt & 63) : (tt >> 6)) : 0.f;
#pragma unroll
            for (int e = 0; e < 4; ++e) { const float ang = pos * frq[e]; cs[e] = __cosf(ang); sn[e] = __sinf(ang); }
            bf16_t* rb = Y + (size_t)row * NPAD + 4 * j;
            u32x2 raw[5];
#pragma unroll
            for (int it = 0; it < 5; ++it) { const int hh = it * 2 + hw; raw[it] = *(const u32x2*)(rb + (hh < 8 ? C_AQ + hh * 128 : C_AK + (hh - 8) * 128)); }
#pragma unroll
            for (int it = 0; it < 5; ++it) { const int hh = it * 2 + hw;
                float x[4] = {bflo(raw[it].x), bfhi(raw[it].x), bflo(raw[it].y), bfhi(raw[it].y)};
                float ss = x[0] * x[0] + x[1] * x[1] + x[2] * x[2] + x[3] * x[3];
#pragma unroll
                for (int o = 16; o >= 1; o >>= 1) ss += __shfl_xor(ss, o);
                const float rstd = rsqrtf(ss * (1.0f / 128.0f) + EPS);
                const f32x4 gn = hh < 8 ? qg4 : kg4;
                float y[4];
#pragma unroll
                for (int e = 0; e < 4; ++e) { x[e] *= rstd * gn[e]; }
#pragma unroll
                for (int e = 0; e < 4; ++e) { const float pr = __shfl_xor(x[e], 8); y[e] = second ? (x[e] * cs[e] + pr * sn[e]) : (x[e] * cs[e] - pr * sn[e]); }
                u32x2 w; w.x = cvt_pk_bf16(y[0], y[1]); w.y = cvt_pk_bf16(y[2], y[3]);
                if (hh < 8) *(u32x2*)(rb + C_AQ + hh * 128) = w;
                if (hh >= 8) { int k8 = __builtin_amdgcn_cvt_pk_fp8_f32(y[0], y[1], 0, false); k8 = __builtin_amdgcn_cvt_pk_fp8_f32(y[2], y[3], k8, true);
                    *(int*)(p.ws + WS_K8 + (size_t)row * 256 + (hh - 8) * 128 + 4 * j) = k8; }
            }
        }
    }
    {
        const int nth = nw2 * 64, th = wv * 64 + lane;
        for (int task = th; task < NB * 2 * NCHUNK * 128 * 8; task += nth) {
            const int d = task & 127, g = (task >> 7) & 7, T = (task >> 10) % NCHUNK, bk = (task >> 10) / NCHUNK, kvh = bk & 1, bb = bk >> 1;
            const bf16_t* vsrc = Y + (size_t)(bb * RPB + T * 64) * NPAD + C_AV + kvh * 128 + d;
            float f[8];
#pragma unroll
            for (int e = 0; e < 8; ++e) { const int pos = 8 * g + e, hi_ = pos >> 5, bq = pos & 31, half = bq >> 4, r = bq & 15, key = 32 * half + (r & 3) + 8 * (r >> 2) + 4 * hi_;
                f[e] = bf2f(vsrc[(size_t)key * NPAD]); }
            int w0 = __builtin_amdgcn_cvt_pk_fp8_f32(f[0], f[1], 0, false); w0 = __builtin_amdgcn_cvt_pk_fp8_f32(f[2], f[3], w0, true);
            int w1 = __builtin_amdgcn_cvt_pk_fp8_f32(f[4], f[5], 0, false); w1 = __builtin_amdgcn_cvt_pk_fp8_f32(f[6], f[7], w1, true);
            *(u32x2*)(p.ws + WS_V8 + ((size_t)bk * NCHUNK + T) * 8192 + d * 64 + 8 * g) = (u32x2){(unsigned)w0, (unsigned)w1};
        }
    }
    {
        bf16_t* DMB = (bf16_t*)(p.ws + WS_H);
        const float* cw = p.conv_w + (size_t)l * 3 * BRW;
        const int nth = nw2 * 64, th = wv * 64 + lane;
        for (int task = th; task < MROWS * 128; task += nth) {
            const int row = task >> 7, c8 = (task & 127) * 8;
            const int tt = row % RPB; const bool lat = tt < TL; const int t = lat ? tt : tt - TL, T = lat ? TL : LC;
            const bf16_t* yr = Y + (size_t)row * NPAD;
            u32x4 convw;
            {
                float a0[8], a1[8], a2[8], u[8], g[8];
                unpack8(*(const u32x4*)(yr + C_CU + c8), u); unpack8(*(const u32x4*)(yr + C_CC + c8), g);
#pragma unroll
                for (int i = 0; i < 8; ++i) a1[i] = u[i] * g[i];
                if (t > 0) { unpack8(*(const u32x4*)(yr - NPAD + C_CU + c8), u); unpack8(*(const u32x4*)(yr - NPAD + C_CC + c8), g);
#pragma unroll
                    for (int i = 0; i < 8; ++i) a0[i] = u[i] * g[i]; }
                else {
#pragma unroll
                    for (int i = 0; i < 8; ++i) a0[i] = 0.f; }
                if (t < T - 1) { unpack8(*(const u32x4*)(yr + NPAD + C_CU + c8), u); unpack8(*(const u32x4*)(yr + NPAD + C_CC + c8), g);
#pragma unroll
                    for (int i = 0; i < 8; ++i) a2[i] = u[i] * g[i]; }
                else {
#pragma unroll
                    for (int i = 0; i < 8; ++i) a2[i] = 0.f; }
                float bg[8], z[8], o[8];
                unpack8(*(const u32x4*)(yr + C_CB + c8), bg); unpack8(*(const u32x4*)(yr + C_CZ + c8), z);
#pragma unroll
                for (int i = 0; i < 8; ++i) o[i] = bg[i] * (cw[c8 + i] * a0[i] + cw[BRW + c8 + i] * a1[i] + cw[2 * BRW + c8 + i] * a2[i]) * z[i];
                convw = pack8(o);
            }
            {
                const int g = c8 >> 8, w = 2 << g;
                int lo = t - (w >> 1); if (lo < 0) lo = 0; int hi = t + w - (w >> 1); if (hi > T) hi = T;
                float s[8], u0[8];
#pragma unroll
                for (int i = 0; i < 8; ++i) s[i] = 0.f;
                u32x4 tap[16];
#pragma unroll
                for (int k = 0; k < 16; ++k) { const int q = t - (w >> 1) + k; const bool ok = (k < w) && (q >= 0) && (q < T);
                    tap[k] = ok ? *(const u32x4*)(yr + (long)(q - t) * NPAD + C_PU + c8) : (u32x4){0u, 0u, 0u, 0u}; }
#pragma unroll
                for (int k = 0; k < 16; ++k) { float u[8]; unpack8(tap[k], u);
#pragma unroll
                    for (int i = 0; i < 8; ++i) s[i] += u[i]; }
                unpack8(*(const u32x4*)(yr + C_PU + c8), u0);
                const float inv = 1.0f / (float)(hi - lo);
                float o[8];
#pragma unroll
                for (int i = 0; i < 8; ++i) o[i] = s[i] * inv - u0[i];
                *(u32x4*)(DMB + (size_t)row * BRW + c8) = pack8(o);
                *(u32x4*)(Y + (size_t)row * NPAD + C_CZ + c8) = convw;
            }
        }
    }
}

__device__ __forceinline__ f32x4 mfma16(bf16x8 a, bf16x8 b, f32x4 c) { return __builtin_amdgcn_mfma_f32_16x16x32_bf16(a, b, c, 0, 0, 0); }
__device__ void mlstm_item(const Params& p, int item, unsigned char* smem) {
    const int tid = otid(), wid = tid >> 6, lane = tid & 63, fr = lane & 15, kq = lane >> 4;
    const int ep = item & 3, dir = (item >> 2) & 1, hd = (item >> 3) & 3, b = item >> 5;
    const int sq = (b * 4 + hd) * 2 + dir;
    const bf16_t* Y = (const bf16_t*)(p.ws + WS_Y);
    bf16_t* HM = (bf16_t*)(p.ws + WS_HM) + (size_t)dir * MROWS * BRW;
    const f32x4* GT4 = (const f32x4*)(p.ws + WS_GT4) + (size_t)sq * RPB; const float* GW = (const float*)(p.ws + WS_GW) + (size_t)sq * RPB; const float* GD = (const float*)(p.ws + WS_GD) + sq * 128;
    bf16_t* Ks = (bf16_t*)(smem); bf16_t* KTs = (bf16_t*)(smem + 33792);
    bf16_t* VTs = (bf16_t*)(smem + 70656); bf16_t* VWTs = (bf16_t*)(smem + 82176); bf16_t* CTs = (bf16_t*)(smem + 93696); bf16_t* Ss = (bf16_t*)(smem + 135936);
    float* sA = (float*)(smem + 145152); float* sM = sA + 64; float* sI = sA + 128; float* sE = sA + 192;
    for (int i = tid; i < 80 * 72; i += 512) { VTs[i] = 0; VWTs[i] = 0; }
    for (int i = tid; i < 80 * 264; i += 512) CTs[i] = 0;
    __syncthreads();
    if (tid < 64) VTs[64 * 72 + tid] = 0x3F80;
    f32x4 Cacc[2][5];
#pragma unroll
    for (int a = 0; a < 2; ++a)
#pragma unroll
        for (int c = 0; c < 5; ++c) Cacc[a][c] = (f32x4){0.f, 0.f, 0.f, 0.f};
    const int rg = wid >> 1, ch = wid & 1;
    u32x4 kreg[4], vreg; f32x4 g4; float wv_ = 0.f, wtok = 0.f, decay = 0.f;
    bf16x8 qf[8];
    const int dkp = tid & 127, sg = tid >> 7;
    const int vs = tid & 63, ve8 = (tid >> 6) * 8;
#define ML_LOAD(ci) do { \
        _Pragma("unroll") for (int j = 0; j < 4; ++j) { const int idx = tid + 512 * j, rr = idx >> 5, c8 = (idx & 31) * 8; \
            kreg[j] = *(const u32x4*)(Y + (size_t)seq_row(b, dir, (ci) * 64 + rr) * NPAD + C_MK + hd * 256 + c8); } \
        vreg = *(const u32x4*)(Y + (size_t)seq_row(b, dir, (ci) * 64 + vs) * NPAD + C_MV + hd * 256 + ep * 64 + ve8); wv_ = GW[(ci) * 64 + vs]; \
        g4 = GT4[(ci) * 64 + (tid & 63)]; wtok = GW[(ci) * 64 + (tid & 63)]; \
        decay = GD[(ci)]; } while (0)
#define ML_QLOAD(ci) do { const bf16_t* qrow = Y + (size_t)seq_row(b, dir, (ci) * 64 + 16 * rg + fr) * NPAD + C_MQ + hd * 256 + 8 * kq; \
        _Pragma("unroll") for (int ks = 0; ks < 8; ++ks) qf[ks] = *(const bf16x8*)(qrow + 32 * ks); } while (0)
    ML_LOAD(0); ML_QLOAD(0);
    for (int ci = 0; ci < NCHUNK; ++ci) {
#pragma unroll
        for (int j = 0; j < 4; ++j) { const int idx = tid + 512 * j, rr = idx >> 5, c8 = (idx & 31) * 8; *(u32x4*)(Ks + rr * 264 + c8) = kreg[j]; }
        { float vf[8]; unpack8(vreg, vf); const float ws_ = wv_ * 0.0625f;
#pragma unroll
            for (int i = 0; i < 8; ++i) { VTs[(ve8 + i) * 72 + vs] = f2bf(vf[i]); VWTs[(ve8 + i) * 72 + vs] = f2bf(vf[i] * ws_); } }
        if (tid < 64) { sA[tid] = g4[0]; sM[tid] = g4[1]; sI[tid] = g4[2]; sE[tid] = g4[3]; VWTs[64 * 72 + tid] = f2bf(wtok * 0.0625f); }
        const float dec = decay;
        __syncthreads();
        const int cn = ci + 1 < NCHUNK ? ci + 1 : NCHUNK - 1;
        ML_LOAD(cn);
        {
            const int t = 16 * rg + fr; const float Mt = sM[t];
#pragma unroll
            for (int s2 = 0; s2 < 2; ++s2) { const int st = 2 * ch + s2; f32x4 acc = {0.f, 0.f, 0.f, 0.f};
#pragma unroll
                for (int ks = 0; ks < 8; ++ks) { const bf16x8 kf = *(const bf16x8*)(Ks + (16 * st + fr) * 264 + 32 * ks + 8 * kq); acc = mfma16(kf, qf[ks], acc); }
                float o[4];
#pragma unroll
                for (int i = 0; i < 4; ++i) { const int s = 16 * st + 4 * kq + i; o[i] = (s <= t) ? acc[i] * fexp(sA[s] - Mt) * 0.0625f : 0.f; }
                u32x2 w; w.x = cvt_pk_bf16(o[0], o[1]); w.y = cvt_pk_bf16(o[2], o[3]);
                *(u32x2*)(Ss + t * 72 + 16 * st + 4 * kq) = w; }
        }
#pragma unroll
        for (int j = 0; j < 2; ++j) { const int s0 = 8 * (sg + 4 * j); unsigned kt[8]; u32x4 lo, hi;
#pragma unroll
            for (int jj = 0; jj < 8; ++jj) kt[jj] = *(const unsigned*)(Ks + (s0 + jj) * 264 + 2 * dkp);
            lo.x = (kt[0] & 0xffffu) | (kt[1] << 16); lo.y = (kt[2] & 0xffffu) | (kt[3] << 16); lo.z = (kt[4] & 0xffffu) | (kt[5] << 16); lo.w = (kt[6] & 0xffffu) | (kt[7] << 16);
            hi.x = (kt[0] >> 16) | (kt[1] & 0xffff0000u); hi.y = (kt[2] >> 16) | (kt[3] & 0xffff0000u); hi.z = (kt[4] >> 16) | (kt[5] & 0xffff0000u); hi.w = (kt[6] >> 16) | (kt[7] & 0xffff0000u);
            *(u32x4*)(KTs + (2 * dkp) * 72 + s0) = lo; *(u32x4*)(KTs + (2 * dkp + 1) * 72 + s0) = hi; }
        __syncthreads();
        {
            f32x4 aN0 = {0.f, 0.f, 0.f, 0.f}, aN1 = aN0, aD = aN0;
#pragma unroll
            for (int ks = 0; ks < 8; ++ks) { const bf16x8 c0 = *(const bf16x8*)(CTs + (32 * ch + fr) * 264 + 32 * ks + 8 * kq), c1 = *(const bf16x8*)(CTs + (32 * ch + 16 + fr) * 264 + 32 * ks + 8 * kq),
                                                     c2 = *(const bf16x8*)(CTs + (64 + fr) * 264 + 32 * ks + 8 * kq);
                aN0 = mfma16(qf[ks], c0, aN0); aN1 = mfma16(qf[ks], c1, aN1); aD = mfma16(qf[ks], c2, aD); }
            ML_QLOAD(cn);
            float it4[4], en4[4];
#pragma unroll
            for (int i = 0; i < 4; ++i) { it4[i] = sI[16 * rg + 4 * kq + i]; en4[i] = sE[16 * rg + 4 * kq + i]; aN0[i] *= it4[i]; aN1[i] *= it4[i]; aD[i] *= it4[i]; }
#pragma unroll
            for (int ks = 0; ks < 2; ++ks) { const bf16x8 sf = *(const bf16x8*)(Ss + (16 * rg + fr) * 72 + 32 * ks + 8 * kq);
                const bf16x8 v0 = *(const bf16x8*)(VTs + (32 * ch + fr) * 72 + 32 * ks + 8 * kq), v1 = *(const bf16x8*)(VTs + (32 * ch + 16 + fr) * 72 + 32 * ks + 8 * kq), v2 = *(const bf16x8*)(VTs + (64 + fr) * 72 + 32 * ks + 8 * kq);
                aN0 = mfma16(sf, v0, aN0); aN1 = mfma16(sf, v1, aN1); aD = mfma16(sf, v2, aD); }
#pragma unroll
            for (int i = 0; i < 4; ++i) { const float den = __shfl(aD[i], lane & 48); const float rd = 1.0f / fmaxf(fabsf(den), en4[i]);
                const int row = seq_row(b, dir, ci * 64 + 16 * rg + 4 * kq + i);
                bf16_t* hp = HM + (size_t)row * BRW + hd * 256 + ep * 64 + 32 * ch + fr;
                hp[0] = f2bf(aN0[i] * rd); hp[16] = f2bf(aN1[i] * rd); }
        }
#pragma unroll
        for (int rt = 0; rt < 2; ++rt)
#pragma unroll
            for (int ct = 0; ct < 5; ++ct) { f32x4 cacc = Cacc[rt][ct] * dec;
#pragma unroll
                for (int ks = 0; ks < 2; ++ks) { const bf16x8 af = *(const bf16x8*)(KTs + (32 * wid + 16 * rt + fr) * 72 + 32 * ks + 8 * kq), bv = *(const bf16x8*)(VWTs + (16 * ct + fr) * 72 + 32 * ks + 8 * kq);
                    cacc = mfma16(af, bv, cacc); }
                Cacc[rt][ct] = cacc; }
        __syncthreads();
#pragma unroll
        for (int rt = 0; rt < 2; ++rt)
#pragma unroll
            for (int ct = 0; ct < 5; ++ct) { u32x2 w; w.x = cvt_pk_bf16(Cacc[rt][ct][0], Cacc[rt][ct][1]); w.y = cvt_pk_bf16(Cacc[rt][ct][2], Cacc[rt][ct][3]);
                *(u32x2*)(CTs + (16 * ct + fr) * 264 + 32 * wid + 16 * rt + 4 * kq) = w; }
    }
#undef ML_LOAD
#undef ML_QLOAD
    __syncthreads();
}

__device__ void phase_mix2(const Params& p, int l, unsigned char* smem) {
    bf16_t* Y = (bf16_t*)(p.ws + WS_Y);
#ifndef NO_MLSTM
    if ((int)blockIdx.x < 128) { const int x = blockIdx.x & 7, k = blockIdx.x >> 3; mlstm_item(p, ((x * 2 + (k >> 3)) << 3) | (k & 7), smem); }
#endif
#ifndef NO_ATT
    const int natt = 512 + (l == 0 ? 32 : 0);
    unsigned* ctr = (unsigned*)(p.ws + WS_BAR + 14336) + l * 64;
    volatile unsigned* sidx = (volatile unsigned*)(smem + LDS_BYTES - 32);
    for (;;) {
        __syncthreads();
        if (threadIdx.x == 0) *sidx = atomicAdd(ctr, 1u);
        __syncthreads();
        const int it = __builtin_amdgcn_readfirstlane((int)*sidx);
        if (it >= natt + (MROWS / 256) * 4) break;
        if (it >= natt) {
            SchedPool S; S.A = (const char*)(p.ws + WS_H); S.Bt = (const char*)(p.ws + WS_POOLW) + (size_t)l * 4 * 256 * 256 * 2; S.G = 1 << 20; S.c = it - natt; S.i0 = 0;
            EpiPool E; E.Y = Y;
            pg8::Gemm g; g.lda = BRW; g.ldb = 256; { int kk = 256; asm volatile("" : "+s"(kk)); g.K = kk; }
            pg8::gemm_phase(( LAS unsigned char*)smem, g, S, E);
            continue; }
        int b, head, qrow, krow, seq;
        if (it < 512) { const int qb = it & 15; head = (it >> 4) & 7; b = it >> 7; qrow = b * RPB + qb * 256; krow = b * RPB; seq = RPB; }
        else { const int i2 = it - 512; head = i2 & 7; b = i2 >> 3; qrow = b * RPB + TL; krow = qrow; seq = LC; }
        const int kvh = head >> 2;
        bf16_t* rowq = Y + (size_t)qrow * NPAD; const bf16_t* rowk = Y + (size_t)krow * NPAD;
        att::attn_dense_body(rowq + C_AQ + head * 128, p.ws + WS_K8 + (size_t)krow * 256 + kvh * 128, p.ws + WS_V8 + ((size_t)(b * 2 + kvh) * NCHUNK + (krow - b * RPB) / 64) * 8192, rowq + C_AZ + head * 128, seq, (char*)smem);
    }
#endif
    __syncthreads();
    __syncthreads();
}

__device__ void phase_mix3(const Params& p, int l) {
    const int tid = otid(), lane = tid & 63, wv = obid() * 8 + (tid >> 6), nwv = gridDim.x * 8;
    bf16_t* Y = (bf16_t*)(p.ws + WS_Y);
    const bf16_t* HM0 = (const bf16_t*)(p.ws + WS_HM); const bf16_t* HM1 = HM0 + (size_t)MROWS * BRW;
    const float* gain = p.m_gain + l * BRW;
    for (int row = wv; row < MROWS; row += nwv) {
        f32x4 v[4]; u32x2 ow[4], zw[4];
#pragma unroll
        for (int hd = 0; hd < 4; ++hd) { const size_t off = (size_t)row * BRW + hd * 256 + 4 * lane;
            { const u32x2 h0 = *(const u32x2*)(HM0 + off), h1 = *(const u32x2*)(HM1 + off);
              v[hd] = (f32x4){bflo(h0.x) + bflo(h1.x), bfhi(h0.x) + bfhi(h1.x), bflo(h0.y) + bflo(h1.y), bfhi(h0.y) + bfhi(h1.y)}; }
            ow[hd] = *(const u32x2*)(Y + (size_t)row * NPAD + C_MO + hd * 256 + 4 * lane); zw[hd] = *(const u32x2*)(Y + (size_t)row * NPAD + C_MZ + hd * 256 + 4 * lane); }
#pragma unroll
        for (int hd = 0; hd < 4; ++hd) {
            float ss = v[hd][0] * v[hd][0] + v[hd][1] * v[hd][1] + v[hd][2] * v[hd][2] + v[hd][3] * v[hd][3];
#pragma unroll
            for (int o = 32; o >= 1; o >>= 1) ss += __shfl_xor(ss, o);
            const float rstd = rsqrtf(ss * (1.0f / 256.0f) + EPS);
            const f32x4 g = *(const f32x4*)(gain + hd * 256 + 4 * lane);
            const float o0 = bflo(ow[hd].x), o1 = bfhi(ow[hd].x), o2 = bflo(ow[hd].y), o3 = bfhi(ow[hd].y), z0 = bflo(zw[hd].x), z1 = bfhi(zw[hd].x), z2 = bflo(zw[hd].y), z3 = bfhi(zw[hd].y);
            u32x2 w; w.x = cvt_pk_bf16(v[hd][0] * rstd * g[0] * o0 * z0, v[hd][1] * rstd * g[1] * o1 * z1); w.y = cvt_pk_bf16(v[hd][2] * rstd * g[2] * o2 * z2, v[hd][3] * rstd * g[3] * o3 * z3);
            *(u32x2*)(Y + (size_t)row * NPAD + C_MO + hd * 256 + 4 * lane) = w;
        }
    }
}

#define XB_TMO      128
#define XB_XCNT(j)  (256  + 64 * (j))
#define XB_XSUB(j)  (1280 + 64 * (j))
#define XB_XGEN(j)  (2304 + 64 * (j))
#define XB_TOP      3328
#define XB_TOPGEN   3392
#define XCD_BAR_WORDS 3456
#define XB_SPIN_CAP (1u << 18)
__device__ __forceinline__ unsigned xb_ld(unsigned* p)              { return __hip_atomic_load(p, __ATOMIC_RELAXED, __HIP_MEMORY_SCOPE_AGENT); }
__device__ __forceinline__ unsigned xb_add(unsigned* p, unsigned v) { return __hip_atomic_fetch_add(p, v, __ATOMIC_RELAXED, __HIP_MEMORY_SCOPE_AGENT); }
__device__ __forceinline__ unsigned xb_xcc_id() { return (unsigned)__builtin_amdgcn_s_getreg((3 << 11) | 20) & 0xFu; }
#define XB_SPIN(cond, bar) do { unsigned _sp = 0; while (cond) { __builtin_amdgcn_s_sleep(1); \
    if ((++_sp & 255u) == 0u) { if (xb_ld(&(bar)[XB_TMO])) break; if (_sp > XB_SPIN_CAP) { atomicAdd(&(bar)[XB_TMO], 1u); break; } } } } while (0)
struct XcdBarrier { unsigned* bar; unsigned x; volatile LAS unsigned* st; };
__device__ __forceinline__ XcdBarrier xcd_barrier_post(unsigned* bar, volatile LAS unsigned* st) {
    XcdBarrier b; b.bar = bar; b.x = xb_xcc_id(); b.st = st;
    if (threadIdx.x == 0) (void)xb_add(&bar[XB_XCNT(b.x)], 1u);
    return b;
}
__device__ __forceinline__ void xcd_barrier_complete(unsigned* bar, unsigned x, unsigned& nloc, unsigned& nx) {
    const unsigned G = gridDim.x * gridDim.y * gridDim.z;
    unsigned sum, cnt, mine, sp = 0u;
    for (;;) {
        sum = 0u; cnt = 0u; mine = 0u;
#pragma unroll
        for (unsigned j = 0; j < 16; ++j) { const unsigned c = xb_ld(&bar[XB_XCNT(j)]); sum += c; cnt += (c > 0u) ? 1u : 0u; mine = (j == x) ? c : mine; }
        if (sum == G) break;
        __builtin_amdgcn_s_sleep(1);
        if ((++sp & 255u) == 0u) { if (xb_ld(&bar[XB_TMO])) break; if (sp > XB_SPIN_CAP) { atomicAdd(&bar[XB_TMO], 1u); break; } }
    }
    nloc = mine > 0u ? mine : 1u; nx = cnt > 0u ? cnt : 1u;
}
__device__ __forceinline__ void xcd_barrier(const XcdBarrier& b) {
    asm volatile("s_waitcnt vmcnt(0)" ::: "memory");
    __syncthreads();
    if (threadIdx.x == 0) {
        unsigned* bar = b.bar;
        __builtin_amdgcn_s_waitcnt(0);
        unsigned nloc = b.st[0], nx = b.st[1];
        if (nloc == 0u) { xcd_barrier_complete(bar, b.x, nloc, nx); b.st[0] = nloc; b.st[1] = nx; }
        const unsigned old = xb_add(&bar[XB_XSUB(b.x)], 1u);
        const unsigned gen = old / nloc;
        if (old + 1u == (gen + 1u) * nloc) {
            __builtin_amdgcn_fence(__ATOMIC_RELEASE, "agent");
            asm volatile("s_waitcnt vmcnt(0)" ::: "memory");
            const unsigned og = xb_add(&bar[XB_TOP], 1u);
            const unsigned tg = og / nx;
            if (og + 1u == (tg + 1u) * nx) xb_add(&bar[XB_TOPGEN], 1u);
            else XB_SPIN(xb_ld(&bar[XB_TOPGEN]) == tg, bar);
            __builtin_amdgcn_fence(__ATOMIC_ACQUIRE, "agent");
            xb_add(&bar[XB_XGEN(b.x)], 1u);
            asm volatile("s_waitcnt vmcnt(0)" ::: "memory");
        } else {
            XB_SPIN(xb_ld(&bar[XB_XGEN(b.x)]) == gen, bar);
            __builtin_amdgcn_fence(__ATOMIC_ACQUIRE, "agent");
            asm volatile("s_waitcnt vmcnt(0)" ::: "memory");
        }
    }
    __syncthreads();
}

constexpr int NPHASE = 16;
__device__ void run_phase(const Params& p, int ph, unsigned char* smem, bool dost = true) {
#ifndef NO_PREP
    if (ph == 0) { phase_prep(p, smem); return; }
#endif
#ifndef NO_FINAL
    if (ph == NPHASE - 1) { phase_final(p); return; }
#endif
    const int l = (ph - 1) / 7, s = (ph - 1) % 7;
    bf16_t* Y = (bf16_t*)(p.ws + WS_Y);
    switch (s) {
#ifndef NO_NORM
    case 0: phase_norm(p, l); break;
#endif
#ifndef NO_GIN
    case 1: { EpiIn E; E.Y = Y; E.G32 = (float*)(p.ws + WS_G32); E.dost = dost;
              { SchedIn S; S.A = (const char*)(p.ws + WS_H); S.Bt = (const char*)(p.ws + WS_WIN) + (size_t)l * NPAD * DM * 2; S.G = gridDim.x; S.c = blockIdx.x; S.trim = (l == 1); S.part = 0;
                E.ps = 1.0f; pg8::Gemm g; g.lda = DM; g.ldb = DM; g.K = DM;
#ifndef T_NO_P0
                pg8::gemm_phase<EpiIn, SchedIn, false>((LAS unsigned char*)smem, g, S, E);
#endif
              }
              __syncthreads();
              { SchedIn S; S.A = (const char*)(p.ws + WS_H8); S.Bt = (const char*)(p.ws + WS_W8) + (size_t)l * NT8 * 256 * DM; S.G = gridDim.x; S.c = gridDim.x - 1 - blockIdx.x;     S.trim = (l == 1); S.part = 1;
                EpiGate8 E8; E8.Y = Y; pg8::Gemm g; g.lda = DM / 2; g.ldb = DM / 2; g.K = DM / 2;
#ifndef T_NO_P1
                pg8::gemm_phase<EpiGate8, SchedIn, true>((LAS unsigned char*)smem, g, S, E8);
#endif
              } } break;
#endif
#ifndef NO_MIX1
    case 2: phase_mix1(p, l, smem); break;
#endif
#ifndef NO_MIX2
    case 3: phase_mix2(p, l, smem); break;
#endif
#ifndef NO_MIX3
    case 4: phase_mix3(p, l); break;
#endif
#ifndef NO_MERGE
    case 5: { SchedMerge S; S.Y = (const char*)Y; S.Wbr = (const char*)(p.ws + WS_WBR) + (size_t)l * 4 * DM * BRW * 2; S.G = gridDim.x; S.c = blockIdx.x; S.nM = l == 0 ? 68 : 64;
              EpiMerge E; E.Y = Y; E.accb = (bf16_t*)(p.ws + WS_H);
              pg8::Gemm g; g.lda = NPAD; g.ldb = BRW; g.K = BRW;
              pg8::gemm_phase((LAS unsigned char*)smem, g, S, E);
              if (l == 0 && (int)blockIdx.x >= 32) { __syncthreads(); for (int u = blockIdx.x - 32; u < U_CONV1; u += gridDim.x - 32) conv_unit(p, 1, u, smem); } } break;
#endif
#ifndef NO_OUT
    case 6: { SchedOut S; S.A = (const char*)(p.ws + WS_H); S.Bt = (const char*)(p.ws + WS_WOUT) + (size_t)l * DM * DM * 2; S.G = gridDim.x; S.c = blockIdx.x; S.nM = l == 0 ? 68 : 64;
              EpiOut E; E.xin = p.x; E.ctxin = p.ctx; E.mod = (const float*)(p.ws + WS_MOD) + (size_t)l * 5 * 6144; E.X1 = (bf16_t*)(p.ws + WS_X1); E.first = (l == 0);
              pg8::Gemm g; g.lda = DM; g.ldb = DM; g.K = DM;
              pg8::gemm_phase((LAS unsigned char*)smem, g, S, E); } break;
#endif
    }
}

__global__ void __launch_bounds__(512, 2) hybrid_fwd(Params p) {
    extern __shared__ __attribute__((aligned(16))) unsigned char smem[];
    volatile LAS unsigned* st = (volatile LAS unsigned*)((LAS unsigned char*)smem + (LDS_BYTES - 16));
    if (threadIdx.x == 0) { st[0] = 0u; st[1] = 0u; }
    __syncthreads();
    const XcdBarrier xbar = xcd_barrier_post((unsigned*)(p.ws + WS_BAR), st);
    for (int ph = p.ph_lo; ph < p.ph_hi; ++ph) {
        int reps = 1;
#ifdef PROBE_REP_MASK
        if (ph > 0 && ph < NPHASE - 1 && ((PROBE_REP_MASK >> ((ph - 1) % 7)) & 1)) reps = 2;
        if (ph == 0 && (PROBE_REP_MASK & 128)) reps = 2;
#endif
        for (int r = 0; r < reps; ++r) { run_phase(p, ph, smem, r + 1 == reps || p.ph_hi > 1000); if (r + 1 < reps) xcd_barrier(xbar); }
        if (ph + 1 < p.ph_hi) { if (p.ph_hi > NPHASE) cg::this_grid().sync(); else xcd_barrier(xbar); }
#ifdef PROBE_EXTRA_SYNC
        if (ph + 1 < p.ph_hi) { for (int q = 0; q < PROBE_EXTRA_SYNC; ++q) cg::this_grid().sync(); }
#endif
    }
}


#ifdef DBG_STOP
__global__ void dbg_dump(Params p) {
    const bf16_t* Y = (const bf16_t*)(p.ws + WS_Y); const float* HM = (const float*)(p.ws + WS_HM); const bf16_t* H = (const bf16_t*)(p.ws + WS_H);
    for (size_t i = (size_t)blockIdx.x * blockDim.x + threadIdx.x; i < (size_t)NB * TL * DM; i += (size_t)gridDim.x * blockDim.x) {
        const size_t row = i / DM; const int c = (int)(i % DM);
        float s = 0.f;
#if DBG_WHAT & 1
        for (int j = 0; j < 11; ++j) { const int col = c + 2048 * j; if (col < 22016) s += bf2f(Y[row * NPAD + col]); }
#endif
#if DBG_WHAT & 2
        { const size_t k = i % ((size_t)MROWS * BRW); s += HM[k] + HM[k + (size_t)MROWS * BRW]; }
#endif
#if DBG_WHAT & 4
        s += bf2f(H[i]);
#endif
        p.out[i] = s;
    }
}
#endif
extern "C" void kernel_launch(void* const* d_in, const int* in_sizes, int n_in, void* d_out, int out_size, void* d_ws, size_t ws_size, hipStream_t stream) {
    static int grid = 0;
    if (grid == 0) {
        if (n_in != 18 || ws_size < WS_END) { fprintf(stderr, "kernel_launch: n_in %d ws %zu (need %zu)\n", n_in, ws_size, (size_t)WS_END); grid = -1; return; }
        if (hipFuncSetAttribute((const void*)hybrid_fwd, hipFuncAttributeMaxDynamicSharedMemorySize, LDS_BYTES) != hipSuccess) { fprintf(stderr, "kernel_launch: hipFuncSetAttribute failed\n"); grid = -1; return; }
        int dev = 0, cus = 0, per_cu = 0;
        hipGetDevice(&dev); hipDeviceGetAttribute(&cus, hipDeviceAttributeMultiprocessorCount, dev);
        hipOccupancyMaxActiveBlocksPerMultiprocessor(&per_cu, (const void*)hybrid_fwd, 512, LDS_BYTES);
        if (per_cu < 1) { fprintf(stderr, "kernel_launch: occupancy query says %d blocks per CU\n", per_cu); per_cu = 1; }
        (void)hipGetLastError();
        grid = cus;
    }
    if (grid < 0) return;
    Params p{};
    p.x = (const float*)d_in[0]; p.c = (const float*)d_in[1]; p.ctx = (const float*)d_in[2]; p.c_ctx = (const float*)d_in[3]; p.norm_gain = (const float*)d_in[4];
    p.w_mod = (const float*)d_in[5]; p.b_mod = (const float*)d_in[6]; p.w_in = (const float*)d_in[7]; p.q_gain = (const float*)d_in[8]; p.k_gain = (const float*)d_in[9];
    p.gate_bias = (const float*)d_in[10]; p.m_gain = (const float*)d_in[11]; p.conv_w = (const float*)d_in[12]; p.pool_w = (const float*)d_in[13]; p.pool_scale = (const float*)d_in[14];
    p.w_branch = (const float*)d_in[15]; p.w_out = (const float*)d_in[16]; p.final_gain = (const float*)d_in[17];
    p.out = (float*)d_out; p.ws = (unsigned char*)d_ws;
#ifdef DBG_STOP
    for (int ph = 0; ph < DBG_STOP; ++ph) { p.ph_lo = ph; p.ph_hi = ph + 1; hipLaunchKernelGGL(hybrid_fwd, dim3(grid), dim3(512), LDS_BYTES, stream, p); }
    hipLaunchKernelGGL(dbg_dump, dim3(2048), dim3(256), 0, stream, p);
#elif MK_PER_PHASE
    for (int ph = 0; ph < NPHASE; ++ph) {
        p.ph_lo = ph; p.ph_hi = ph + 1;
        hipLaunchKernelGGL(hybrid_fwd, dim3(grid), dim3(512), LDS_BYTES, stream, p);
    }
#else
    p.ph_lo = 0; p.ph_hi = NPHASE;
    if (hipMemsetAsync((char*)d_ws + WS_BAR, 0, 16384, stream) != hipSuccess) { fprintf(stderr, "kernel_launch: memset of barrier words failed\n"); return; }
    void* args[] = {&p};
    hipError_t e = hipLaunchCooperativeKernel((const void*)hybrid_fwd, dim3(grid), dim3(512), args, LDS_BYTES, stream);
    if (e != hipSuccess) fprintf(stderr, "cooperative launch failed: %s (grid %d)\n", hipGetErrorString(e), grid);
#endif
}
```

```cpp
#include <hip/hip_runtime.h>
#include <hip/hip_cooperative_groups.h>
#include <cstdio>
#include <cstdint>
namespace cg = cooperative_groups;

#ifndef MK_PER_PHASE
#define MK_PER_PHASE 0
#endif

#define LAS __attribute__((address_space(3)))
typedef unsigned short bf16_t;
typedef short bf16x8 __attribute__((ext_vector_type(8)));
typedef short s16x4 __attribute__((ext_vector_type(4)));
typedef float f32x4 __attribute__((ext_vector_type(4)));
typedef float f32x8 __attribute__((ext_vector_type(8)));
typedef float f32x16 __attribute__((ext_vector_type(16)));
typedef unsigned u32x4 __attribute__((ext_vector_type(4)));
typedef unsigned u32x2 __attribute__((ext_vector_type(2)));

constexpr int DM = 2048, NB = 4, TL = 4096, LC = 256, RPB = TL + LC  , MROWS = NB * RPB  ;
constexpr int NIN = 22032, NPAD = 22272, BRW = 1024;
constexpr int C_AQ = 0, C_AK = 1024, C_AV = 1280, C_AZ = 1536, C_MQ = 2560, C_MK = 3584, C_MV = 4608, C_MO = 5632, C_MZ = 6656,
              C_CU = 7680, C_CB = 8704, C_CC = 9728, C_CZ = 10752, C_PU = 11776, C_PZ = 12800, C_GM = 13824, C_MG = 22016;
constexpr int NCHUNK = RPB / 64;
constexpr float EPS = 1e-6f;

constexpr size_t WS_WIN = 0;
constexpr size_t WS_WBR = WS_WIN + (size_t)2 * NPAD * DM * 2;
constexpr size_t WS_WOUT = WS_WBR + (size_t)2 * 4 * DM * BRW * 2;
constexpr size_t WS_POOLW = WS_WOUT + (size_t)2 * DM * DM * 2;
constexpr size_t WS_MOD = WS_POOLW + (size_t)2 * 4 * 256 * 256 * 2;
constexpr size_t WS_H = WS_MOD + (size_t)2 * 5 * 6144 * 4;
constexpr size_t WS_Y = WS_H + (size_t)MROWS * DM * 2;
constexpr size_t WS_X1 = WS_Y + (size_t)MROWS * NPAD * 2;
constexpr size_t WS_H8 = WS_X1 + (size_t)MROWS * DM * 2;
constexpr size_t WS_HM = WS_X1 + (size_t)MROWS * DM * 4;
static_assert(WS_H8 + (size_t)MROWS * DM <= WS_HM, "the fp8 copy of h must fit in the free half of the X1 slot");
constexpr size_t WS_G32 = WS_HM + (size_t)2 * MROWS * BRW * 4;
constexpr size_t WS_GT4 = WS_G32 + (size_t)MROWS * 16 * 4;
constexpr size_t WS_GW = WS_GT4 + (size_t)32 * RPB * 16;
constexpr size_t WS_GD = WS_GW + (size_t)32 * RPB * 4;
constexpr size_t WS_BAR = WS_GD + (size_t)32 * 128 * 4;
constexpr int NT8 = 42;
constexpr size_t WS_W8 = WS_BAR + 16384;
constexpr size_t WS_K8 = WS_W8 + (size_t)2 * NT8 * 256 * DM;
constexpr size_t WS_V8 = WS_K8 + (size_t)MROWS * 256;
constexpr size_t WS_END = WS_V8 + (size_t)MROWS * 256;
__host__ __device__ __forceinline__ constexpr int pn_of_q8(int q) { return q < 6 ? q : (q < 10 ? 18 + (q - 6) : 54 + (q - 10)); }
__host__ __device__ __forceinline__ constexpr int pn_of_p16(int p) { return p < 12 ? 6 + p : (p < 44 ? 22 + (p - 12) : 86); }

constexpr int LDS_BYTES = 155648;

struct Params {
    const float* x; const float* c; const float* ctx; const float* c_ctx; const float* norm_gain; const float* w_mod; const float* b_mod; const float* w_in;
    const float* q_gain; const float* k_gain; const float* gate_bias; const float* m_gain; const float* conv_w; const float* pool_w; const float* pool_scale;
    const float* w_branch; const float* w_out; const float* final_gain;
    float* out; unsigned char* ws;
    int ph_lo, ph_hi;
};

__device__ __forceinline__ int otid() { int t = threadIdx.x; asm volatile("" : "+v"(t)); return t; }
__device__ __forceinline__ int obid() { int t = blockIdx.x; asm volatile("" : "+s"(t)); return t; }
typedef __bf16 bf16x2_t __attribute__((ext_vector_type(2)));
typedef float f32x2_t __attribute__((ext_vector_type(2)));
__device__ __forceinline__ unsigned cvt_pk_bf16(float lo, float hi) { f32x2_t v = {lo, hi}; bf16x2_t r = __builtin_convertvector(v, bf16x2_t); return *reinterpret_cast<unsigned*>(&r); }
__device__ __forceinline__ bf16_t f2bf(float f) { return (bf16_t)(cvt_pk_bf16(f, 0.f) & 0xffffu); }
__device__ __forceinline__ float bf2f(bf16_t b) { return __uint_as_float(((unsigned)b) << 16); }
__device__ __forceinline__ float bflo(unsigned w) { return __uint_as_float(w << 16); }
__device__ __forceinline__ float bfhi(unsigned w) { return __uint_as_float(w & 0xffff0000u); }
__device__ __forceinline__ float sigmoidf_(float x) { return __builtin_amdgcn_rcpf(1.0f + __builtin_amdgcn_exp2f(-1.4426950408889634f * x)); }
__device__ __forceinline__ float siluf_(float x) { return x * sigmoidf_(x); }
__device__ __forceinline__ float fexp(float x) { return __builtin_amdgcn_exp2f(1.4426950408889634f * x); }
__device__ __forceinline__ void unpack8(const u32x4 w, float (&f)[8]) { f[0] = bflo(w.x); f[1] = bfhi(w.x); f[2] = bflo(w.y); f[3] = bfhi(w.y); f[4] = bflo(w.z); f[5] = bfhi(w.z); f[6] = bflo(w.w); f[7] = bfhi(w.w); }
__device__ __forceinline__ u32x4 pack8(const float (&f)[8]) { u32x4 w; w.x = cvt_pk_bf16(f[0], f[1]); w.y = cvt_pk_bf16(f[2], f[3]); w.z = cvt_pk_bf16(f[4], f[5]); w.w = cvt_pk_bf16(f[6], f[7]); return w; }

namespace pg8 {
constexpr int BM = 256, BK = 64, HALF = 128, HTB = HALF * BK * 2, STAGE_BYTES = 8 * HTB, NXCD = 8, WGM = 8;
__host__ __device__ __forceinline__ int lds_byte(int r, int c) { const int st = (r >> 4) * 2 + (c >> 5), rr = r & 15, cc = c & 31, ob = rr * 64 + cc * 2; return st * 1024 + (ob ^ (((ob >> 9) & 1) << 5)); }
__host__ __device__ __forceinline__ void stage_rc(int b, int& R, int& C) { const int st = b / 1024, sb = b % 1024, swz = sb ^ (((sb >> 9) & 1) << 5); R = (st >> 1) * 16 + swz / 64; C = (st & 1) * 32 + (swz % 64) / 2; }
__host__ __device__ __forceinline__ int perm32(int rho) { const int n = rho >> 4, i = rho & 15; return 8 * (i >> 2) + 4 * n + (i & 3); }

struct Unit { const char* a; const char* b; int pm, pn, tag; };
struct Gemm { int lda, ldb, K; };

__device__ __forceinline__ bool static_tile(int nM, int nN, long L, int& pm, int& pn) {
    const int nwg = nM * nN; if (L >= nwg) return false;
    int wgid = (int)L; { const int q = nwg / NXCD, r = nwg % NXCD, xcd = wgid % NXCD, off = wgid / NXCD; wgid = (xcd < r ? xcd * (q + 1) : r * (q + 1) + (xcd - r) * q) + off; }
    const int nig = WGM * nN, gid = wgid / nig, fm = gid * WGM, gsz = (nM - fm) < WGM ? (nM - fm) : WGM;
    pm = fm + ((wgid % nig) % gsz); pn = (wgid % nig) / gsz; return true;
}

typedef int v4i_t __attribute__((ext_vector_type(4)));
typedef int v8i_t __attribute__((ext_vector_type(8)));
template <bool F8> struct Frag;
template <> struct Frag<false> { bf16x8 h[2]; __device__ __forceinline__ void set(int k, bf16x8 x) { h[k] = x; } };
template <> struct Frag<true>  { v8i_t v;     __device__ __forceinline__ void set(int k, bf16x8 x) { const v4i_t q = __builtin_bit_cast(v4i_t, x); if (k == 0) v.lo = q; else v.hi = q; } };
template <class Epi, class Sched, bool FP8 = false>
__device__ __forceinline__ void gemm_phase(LAS unsigned char* lds, const Gemm g, const Sched& S, const Epi& E) {
    const int tid = otid(), wid = __builtin_amdgcn_readfirstlane(tid >> 6), lane = tid & 63, wr = wid >> 2, wc = wid & 3, fr = lane & 15, fq = lane >> 4;
    const int K = g.K, nt = K / BK;
    unsigned voffA[2], voffB[2];
#pragma unroll
    for (int i = 0; i < 2; ++i) { int R, C; stage_rc(tid * 16 + i * 8192, R, C); const int Rb = Epi::PERM ? ((R & ~31) + perm32(R & 31)) : R;
        voffA[i] = (unsigned)(R * g.lda + C) * 2u; voffB[i] = (unsigned)(Rb * g.ldb + C) * 2u; }
    const size_t kstep = (size_t)(BK * 2);
    const size_t hstepA = (size_t)HALF * g.lda * 2, hstepB = (size_t)HALF * g.ldb * 2;
    const unsigned ldsw = (unsigned)wid * 1024u;
    const int aoff = lds_byte(wr * 64 + fr, fq * 8), boff = lds_byte(wc * 32 + fr, fq * 8);
#define PG8_SA(b, h) (((b) * 2 + (h)) * HTB)
#define PG8_SB(b, h) ((4 + (b) * 2 + (h)) * HTB)
#define PG8_STAGE(bufoff, gbase, voff) do { _Pragma("unroll") for (int _i = 0; _i < 2; ++_i) \
        __builtin_amdgcn_global_load_lds((const unsigned*)((const char*)(gbase) + (voff)[_i]), (LAS unsigned*)(lds + (bufoff) + ldsw + _i * 8192), 16, 0, 0); } while (0)
#define PG8_LDA(dst, b, h) do { _Pragma("unroll") for (int m = 0; m < 4; ++m) _Pragma("unroll") for (int k = 0; k < 2; ++k) dst[m].set(k, *(const LAS bf16x8*)(lds + PG8_SA(b, h) + aoff + m * 2048 + k * 1024)); } while (0)
#define PG8_LDB(dst, b, h) do { _Pragma("unroll") for (int n = 0; n < 2; ++n) _Pragma("unroll") for (int k = 0; k < 2; ++k) dst[n].set(k, *(const LAS bf16x8*)(lds + PG8_SB(b, h) + boff + n * 2048 + k * 1024)); } while (0)
#define PG8_MMA(ai, bj, At, Bt) do { __builtin_amdgcn_s_setprio(1); _Pragma("unroll") for (int m = 0; m < 4; ++m) _Pragma("unroll") for (int n = 0; n < 2; ++n) { \
        if constexpr (FP8)   \
            asm volatile("v_mfma_f32_16x16x128_f8f6f4 %0, %1, %2, %0" : "+v"(acc[ai][bj][m][n]) : "v"(Bt[n].v), "v"(At[m].v));   \
        else { _Pragma("unroll") for (int k = 0; k < 2; ++k) acc[ai][bj][m][n] = __builtin_amdgcn_mfma_f32_16x16x32_bf16(Bt[n].h[k], At[m].h[k], acc[ai][bj][m][n], 0, 0, 0); } } \
        __builtin_amdgcn_s_setprio(0); } while (0)
#define PG8_WAIT_V(n) asm volatile("s_waitcnt vmcnt(" #n ")" ::: "memory")
#define PG8_WAIT_L(n) asm volatile("s_waitcnt lgkmcnt(" #n ")" ::: "memory")
#define PG8_BAR __builtin_amdgcn_s_barrier()
#define PG8_SCHED __builtin_amdgcn_sched_barrier(0)
    Unit cur, nxt; int ui = 0;
    if (!S.next(0, cur)) return;
    f32x4 acc[2][2][4][2];
#pragma unroll
    for (int a = 0; a < 2; ++a)
#pragma unroll
        for (int b = 0; b < 2; ++b)
#pragma unroll
            for (int m = 0; m < 4; ++m)
#pragma unroll
                for (int n = 0; n < 2; ++n) acc[a][b][m][n] = (f32x4){0.f, 0.f, 0.f, 0.f};
    Frag<FP8> At[4], B0[2], B1[2];
    const char* cA = cur.a; const char* cB = cur.b;
    PG8_STAGE(PG8_SB(0, 0), cB, voffB); PG8_STAGE(PG8_SA(0, 0), cA, voffA); PG8_STAGE(PG8_SB(0, 1), cB + hstepB, voffB); PG8_STAGE(PG8_SA(0, 1), cA + hstepA, voffA);
    if (wr == 1) PG8_BAR;
    PG8_WAIT_V(4); PG8_BAR;
    PG8_STAGE(PG8_SB(1, 0), cB + kstep, voffB); PG8_STAGE(PG8_SA(1, 0), cA + kstep, voffA); PG8_STAGE(PG8_SB(1, 1), cB + hstepB + kstep, voffB);
    PG8_WAIT_V(6); PG8_BAR;
    for (;;) {
        const bool has_next = S.next(ui + 1, nxt);
        const char* nA = has_next ? nxt.a : cA; const char* nB = has_next ? nxt.b : cB;
        for (int t = 0; t < nt; t += 2) {
            const bool last = (t == nt - 2);
            const char* a1 = cA + (size_t)(t + 1) * kstep;
            const char* a2 = last ? nA : cA + (size_t)(t + 2) * kstep; const char* b2 = last ? nB : cB + (size_t)(t + 2) * kstep;
            const char* a3 = a2 + kstep; const char* b3 = b2 + kstep;
            PG8_LDB(B0, 0, 0); PG8_SCHED; PG8_LDA(At, 0, 0); PG8_STAGE(PG8_SA(1, 1), a1 + hstepA, voffA);
            PG8_WAIT_L(8); PG8_BAR; PG8_WAIT_L(0); PG8_MMA(0, 0, At, B0); PG8_BAR; PG8_SCHED;
            PG8_LDB(B1, 0, 1); PG8_STAGE(PG8_SB(0, 0), b2, voffB);
            PG8_BAR; PG8_WAIT_L(0); PG8_MMA(0, 1, At, B1); PG8_BAR;
            PG8_LDA(At, 0, 1); PG8_STAGE(PG8_SA(0, 0), a2, voffA);
            PG8_BAR; PG8_WAIT_L(0); PG8_MMA(1, 0, At, B0); PG8_BAR; PG8_SCHED;
            PG8_STAGE(PG8_SB(0, 1), b2 + hstepB, voffB);
            PG8_WAIT_V(6); PG8_BAR; PG8_MMA(1, 1, At, B1); PG8_BAR;
            PG8_LDB(B0, 1, 0); PG8_SCHED; PG8_LDA(At, 1, 0); PG8_STAGE(PG8_SA(0, 1), a2 + hstepA, voffA);
            PG8_WAIT_L(8); PG8_BAR; PG8_WAIT_L(0); PG8_MMA(0, 0, At, B0); PG8_BAR; PG8_SCHED;
            PG8_LDB(B1, 1, 1); PG8_STAGE(PG8_SB(1, 0), b3, voffB);
            PG8_BAR; PG8_WAIT_L(0); PG8_MMA(0, 1, At, B1); PG8_BAR;
            PG8_LDA(At, 1, 1); PG8_STAGE(PG8_SA(1, 0), a3, voffA);
            PG8_BAR; PG8_WAIT_L(0); PG8_MMA(1, 0, At, B0); PG8_BAR; PG8_SCHED;
            PG8_STAGE(PG8_SB(1, 1), b3 + hstepB, voffB);
            PG8_WAIT_V(6); PG8_BAR; PG8_MMA(1, 1, At, B1); PG8_BAR;
        }
        if constexpr (FP8) asm volatile("s_nop 15\n\ts_nop 15" ::: "memory");
        E(acc, cur, wr, wc, fr, fq);
        if (!has_next) break;
#pragma unroll
        for (int a = 0; a < 2; ++a)
#pragma unroll
            for (int b = 0; b < 2; ++b)
#pragma unroll
                for (int m = 0; m < 4; ++m)
#pragma unroll
                    for (int n = 0; n < 2; ++n) acc[a][b][m][n] = (f32x4){0.f, 0.f, 0.f, 0.f};
        cur = nxt; cA = nA; cB = nB; ++ui;
    }
    PG8_WAIT_V(0);
    if (wr == 0) PG8_BAR;
    PG8_BAR;
#undef PG8_SA
#undef PG8_SB
#undef PG8_STAGE
#undef PG8_LDA
#undef PG8_LDB
#undef PG8_MMA
#undef PG8_WAIT_V
#undef PG8_WAIT_L
#undef PG8_BAR
#undef PG8_SCHED
}
}


struct SchedIn {
    const char* A; const char* Bt; int G, c, trim, part;
    __device__ __forceinline__ bool next(int i, pg8::Unit& u) const {
        int pm, pn, q = 0; const long L = (long)i * G + c;
        const int nN = part ? NT8 : 45, nM = trim ? 64 : MROWS / 256;
        if (L < (long)nM * nN) { pg8::static_tile(nM, nN, L, pm, pn); if (trim) pm += pm / 16; q = pn; pn = part ? pn_of_q8(pn) : pn_of_p16(pn); }
        else { if (!trim) return false; const int idx = (int)(L - (long)nM * nN);
            if (part) { if (idx >= 4 * 6) return false; const int k = idx % 6; pm = 17 * (idx / 6) + 16; q = 4 + k; pn = pn_of_q8(q); }
            else { if (idx >= 4 * 9) return false; const int k = idx % 9; pm = 17 * (idx / 9) + 16; pn = k < 8 ? 10 + k : 86; } }
        u.pm = pm; u.pn = pn; u.tag = 0;
        if (part) { u.a = A + (size_t)pm * 256 * DM; u.b = Bt + (size_t)q * 256 * DM; }
        else { u.a = A + (size_t)pm * 256 * DM * 2; u.b = Bt + (size_t)pn * 256 * DM * 2; }
        return true; }
};
struct EpiIn {
    static constexpr bool PERM = true;
    bf16_t* Y; float* G32; bool dost; float ps;
    __device__ __forceinline__ void operator()(const f32x4 (&acc)[2][2][4][2], const pg8::Unit& u, int wr, int wc, int fr, int fq) const {
        if (!dost) return;
        const int pn = u.pn;
        int opq = 0; asm volatile("" : "+v"(opq));
        const int row0 = u.pm * 256 + wr * 64 + fr + opq;
        if (pn == 86) {
            if (wc == 0 && fq < 2) {
#pragma unroll
                for (int ai = 0; ai < 2; ++ai)
#pragma unroll
                    for (int m = 0; m < 4; ++m) { float* gp = G32 + (size_t)(row0 + ai * 128 + m * 16) * 16 + 8 * fq;
                        *(f32x4*)gp = acc[ai][0][m][0]; *(f32x4*)(gp + 4) = acc[ai][0][m][1]; }
            }
            return;
        }
        int act = 0;
        if ((pn >= 6 && pn < 10) || (pn >= 26 && pn < 30) || (pn >= 42 && pn < 46) || (pn >= 50 && pn < 54)) act = 1;
        else if ((pn >= 22 && pn < 26) || pn >= 54) act = 2;
        const int col0 = pn * 256 + wc * 32 + 8 * fq;
#pragma unroll
        for (int ai = 0; ai < 2; ++ai)
#pragma unroll
            for (int m = 0; m < 4; ++m) { bf16_t* rowp = Y + (size_t)(row0 + ai * 128 + m * 16) * NPAD + col0;
#pragma unroll
                for (int bj = 0; bj < 2; ++bj) { f32x4 v0 = acc[ai][bj][m][0], v1 = acc[ai][bj][m][1];
                    if (act == 1) {
#pragma unroll
                        for (int j = 0; j < 4; ++j) { v0[j] = siluf_(v0[j]); v1[j] = siluf_(v1[j]); } }
                    else if (act == 2) {
#pragma unroll
                        for (int j = 0; j < 4; ++j) { v0[j] = sigmoidf_(v0[j] * ps); v1[j] = sigmoidf_(v1[j] * ps); } }
                    u32x4 w; w.x = cvt_pk_bf16(v0[0], v0[1]); w.y = cvt_pk_bf16(v0[2], v0[3]); w.z = cvt_pk_bf16(v1[0], v1[1]); w.w = cvt_pk_bf16(v1[2], v1[3]);
                    *(u32x4*)(rowp + bj * 128) = w; } }
    }
};

struct EpiGate8 {
    static constexpr bool PERM = true;
    bf16_t* Y;
    __device__ __forceinline__ void operator()(const f32x4 (&acc)[2][2][4][2], const pg8::Unit& u, int wr, int wc, int fr, int fq) const {
        int opq = 0; asm volatile("" : "+v"(opq));
        const int row0 = u.pm * 256 + wr * 64 + fr + opq, col0 = u.pn * 256 + wc * 32 + 8 * fq; const bool gate = u.pn >= 54;
#pragma unroll
        for (int ai = 0; ai < 2; ++ai)
#pragma unroll
            for (int m = 0; m < 4; ++m) { bf16_t* rowp = Y + (size_t)(row0 + ai * 128 + m * 16) * NPAD + col0;
#pragma unroll
                for (int bj = 0; bj < 2; ++bj) { float o[8];
#pragma unroll
                    for (int j = 0; j < 4; ++j) { const float x0 = acc[ai][bj][m][0][j] * (1.0f / 64.0f), x1 = acc[ai][bj][m][1][j] * (1.0f / 64.0f); o[j] = gate ? sigmoidf_(x0) : x0; o[4 + j] = gate ? sigmoidf_(x1) : x1; }
                    *(u32x4*)(rowp + bj * 128) = pack8(o); } }
    }
};
struct SchedPool {
    const char* A; const char* Bt; int G, c, i0;
    __device__ __forceinline__ bool next(int i, pg8::Unit& u) const {
        const long L = (long)i * G + c; if (L >= (MROWS / 256) * 4) return false;
        const int pm = (int)(L >> 2), g = (int)(L & 3);
        u.pm = pm; u.pn = g; u.tag = 0; u.a = A + ((size_t)pm * 256 * BRW + g * 256) * 2; u.b = Bt + (size_t)g * 256 * 256 * 2; return true; }
};
struct EpiPool {
    static constexpr bool PERM = true;
    bf16_t* Y;
    __device__ __forceinline__ void operator()(const f32x4 (&acc)[2][2][4][2], const pg8::Unit& u, int wr, int wc, int fr, int fq) const {
        int opq = 0; asm volatile("" : "+v"(opq));
        const int row0 = u.pm * 256 + wr * 64 + fr + opq, colc = u.pn * 256 + wc * 32 + 8 * fq;
#pragma unroll
        for (int ai = 0; ai < 2; ++ai) {
            u32x4 zw[4][2];
#pragma unroll
            for (int m = 0; m < 4; ++m)
#pragma unroll
                for (int bj = 0; bj < 2; ++bj) zw[m][bj] = *(const u32x4*)(Y + (size_t)(row0 + ai * 128 + m * 16) * NPAD + C_PZ + colc + bj * 128);
#pragma unroll
            for (int m = 0; m < 4; ++m)
#pragma unroll
                for (int bj = 0; bj < 2; ++bj) { float z[8]; unpack8(zw[m][bj], z);
                    const f32x4 v0 = acc[ai][bj][m][0], v1 = acc[ai][bj][m][1]; float o[8];
#pragma unroll
                    for (int j = 0; j < 4; ++j) { o[j] = v0[j] * z[j]; o[4 + j] = v1[j] * z[4 + j]; }
                    *(u32x4*)(Y + (size_t)(row0 + ai * 128 + m * 16) * NPAD + C_PZ + colc + bj * 128) = pack8(o); }
            asm volatile("" ::: "memory"); }
    }
};

struct SchedMerge {
    const char* Y; const char* Wbr; int G, c, nM;
    __device__ __forceinline__ bool next(int i, pg8::Unit& u) const {
        const long L = (long)(i >> 2) * G + c; const int br = i & 3; if (L >= (long)nM * 8) return false;
        const int pm = (int)(L >> 3), pn = (int)(L & 7);
        const int pmr = (nM == 64) ? (pm + pm / 16) : pm;
        const int coff = br == 0 ? C_AQ : (br == 1 ? C_MO : (br == 2 ? C_CZ : C_PZ));
        u.pm = pmr; u.pn = pn; u.tag = br; u.a = Y + ((size_t)pmr * 256 * NPAD + coff) * 2; u.b = Wbr + ((size_t)br * DM * BRW + (size_t)pn * 256 * BRW) * 2; return true; }
};
struct EpiMerge {
    static constexpr bool PERM = true;
    const bf16_t* Y; bf16_t* accb;
    __device__ __forceinline__ void operator()(const f32x4 (&acc)[2][2][4][2], const pg8::Unit& u, int wr, int wc, int fr, int fq) const {
        int opq = 0; asm volatile("" : "+v"(opq));
        const int row0 = u.pm * 256 + wr * 64 + fr + opq, col0 = u.pn * 256 + wc * 32 + 8 * fq, tag = u.tag;
#pragma unroll
        for (int ai = 0; ai < 2; ++ai) {
            u32x4 gw[4][2], pw[4][2];
#pragma unroll
            for (int m = 0; m < 4; ++m) { const size_t row = (size_t)(row0 + ai * 128 + m * 16);
#pragma unroll
                for (int bj = 0; bj < 2; ++bj) { gw[m][bj] = *(const u32x4*)(Y + row * NPAD + C_GM + tag * DM + col0 + bj * 128);
                    pw[m][bj] = tag != 0 ? *(const u32x4*)(accb + row * DM + col0 + bj * 128) : (u32x4){0u, 0u, 0u, 0u}; } }
#pragma unroll
            for (int m = 0; m < 4; ++m) { const size_t row = (size_t)(row0 + ai * 128 + m * 16);
#pragma unroll
                for (int bj = 0; bj < 2; ++bj) { float gt[8], pv[8]; unpack8(gw[m][bj], gt); unpack8(pw[m][bj], pv);
                    const f32x4 v0 = acc[ai][bj][m][0], v1 = acc[ai][bj][m][1]; float o[8];
#pragma unroll
                    for (int j = 0; j < 4; ++j) { o[j] = v0[j] * gt[j] + pv[j]; o[4 + j] = v1[j] * gt[4 + j] + pv[4 + j]; }
                    *(u32x4*)(accb + row * DM + col0 + bj * 128) = pack8(o); } }
            asm volatile("" ::: "memory"); }
    }
};

struct SchedOut {
    const char* A; const char* Bt; int G, c, nM;
    __device__ __forceinline__ bool next(int i, pg8::Unit& u) const {
        const long L = (long)i * G + c; if (L >= (long)nM * 8) return false;
        const int pm = (int)(L >> 3), pn = (int)(L & 7);
        const int pmr = (nM == 64) ? (pm + pm / 16) : pm;
        u.pm = pmr; u.pn = pn; u.tag = 0; u.a = A + (size_t)pmr * 256 * DM * 2; u.b = Bt + (size_t)pn * 256 * DM * 2; return true; }
};
struct EpiOut {
    static constexpr bool PERM = false;
    const float* xin; const float* ctxin;
    const float* mod;
    bf16_t* X1; int first;
    __device__ __forceinline__ void operator()(const f32x4 (&acc)[2][2][4][2], const pg8::Unit& u, int wr, int wc, int fr, int fq) const {
        const int b = u.pm / 17, j = u.pm % 17; const bool isctx = (j == 16);
        int opq = 0; asm volatile("" : "+v"(opq));
        const int rin = wr * 64 + fr + opq;
        const int col0 = u.pn * 256 + wc * 32 + 4 * fq;
        const float* gtp = mod + (size_t)(isctx ? 4 : b) * 6144 + 4096 + col0;
        const float* resb = isctx ? ctxin + (size_t)b * LC * DM : xin + ((size_t)b * TL + (size_t)j * 256) * DM;
        bf16_t* xb = X1 + (size_t)u.pm * 256 * DM;
        f32x4 gv[2][2];
#pragma unroll
        for (int bj = 0; bj < 2; ++bj)
#pragma unroll
            for (int n = 0; n < 2; ++n) gv[bj][n] = *(const f32x4*)(gtp + bj * 128 + n * 16);
#pragma unroll
        for (int ai = 0; ai < 2; ++ai) {
            f32x4 rv[4][2][2];
#pragma unroll
            for (int m = 0; m < 4; ++m) { const size_t off = (size_t)(rin + ai * 128 + m * 16) * DM + col0;
#pragma unroll
                for (int bj = 0; bj < 2; ++bj)
#pragma unroll
                    for (int n = 0; n < 2; ++n) {
                        if (first) rv[m][bj][n] = *(const f32x4*)(resb + off + bj * 128 + n * 16);
                        else { const u32x2 w = *(const u32x2*)(xb + off + bj * 128 + n * 16); rv[m][bj][n] = (f32x4){bflo(w.x), bfhi(w.x), bflo(w.y), bfhi(w.y)}; } } }
#pragma unroll
            for (int m = 0; m < 4; ++m) { const size_t off = (size_t)(rin + ai * 128 + m * 16) * DM + col0;
#pragma unroll
                for (int bj = 0; bj < 2; ++bj)
#pragma unroll
                    for (int n = 0; n < 2; ++n) { const f32x4 o = rv[m][bj][n] + gv[bj][n] * acc[ai][bj][m][n];
                        u32x2 w; w.x = cvt_pk_bf16(o[0], o[1]); w.y = cvt_pk_bf16(o[2], o[3]); *(u32x2*)(xb + off + bj * 128 + n * 16) = w; } }
            asm volatile("" ::: "memory"); }
    }
};

namespace att {
using pg8::v4i_t; using pg8::v8i_t;
constexpr int D = 128, NW = 8, QBLK = 32, KVBLK = 64;
constexpr float SCALE = 0.088388347648318440f;
constexpr float THR = 5.f;
constexpr int LDQ = NPAD, LDK = NPAD;
constexpr size_t SHM_V = KVBLK * D * 2, SHM_K = KVBLK * D * 2, SHM_ATTN = 2 * SHM_V + 2 * SHM_K + NW * 64 * 4;
#define KSWZ(row, colB) ((row) * 256 + ((colB) ^ (((row) & 7) << 4)))
#define SBAR() __builtin_amdgcn_sched_barrier(0)
__device__ __forceinline__ int crow(int r, int hi) { return (r & 3) + 8 * (r >> 2) + 4 * hi; }
__device__ __forceinline__ void partialSM(f32x16& p0, f32x16& p1, float& m_reg, float& mn, float& alpha) {
  constexpr float C = SCALE * 1.4426950408889634f;
  float pmax = p0[0]; for (int r = 1; r < 16; ++r) pmax = fmaxf(pmax, p0[r]); for (int r = 0; r < 16; ++r) pmax = fmaxf(pmax, p1[r]);
  { auto rr = __builtin_amdgcn_permlane32_swap(__float_as_uint(pmax), __float_as_uint(pmax), false, false);
    pmax = fmaxf(__uint_as_float(rr[0]), __uint_as_float(rr[1])); }
  if (__builtin_expect(__all(pmax - m_reg <= THR / SCALE), 1)) { mn = m_reg; alpha = 1.f; }
  else { mn = fmaxf(m_reg, pmax); alpha = __builtin_amdgcn_exp2f((m_reg - mn) * C); m_reg = mn; }
  float mnC = -mn * C;
  for (int r = 0; r < 16; ++r) p0[r] = fmaf(p0[r], C, mnC); for (int r = 0; r < 16; ++r) p1[r] = fmaf(p1[r], C, mnC);
  for (int r = 0; r < 16; ++r) p0[r] = __builtin_amdgcn_exp2f(p0[r]);
}
__device__ __forceinline__ void finishSM(f32x16& p0, f32x16& p1, float alpha, float& l_reg, v8i_t& p8) {
  for (int r = 0; r < 16; ++r) p1[r] = __builtin_amdgcn_exp2f(p1[r]);
  float ps = 0; for (int r = 0; r < 16; ++r) ps += p0[r]; for (int r = 0; r < 16; ++r) ps += p1[r];
  { auto rr = __builtin_amdgcn_permlane32_swap(__float_as_uint(ps), __float_as_uint(ps), false, false);
    ps = __uint_as_float(rr[0]) + __uint_as_float(rr[1]); }
  l_reg = l_reg * alpha + ps;
#pragma unroll
  for (int i = 0; i < 4; ++i) { int w = __builtin_amdgcn_cvt_pk_fp8_f32(p0[4 * i], p0[4 * i + 1], 0, false); w = __builtin_amdgcn_cvt_pk_fp8_f32(p0[4 * i + 2], p0[4 * i + 3], w, true); p8[i] = w;
    int v = __builtin_amdgcn_cvt_pk_fp8_f32(p1[4 * i], p1[4 * i + 1], 0, false); v = __builtin_amdgcn_cvt_pk_fp8_f32(p1[4 * i + 2], p1[4 * i + 3], v, true); p8[4 + i] = v; }
}
#define KSWZ8(row, colB) ((row) * 128 + ((colB) ^ (((row) & 7) << 4)))
__device__ __forceinline__ u32x2 bf8x_to_fp8(bf16x8 x) {
  const u32x4 w = __builtin_bit_cast(u32x4, x);
  int lo = __builtin_amdgcn_cvt_pk_fp8_f32(bflo(w.x), bfhi(w.x), 0, false); lo = __builtin_amdgcn_cvt_pk_fp8_f32(bflo(w.y), bfhi(w.y), lo, true);
  int hi = __builtin_amdgcn_cvt_pk_fp8_f32(bflo(w.z), bfhi(w.z), 0, false); hi = __builtin_amdgcn_cvt_pk_fp8_f32(bflo(w.w), bfhi(w.w), hi, true);
  return (u32x2){(unsigned)lo, (unsigned)hi};
}
__device__ __forceinline__ void qkt(f32x16& p0, f32x16& p1, const char* Ks, const v8i_t* q8, int r32, int hi) {
  const int c0 = 32 * hi, c1 = 64 + 32 * hi;
  const v8i_t a00 = __builtin_shufflevector(*(const v4i_t*)(Ks + KSWZ8(r32, c0)), *(const v4i_t*)(Ks + KSWZ8(r32, c0 + 16)), 0, 1, 2, 3, 4, 5, 6, 7);
  const v8i_t a10 = __builtin_shufflevector(*(const v4i_t*)(Ks + KSWZ8(32 + r32, c0)), *(const v4i_t*)(Ks + KSWZ8(32 + r32, c0 + 16)), 0, 1, 2, 3, 4, 5, 6, 7);
  const v8i_t a01 = __builtin_shufflevector(*(const v4i_t*)(Ks + KSWZ8(r32, c1)), *(const v4i_t*)(Ks + KSWZ8(r32, c1 + 16)), 0, 1, 2, 3, 4, 5, 6, 7);
  const v8i_t a11 = __builtin_shufflevector(*(const v4i_t*)(Ks + KSWZ8(32 + r32, c1)), *(const v4i_t*)(Ks + KSWZ8(32 + r32, c1 + 16)), 0, 1, 2, 3, 4, 5, 6, 7);
  asm volatile("v_mfma_f32_32x32x64_f8f6f4 %0, %1, %2, 0" : "=&v"(p0) : "v"(a00), "v"(q8[0]));
  asm volatile("v_mfma_f32_32x32x64_f8f6f4 %0, %1, %2, 0" : "=&v"(p1) : "v"(a10), "v"(q8[0]));
  asm volatile("v_mfma_f32_32x32x64_f8f6f4 %0, %1, %2, %0" : "+v"(p0) : "v"(a01), "v"(q8[1]));
  asm volatile("v_mfma_f32_32x32x64_f8f6f4 %0, %1, %2, %0\n\ts_nop 15\n\ts_nop 15" : "+v"(p1) : "v"(a11), "v"(q8[1]));
}
__device__ __forceinline__ int v_st(int k, int c) { const int kk = (k & ~0xC) | ((k & 4) << 1) | ((k & 8) >> 1); return ((kk >> 3) * 4 + (c >> 5)) * 512 + ((kk & 7) * 32 + (c & 31)) * 2; }
__device__ __forceinline__ int v_rd_base(int lane) { return ((lane & 3) << 3) | (((lane >> 2) & 3) << 6) | (((lane >> 4) & 1) << 5) | (((lane >> 5) & 1) << 8); }
constexpr int v_rd_off(int d0, int ks, int half) { return d0 * 512 + ks * 4096 + half * 2048; }
template <int OFF> __device__ __forceinline__ s16x4 tr_read(int vb) {
  s16x4 r; asm volatile("ds_read_b64_tr_b16 %0, %1 offset:%2" : "=&v"(r) : "v"(vb), "i"(OFF) : "memory"); return r;
}
__device__ __forceinline__ void pv_d0(f32x16* o, const char* Vs, v8i_t p8, int r32, int hi) {
  v8i_t vb[4];
#pragma unroll
  for (int d0 = 0; d0 < 4; ++d0) { const char* vp = Vs + (32 * d0 + r32) * 80 + 32 * hi;
    vb[d0] = __builtin_shufflevector(*(const v4i_t*)vp, *(const v4i_t*)(vp + 16), 0, 1, 2, 3, 4, 5, 6, 7); }
  asm volatile("s_nop 4\n\tv_mfma_f32_32x32x64_f8f6f4 %0, %1, %2, %0" : "+v"(o[0]) : "v"(p8), "v"(vb[0]));
  asm volatile("v_mfma_f32_32x32x64_f8f6f4 %0, %1, %2, %0" : "+v"(o[1]) : "v"(p8), "v"(vb[1]));
  asm volatile("v_mfma_f32_32x32x64_f8f6f4 %0, %1, %2, %0" : "+v"(o[2]) : "v"(p8), "v"(vb[2]));
  asm volatile("v_mfma_f32_32x32x64_f8f6f4 %0, %1, %2, %0\n\ts_nop 15\n\ts_nop 15" : "+v"(o[3]) : "v"(p8), "v"(vb[3]));
}
__device__ __forceinline__ void attn_dense_body(bf16_t* __restrict__ Qb, const unsigned char* __restrict__ K8h, const unsigned char* __restrict__ V8t, const bf16_t* __restrict__ Zb, int seq, char* lds) {
  const int tid = otid(), wid = tid >> 6, lane = tid & 63, r32 = lane & 31, hi = lane >> 5;
  bf16_t* V_lds = (bf16_t*)lds; bf16_t* K_lds = (bf16_t*)(lds + 2 * SHM_V);
  float* ws = (float*)(lds + 2 * SHM_V + 2 * SHM_K) + wid * 64; float* li_l = ws; float* al_l = ws + 32;
  float m_reg = -1e30f, l_reg = 0; f32x16 o[4] = {}; v8i_t qr[2];
  const bf16_t* Qw = Qb + (long)(wid * QBLK + r32) * LDQ + hi * 32;
#pragma unroll
  for (int j = 0; j < 2; ++j) { u32x2 c[4];
#pragma unroll
    for (int e = 0; e < 4; ++e) c[e] = bf8x_to_fp8(*reinterpret_cast<const bf16x8*>(Qw + j * 64 + e * 8));
    qr[j] = (v8i_t){(int)c[0].x, (int)c[0].y, (int)c[1].x, (int)c[1].y, (int)c[2].x, (int)c[2].y, (int)c[3].x, (int)c[3].y}; }
  const int sr = tid >> 4, sc = (tid & 15) * 8;
  struct { u32x4 vs0; u32x2 ks0, ks1; } sr_[2];
#define SLOAD(i, k0) do { sr_[i].vs0 = *reinterpret_cast<const u32x4*>(V8t + (long)((k0) >> 6) * 8192 + tid * 16); \
    sr_[i].ks0 = *reinterpret_cast<const u32x2*>(K8h + (long)((k0) + sr) * 256 + sc); sr_[i].ks1 = *reinterpret_cast<const u32x2*>(K8h + (long)((k0) + 32 + sr) * 256 + sc); } while (0)
#define SWRITE(b, i) do { *(u32x4*)((char*)V_lds + (b) * SHM_V + (tid >> 2) * 80 + (tid & 3) * 16) = sr_[i].vs0;          \
    *(u32x2*)((char*)K_lds + (b) * SHM_K + KSWZ8(sr, sc)) = sr_[i].ks0;                       \
    *(u32x2*)((char*)K_lds + (b) * SHM_K + KSWZ8(32 + sr, sc)) = sr_[i].ks1; } while (0)
#define SWAIT() do { asm volatile("s_waitcnt vmcnt(3)" ::: "memory"); } while (0)
#define RESC(a) do { if (__any((a) < 1.f)) { if (hi == 0) al_l[r32] = (a); asm volatile("s_waitcnt lgkmcnt(0)" ::: "memory"); \
    for (int d = 0; d < 4; ++d) for (int r = 0; r < 16; ++r) o[d][r] *= al_l[crow(r, hi)]; } } while (0)
  f32x16 pA0, pA1, pB0, pB1; float mnA, mnB, alA, alB; v8i_t p8; const int NT = seq / KVBLK;
  constexpr int SE = 0, SO = 1;
  SLOAD(SE, 0); asm volatile("s_waitcnt vmcnt(0)" ::: "memory"); SWRITE(0, SE); __syncthreads();
  qkt(pA0, pA1, (const char*)K_lds, qr, r32, hi); partialSM(pA0, pA1, m_reg, mnA, alA);
  SLOAD(SO, KVBLK); { if (2 < NT) SLOAD(SE, 2 * KVBLK); }
  SWAIT(); SWRITE(1, SO); __syncthreads();
  for (int j = 1; j + 1 < NT; j += 2) {
    SBAR(); qkt(pB0, pB1, (const char*)K_lds + SHM_K, qr, r32, hi);
    finishSM(pA0, pA1, alA, l_reg, p8); SBAR();
    SLOAD(SO, (j + 2) * KVBLK); SBAR();
    pv_d0(o, (const char*)V_lds, p8, r32, hi); partialSM(pB0, pB1, m_reg, mnB, alB);
    __syncthreads(); SWAIT(); SWRITE(0, SE);
    RESC(alB); __syncthreads();
    SBAR(); qkt(pA0, pA1, (const char*)K_lds, qr, r32, hi);
    finishSM(pB0, pB1, alB, l_reg, p8); SBAR();
    if (j + 3 < NT) SLOAD(SE, (j + 3) * KVBLK); SBAR();
    pv_d0(o, (const char*)V_lds + SHM_V, p8, r32, hi); partialSM(pA0, pA1, m_reg, mnA, alA);
    __syncthreads(); SWAIT(); SWRITE(1, SO);
    RESC(alA); __syncthreads();
  }
  SBAR(); qkt(pB0, pB1, (const char*)K_lds + SHM_K, qr, r32, hi);
  finishSM(pA0, pA1, alA, l_reg, p8); SBAR();
  pv_d0(o, (const char*)V_lds, p8, r32, hi); partialSM(pB0, pB1, m_reg, mnB, alB);
  __syncthreads(); RESC(alB);
  finishSM(pB0, pB1, alB, l_reg, p8); SBAR();
  pv_d0(o, (const char*)V_lds + SHM_V, p8, r32, hi);
  if (hi == 0) li_l[r32] = l_reg; asm volatile("s_waitcnt lgkmcnt(0)" ::: "memory");
  float rli[16];
#pragma unroll
  for (int r = 0; r < 16; ++r) rli[r] = __builtin_amdgcn_rcpf(li_l[crow(r, hi)]);
  bf16_t* Ol = (bf16_t*)(lds + SHM_ATTN) + wid * (32 * 136);
#pragma unroll
  for (int r = 0; r < 16; ++r) { const int row = crow(r, hi);
#pragma unroll
    for (int d0 = 0; d0 < 4; ++d0) Ol[row * 136 + 32 * d0 + r32] = f2bf(o[d0][r] * rli[r]); }
  asm volatile("s_waitcnt lgkmcnt(0)" ::: "memory");
  int opq = 0; asm volatile("" : "+v"(opq));
  const long gbase = (long)(wid * QBLK + opq) * LDQ;
  u32x4 ov[8], zv[8];
#pragma unroll
  for (int it = 0; it < 8; ++it) { const int chunk = it * 64 + lane, row = chunk >> 4, c8 = (chunk & 15) * 8;
    ov[it] = *(const u32x4*)(Ol + row * 136 + c8); zv[it] = *(const u32x4*)(Zb + gbase + (long)row * LDQ + c8); }
#pragma unroll
  for (int it = 0; it < 8; ++it) { const int chunk = it * 64 + lane, row = chunk >> 4, c8 = (chunk & 15) * 8;
    float of[8], zf[8], rf[8]; unpack8(ov[it], of); unpack8(zv[it], zf);
#pragma unroll
    for (int e = 0; e < 8; ++e) rf[e] = of[e] * zf[e];
    *(u32x4*)(Qb + gbase + (long)row * LDQ + c8) = pack8(rf); }
#undef SLOAD
#undef SWRITE
#undef SWAIT
#undef RESC
}
}

template <int KT>
__device__ __forceinline__ void tconv_tile(const float* __restrict__ src, int ld, int K, bool remap, bf16_t* __restrict__ dst, int n0, int k0, unsigned char* smem, const float* __restrict__ nscale = nullptr) {
    const int tid = otid(), kk = tid >> 4, n4 = (tid & 15) * 4;
    constexpr int LDT = KT + 8, NJ = KT / 32;
    bf16_t* tile = (bf16_t*)smem;
    const int n = n0 + n4; int sc = n; bool zero = false;
    if (remap) { if (n < 7680) sc = n; else if (n < 22016) sc = n + 16; else if (n < 22032) sc = 7680 + (n - 22016); else zero = true; }
    f32x4 v[NJ];
    const f32x4 nsc = nscale ? *(const f32x4*)(nscale + n) : (f32x4){1.f, 1.f, 1.f, 1.f};
#pragma unroll
    for (int j = 0; j < NJ; ++j) v[j] = zero ? (f32x4){0.f, 0.f, 0.f, 0.f} : *(const f32x4*)(src + (size_t)(k0 + kk + 32 * j) * ld + sc) * nsc;
#pragma unroll
    for (int j = 0; j < NJ; ++j)
#pragma unroll
        for (int i = 0; i < 4; ++i) tile[(n4 + i) * LDT + kk + 32 * j] = f2bf(v[j][i]);
    __syncthreads();
#pragma unroll
    for (int j = 0; j < KT / 64; ++j) { const int idx = tid + 512 * j, nn = idx / (KT / 8), k8 = (idx % (KT / 8)) * 8;
        *(u32x4*)(dst + (size_t)(n0 + nn) * K + k0 + k8) = *(const u32x4*)(tile + nn * LDT + k8); }
    __syncthreads();
}
__device__ __forceinline__ void mod_unit(const Params& p, int l, int cb, unsigned char* smem) {
    const int tid = otid();
    float* sc = (float*)smem; float* red = sc + 5 * 2048;
    for (int i = tid; i < 5 * 2048; i += 512) { const int r = i >> 11, k = i & 2047; const float v = r < 4 ? p.c[r * 2048 + k] : p.c_ctx[k]; sc[i] = siluf_(v); }
    __syncthreads();
    const int col4 = (tid & 15) * 4, ks = tid >> 4;
    f32x4 a0 = {0, 0, 0, 0}, a1 = a0, a2 = a0, a3 = a0, a4 = a0;
    const float* wp = p.w_mod + (size_t)l * 2048 * 6144 + (size_t)(ks * 64) * 6144 + cb * 64 + col4;
#pragma unroll 8
    for (int kk = 0; kk < 64; ++kk) { const f32x4 w = *(const f32x4*)(wp + (size_t)kk * 6144); const int k = ks * 64 + kk;
        a0 += sc[k] * w; a1 += sc[2048 + k] * w; a2 += sc[4096 + k] * w; a3 += sc[6144 + k] * w; a4 += sc[8192 + k] * w; }
    *(f32x4*)(red + (ks * 5 + 0) * 64 + col4) = a0; *(f32x4*)(red + (ks * 5 + 1) * 64 + col4) = a1; *(f32x4*)(red + (ks * 5 + 2) * 64 + col4) = a2;
    *(f32x4*)(red + (ks * 5 + 3) * 64 + col4) = a3; *(f32x4*)(red + (ks * 5 + 4) * 64 + col4) = a4;
    __syncthreads();
    if (tid < 320) { const int r = tid >> 6, cc = tid & 63; float s = p.b_mod[l * 6144 + cb * 64 + cc];
        for (int q = 0; q < 32; ++q) s += red[(q * 5 + r) * 64 + cc];
        ((float*)(p.ws + WS_MOD))[(size_t)(l * 5 + r) * 6144 + cb * 64 + cc] = s; }
    __syncthreads();
}
__device__ __forceinline__ void tconv8_tile(const float* __restrict__ src, int ld, int col0, unsigned char* __restrict__ dst, int n0, int k0, unsigned char* smem) {
    const int tid = otid(), kk = tid >> 4, n4 = (tid & 15) * 4;
    constexpr int LDT = 512 + 16;
    unsigned char* tile = smem;
    f32x4 v[16];
#pragma unroll
    for (int j = 0; j < 16; ++j) v[j] = *(const f32x4*)(src + (size_t)(k0 + kk + 32 * j) * ld + col0 + n0 + n4) * 64.0f;
#pragma unroll
    for (int j = 0; j < 16; ++j) { const int w01 = __builtin_amdgcn_cvt_pk_fp8_f32(v[j][0], v[j][1], 0, false), w23 = __builtin_amdgcn_cvt_pk_fp8_f32(v[j][2], v[j][3], 0, false);
        tile[(n4 + 0) * LDT + kk + 32 * j] = (unsigned char)(w01 & 0xff); tile[(n4 + 1) * LDT + kk + 32 * j] = (unsigned char)((w01 >> 8) & 0xff);
        tile[(n4 + 2) * LDT + kk + 32 * j] = (unsigned char)(w23 & 0xff); tile[(n4 + 3) * LDT + kk + 32 * j] = (unsigned char)((w23 >> 8) & 0xff); }
    __syncthreads();
#pragma unroll
    for (int j = 0; j < 4; ++j) { const int idx = tid + 512 * j, nn = idx >> 5, k16 = (idx & 31) * 16;
        *(u32x4*)(dst + (size_t)(n0 + nn) * DM + k0 + k16) = *(const u32x4*)(tile + nn * LDT + k16); }
    __syncthreads();
}
constexpr int U_WINB = 196 * 4, U_W8 = NT8 * 4 * 4, U_WIN1 = U_WINB + U_W8, U_WBR1 = 4 * 32 * 2, U_WOUT1 = 32 * 4, U_POOL1 = 4 * 4, U_CONV1 = U_WIN1 + U_WBR1 + U_WOUT1 + U_POOL1;
__device__ __forceinline__ void conv_unit(const Params& p, int l, int v, unsigned char* smem) {
    if (v < U_WINB) { const int t = v >> 2, nt = t < 192 ? t + 24 : t + 152, kt = v & 3;
        tconv_tile<512>(p.w_in + (size_t)l * DM * NIN, NIN, DM, true, (bf16_t*)(p.ws + WS_WIN) + (size_t)l * NPAD * DM, nt * 64, kt * 512, smem); return; }
    if (v < U_WIN1) { const int w = v - U_WINB, nt = w >> 2, kt = w & 3, q = nt >> 2, col = pn_of_q8(q) * 256 + (nt & 3) * 64;
        tconv8_tile(p.w_in + (size_t)l * DM * NIN, NIN, (col < 7680 ? col : col + 16) - nt * 64, p.ws + WS_W8 + (size_t)l * NT8 * 256 * DM, nt * 64, kt * 512, smem); return; }
    v -= U_WIN1;
    if (v < U_WBR1) { const int mat = l * 4 + (v >> 6), r = v & 63, nt = r >> 1, kt = r & 1;
        tconv_tile<512>(p.w_branch + (size_t)mat * BRW * DM, DM, BRW, false, (bf16_t*)(p.ws + WS_WBR) + (size_t)mat * DM * BRW, nt * 64, kt * 512, smem); return; }
    v -= U_WBR1;
    if (v < U_WOUT1) { const int nt = v >> 2, kt = v & 3;
        tconv_tile<512>(p.w_out + (size_t)l * DM * DM, DM, DM, false, (bf16_t*)(p.ws + WS_WOUT) + (size_t)l * DM * DM, nt * 64, kt * 512, smem); return; }
    v -= U_WOUT1;
    { const int mat = l * 4 + (v >> 2), nt = v & 3;
        tconv_tile<256>(p.pool_w + (size_t)mat * 256 * 256, 256, 256, false, (bf16_t*)(p.ws + WS_POOLW) + (size_t)mat * 256 * 256, nt * 64, 0, smem, p.pool_scale + (size_t)mat * 256); }
}
__device__ void phase_prep(const Params& p, unsigned char* smem) {
    constexpr int U_MOD = 192;
    for (int u = blockIdx.x; u < U_MOD + U_CONV1; u += gridDim.x) {
        if (u < U_MOD) mod_unit(p, u / 96, u % 96, smem); else conv_unit(p, 0, u - U_MOD, smem);
    }
}

__device__ void phase_norm(const Params& p, int l) {
    const int tid = otid(), lane = tid & 63, wv = obid() * 8 + (tid >> 6), nwv = gridDim.x * 8;
    const float* mod = (const float*)(p.ws + WS_MOD) + (size_t)l * 5 * 6144;
    const float* gain = p.norm_gain + l * DM;
    bf16_t* H = (bf16_t*)(p.ws + WS_H);
    for (int row = wv; row < MROWS; row += nwv) {
        const int b = row / RPB, tt = row % RPB; const bool isctx = tt >= TL;
        const float* xr = isctx ? p.ctx + ((size_t)b * LC + (tt - TL)) * DM : p.x + ((size_t)b * TL + tt) * DM;
        const bf16_t* xb = (const bf16_t*)(p.ws + WS_X1) + (size_t)row * DM;
        const float* mr = mod + (size_t)(isctx ? 4 : b) * 6144;
        f32x4 v[8]; float ss = 0.f;
#pragma unroll
        for (int j = 0; j < 8; ++j) {
            if (l == 0) v[j] = *(const f32x4*)(xr + 256 * j + 4 * lane);
            else { const u32x2 w = *(const u32x2*)(xb + 256 * j + 4 * lane); v[j] = (f32x4){bflo(w.x), bfhi(w.x), bflo(w.y), bfhi(w.y)}; }
            ss += v[j][0] * v[j][0] + v[j][1] * v[j][1] + v[j][2] * v[j][2] + v[j][3] * v[j][3]; }
#pragma unroll
        for (int o = 32; o >= 1; o >>= 1) ss += __shfl_xor(ss, o);
        const float rstd = rsqrtf(ss * (1.0f / DM) + EPS);
#pragma unroll
        for (int j = 0; j < 8; ++j) { const int cidx = 256 * j + 4 * lane;
            const f32x4 g = *(const f32x4*)(gain + cidx), sh = *(const f32x4*)(mr + cidx), sc = *(const f32x4*)(mr + 2048 + cidx);
            f32x4 y = v[j] * rstd * g * (1.0f + sc) + sh;
            u32x2 w; w.x = cvt_pk_bf16(y[0], y[1]); w.y = cvt_pk_bf16(y[2], y[3]);
            *(u32x2*)(H + (size_t)row * DM + cidx) = w;
            int w8 = __builtin_amdgcn_cvt_pk_fp8_f32(y[0], y[1], 0, false); w8 = __builtin_amdgcn_cvt_pk_fp8_f32(y[2], y[3], w8, true);
            *(int*)(p.ws + WS_H8 + (size_t)row * DM + cidx) = w8; }
    }
}
__device__ void phase_final(const Params& p) {
    const int tid = otid(), lane = tid & 63, wv = obid() * 8 + (tid >> 6), nwv = gridDim.x * 8;
    for (int row = wv; row < NB * TL; row += nwv) {
        const int b = row / TL, t = row % TL;
        const bf16_t* xb = (const bf16_t*)(p.ws + WS_X1) + (size_t)(b * RPB + t) * DM;
        float* xr = p.out + (size_t)row * DM;
        f32x4 v[8]; float ss = 0.f;
#pragma unroll
        for (int j = 0; j < 8; ++j) { const u32x2 w = *(const u32x2*)(xb + 256 * j + 4 * lane); v[j] = (f32x4){bflo(w.x), bfhi(w.x), bflo(w.y), bfhi(w.y)};
            ss += v[j][0] * v[j][0] + v[j][1] * v[j][1] + v[j][2] * v[j][2] + v[j][3] * v[j][3]; }
#pragma unroll
        for (int o = 32; o >= 1; o >>= 1) ss += __shfl_xor(ss, o);
        const float rstd = rsqrtf(ss * (1.0f / DM) + EPS);
#pragma unroll
        for (int j = 0; j < 8; ++j) { const int cidx = 256 * j + 4 * lane; const f32x4 g = *(const f32x4*)(p.final_gain + cidx); *(f32x4*)(xr + cidx) = v[j] * rstd * g; }
    }
}

__device__ __forceinline__ int seq_row(int b, int dir, int pos  ) {
    if (pos < LC) { const int o = dir ? (LC - 1 - pos) : pos; return b * RPB + TL + o; }
    const int q = pos - LC; const int o = dir ? (TL - 1 - q) : q; return b * RPB + o;
}
__device__ void phase_mix1(const Params& p, int l, unsigned char* smem) {
    const int tid = otid(), lane = tid & 63, wv = obid() * 8 + (tid >> 6), nwv = gridDim.x * 8;
    bf16_t* Y = (bf16_t*)(p.ws + WS_Y);
    if ((int)blockIdx.x >= (int)gridDim.x - 32) {
        const int sq = blockIdx.x - (gridDim.x - 32), dir = sq & 1, hd = (sq >> 1) & 3, b = sq >> 3, wid = tid >> 6;
        const float* G32 = (const float*)(p.ws + WS_G32);
        f32x4* GT4 = (f32x4*)(p.ws + WS_GT4) + (size_t)sq * RPB; float* GW = (float*)(p.ws + WS_GW) + (size_t)sq * RPB; float* GD = (float*)(p.ws + WS_GD) + sq * 128;
        const float bi = p.gate_bias[l * 16 + (dir ? 8 : 0) + hd], bfv = p.gate_bias[l * 16 + (dir ? 12 : 4) + hd];
        float* sAq = (float*)smem; float* sCm = sAq + RPB; float* sB = sCm + RPB; float* sB63 = sB + RPB; float* sC63 = sB63 + 128; float* sMc = sC63 + 128;
        for (int ci = wid; ci < NCHUNK; ci += 8) {
            const int pos = ci * 64 + lane, row = seq_row(b, dir, pos);
            const float gi = G32[(size_t)row * 16 + (dir ? 8 : 0) + hd] + bi, gf = G32[(size_t)row * 16 + (dir ? 12 : 4) + hd] + bfv;
            const float lf = fminf(gf, 0.f) - log1pf(__expf(-fabsf(gf)));
            float bsum = lf;
#pragma unroll
            for (int o = 1; o < 64; o <<= 1) { const float t = __shfl_up(bsum, o); if (lane >= o) bsum += t; }
            const float a = gi - bsum; float cm = a;
#pragma unroll
            for (int o = 1; o < 64; o <<= 1) { const float t = __shfl_up(cm, o); if (lane >= o) cm = fmaxf(cm, t); }
            sAq[pos] = a; sCm[pos] = cm; sB[pos] = bsum;
            if (lane == 63) { sB63[ci] = bsum; sC63[ci] = cm; }
        }
        __syncthreads();
        if (tid == 0) { float m = -1e30f; for (int ci = 0; ci < NCHUNK; ++ci) { sMc[ci] = m; m = sB63[ci] + fmaxf(m, sC63[ci]); } }
        __syncthreads();
        for (int pos = tid; pos < RPB; pos += 512) {
            const int ci = pos >> 6; const float m = sMc[ci], M = fmaxf(m, sCm[pos]), M63 = fmaxf(m, sC63[ci]), a = sAq[pos], bsum = sB[pos];
            GT4[pos] = (f32x4){a, M, fexp(m - M), fexp(-(bsum + M))}; GW[pos] = fexp(a - M63); if ((pos & 63) == 0) GD[ci] = fexp(m - M63);
        }
    {
        const int nth = 32 * 512, th = (blockIdx.x - (gridDim.x - 32)) * 512 + tid;
        for (int task = th; task < NB * 2 * NCHUNK * 128 * 8; task += nth) {
            const int d = task & 127, g = (task >> 7) & 7, T = (task >> 10) % NCHUNK, bk = (task >> 10) / NCHUNK, kvh = bk & 1, bb = bk >> 1;
            const bf16_t* vsrc = Y + (size_t)(bb * RPB + T * 64) * NPAD + C_AV + kvh * 128 + d;
            float f[8];
#pragma unroll
            for (int e = 0; e < 8; ++e) { const int pos = 8 * g + e, hi_ = pos >> 5, bq = pos & 31, half = bq >> 4, r = bq & 15, key = 32 * half + (r & 3) + 8 * (r >> 2) + 4 * hi_;
                f[e] = bf2f(vsrc[(size_t)key * NPAD]); }
            int w0 = __builtin_amdgcn_cvt_pk_fp8_f32(f[0], f[1], 0, false); w0 = __builtin_amdgcn_cvt_pk_fp8_f32(f[2], f[3], w0, true);
            int w1 = __builtin_amdgcn_cvt_pk_fp8_f32(f[4], f[5], 0, false); w1 = __builtin_amdgcn_cvt_pk_fp8_f32(f[6], f[7], w1, true);
            *(u32x2*)(p.ws + WS_V8 + ((size_t)bk * NCHUNK + T) * 8192 + d * 64 + 8 * g) = (u32x2){(unsigned)w0, (unsigned)w1};
        }
    }
        return;
    }
    const int nw2 = nwv - 32 * 8;
    {
        const float* qg = p.q_gain + l * 128; const float* kg = p.k_gain + l * 128;
        const int j = lane & 31, hw = lane >> 5;
        const bool second = (j >> 3) & 1, colpart = j >= 16;
        float frq[4];
#pragma unroll
        for (int e = 0; e < 4; ++e) frq[e] = __builtin_amdgcn_exp2f(-(float)(4 * (j & 7) + e) * (13.287712379549449f / 32.0f));
        const f32x4 qg4 = *(const f32x4*)(qg + 4 * j), kg4 = *(const f32x4*)(kg + 4 * j);
        for (int row = wv; row < MROWS; row += nw2) {
            const int tt = row % RPB; const bool lat = tt < TL;
            float cs[4], sn[4];
            const float pos = lat ? (float)(colpart ? (tt & 63) : (tt >> 6)) : 0.f;
#pragma unroll
            for (int e = 0; e < 4; ++e) { const float ang = pos * frq[e]; cs[e] = __cosf(ang); sn[e] = __sinf(ang); }
            bf16_t* rb = Y + (size_t)row * NPAD + 4 * j;
            u32x2 raw[5];
#pragma unroll
            for (int it = 0; it < 5; ++it) { const int hh = it * 2 + hw; raw[it] = *(const u32x2*)(rb + (hh < 8 ? C_AQ + hh * 128 : C_AK + (hh - 8) * 128)); }
#pragma unroll
            for (int it = 0; it < 5; ++it) { const int hh = it * 2 + hw;
                float x[4] = {bflo(raw[it].x), bfhi(raw[it].x), bflo(raw[it].y), bfhi(raw[it].y)};
                float ss = x[0] * x[0] + x[1] * x[1] + x[2] * x[2] + x[3] * x[3];
#pragma unroll
                for (int o = 16; o >= 1; o >>= 1) ss += __shfl_xor(ss, o);
                const float rstd = rsqrtf(ss * (1.0f / 128.0f) + EPS);
                const f32x4 gn = hh < 8 ? qg4 : kg4;
                float y[4];
#pragma unroll
                for (int e = 0; e < 4; ++e) { x[e] *= rstd * gn[e]; }
#pragma unroll
                for (int e = 0; e < 4; ++e) { const float pr = __shfl_xor(x[e], 8); y[e] = second ? (x[e] * cs[e] + pr * sn[e]) : (x[e] * cs[e] - pr * sn[e]); }
                u32x2 w; w.x = cvt_pk_bf16(y[0], y[1]); w.y = cvt_pk_bf16(y[2], y[3]);
                if (hh < 8) *(u32x2*)(rb + C_AQ + hh * 128) = w;
                if (hh >= 8) { int k8 = __builtin_amdgcn_cvt_pk_fp8_f32(y[0], y[1], 0, false); k8 = __builtin_amdgcn_cvt_pk_fp8_f32(y[2], y[3], k8, true);
                    *(int*)(p.ws + WS_K8 + (size_t)row * 256 + (hh - 8) * 128 + 4 * j) = k8; }
            }
        }
    }
    {
        bf16_t* DMB = (bf16_t*)(p.ws + WS_H);
        const float* cw = p.conv_w + (size_t)l * 3 * BRW;
        const int nth = nw2 * 64, th = wv * 64 + lane;
        for (int task = th; task < MROWS * 128; task += nth) {
            const int row = task >> 7, c8 = (task & 127) * 8;
            const int tt = row % RPB; const bool lat = tt < TL; const int t = lat ? tt : tt - TL, T = lat ? TL : LC;
            const bf16_t* yr = Y + (size_t)row * NPAD;
            u32x4 convw;
            {
                float a0[8], a1[8], a2[8], u[8], g[8];
                unpack8(*(const u32x4*)(yr + C_CU + c8), u); unpack8(*(const u32x4*)(yr + C_CC + c8), g);
#pragma unroll
                for (int i = 0; i < 8; ++i) a1[i] = u[i] * g[i];
                if (t > 0) { unpack8(*(const u32x4*)(yr - NPAD + C_CU + c8), u); unpack8(*(const u32x4*)(yr - NPAD + C_CC + c8), g);
#pragma unroll
                    for (int i = 0; i < 8; ++i) a0[i] = u[i] * g[i]; }
                else {
#pragma unroll
                    for (int i = 0; i < 8; ++i) a0[i] = 0.f; }
                if (t < T - 1) { unpack8(*(const u32x4*)(yr + NPAD + C_CU + c8), u); unpack8(*(const u32x4*)(yr + NPAD + C_CC + c8), g);
#pragma unroll
                    for (int i = 0; i < 8; ++i) a2[i] = u[i] * g[i]; }
                else {
#pragma unroll
                    for (int i = 0; i < 8; ++i) a2[i] = 0.f; }
                float bg[8], z[8], o[8];
                unpack8(*(const u32x4*)(yr + C_CB + c8), bg); unpack8(*(const u32x4*)(yr + C_CZ + c8), z);
#pragma unroll
                for (int i = 0; i < 8; ++i) o[i] = bg[i] * (cw[c8 + i] * a0[i] + cw[BRW + c8 + i] * a1[i] + cw[2 * BRW + c8 + i] * a2[i]) * z[i];
                convw = pack8(o);
            }
            {
                const int g = c8 >> 8, w = 2 << g;
                int lo = t - (w >> 1); if (lo < 0) lo = 0; int hi = t + w - (w >> 1); if (hi > T) hi = T;
                float s[8], u0[8];
#pragma unroll
                for (int i = 0; i < 8; ++i) s[i] = 0.f;
                u32x4 tap[16];
#pragma unroll
                for (int k = 0; k < 16; ++k) { const int q = t - (w >> 1) + k; const bool ok = (k < w) && (q >= 0) && (q < T);
                    tap[k] = ok ? *(const u32x4*)(yr + (long)(q - t) * NPAD + C_PU + c8) : (u32x4){0u, 0u, 0u, 0u}; }
#pragma unroll
                for (int k = 0; k < 16; ++k) { float u[8]; unpack8(tap[k], u);
#pragma unroll
                    for (int i = 0; i < 8; ++i) s[i] += u[i]; }
                unpack8(*(const u32x4*)(yr + C_PU + c8), u0);
                const float inv = 1.0f / (float)(hi - lo);
                float o[8];
#pragma unroll
                for (int i = 0; i < 8; ++i) o[i] = s[i] * inv - u0[i];
                *(u32x4*)(DMB + (size_t)row * BRW + c8) = pack8(o);
                *(u32x4*)(Y + (size_t)row * NPAD + C_CZ + c8) = convw;
            }
        }
    }
}

__device__ __forceinline__ f32x4 mfma16(bf16x8 a, bf16x8 b, f32x4 c) { return __builtin_amdgcn_mfma_f32_16x16x32_bf16(a, b, c, 0, 0, 0); }
__device__ void mlstm_item(const Params& p, int item, unsigned char* smem) {
    const int tid = otid(), wid = tid >> 6, lane = tid & 63, fr = lane & 15, kq = lane >> 4;
    const int ep = item & 3, dir = (item >> 2) & 1, hd = (item >> 3) & 3, b = item >> 5;
    const int sq = (b * 4 + hd) * 2 + dir;
    const bf16_t* Y = (const bf16_t*)(p.ws + WS_Y);
    bf16_t* HM = (bf16_t*)(p.ws + WS_HM) + (size_t)dir * MROWS * BRW;
    const f32x4* GT4 = (const f32x4*)(p.ws + WS_GT4) + (size_t)sq * RPB; const float* GW = (const float*)(p.ws + WS_GW) + (size_t)sq * RPB; const float* GD = (const float*)(p.ws + WS_GD) + sq * 128;
    bf16_t* Ks = (bf16_t*)(smem); bf16_t* KTs = (bf16_t*)(smem + 33792);
    bf16_t* VTs = (bf16_t*)(smem + 70656); bf16_t* VWTs = (bf16_t*)(smem + 82176); bf16_t* CTs = (bf16_t*)(smem + 93696); bf16_t* Ss = (bf16_t*)(smem + 135936);
    float* sA = (float*)(smem + 145152); float* sM = sA + 64; float* sI = sA + 128; float* sE = sA + 192;
    for (int i = tid; i < 80 * 72; i += 512) { VTs[i] = 0; VWTs[i] = 0; }
    for (int i = tid; i < 80 * 264; i += 512) CTs[i] = 0;
    __syncthreads();
    if (tid < 64) VTs[64 * 72 + tid] = 0x3F80;
    f32x4 Cacc[2][5];
#pragma unroll
    for (int a = 0; a < 2; ++a)
#pragma unroll
        for (int c = 0; c < 5; ++c) Cacc[a][c] = (f32x4){0.f, 0.f, 0.f, 0.f};
    const int rg = wid >> 1, ch = wid & 1;
    u32x4 kreg[4], vreg; f32x4 g4; float wv_ = 0.f, wtok = 0.f, decay = 0.f;
    bf16x8 qf[8];
    const int dkp = tid & 127, sg = tid >> 7;
    const int vs = tid & 63, ve8 = (tid >> 6) * 8;
#define ML_LOAD(ci) do { \
        _Pragma("unroll") for (int j = 0; j < 4; ++j) { const int idx = tid + 512 * j, rr = idx >> 5, c8 = (idx & 31) * 8; \
            kreg[j] = *(const u32x4*)(Y + (size_t)seq_row(b, dir, (ci) * 64 + rr) * NPAD + C_MK + hd * 256 + c8); } \
        vreg = *(const u32x4*)(Y + (size_t)seq_row(b, dir, (ci) * 64 + vs) * NPAD + C_MV + hd * 256 + ep * 64 + ve8); wv_ = GW[(ci) * 64 + vs]; \
        g4 = GT4[(ci) * 64 + (tid & 63)]; wtok = GW[(ci) * 64 + (tid & 63)]; \
        decay = GD[(ci)]; } while (0)
#define ML_QLOAD(ci) do { const bf16_t* qrow = Y + (size_t)seq_row(b, dir, (ci) * 64 + 16 * rg + fr) * NPAD + C_MQ + hd * 256 + 8 * kq; \
        _Pragma("unroll") for (int ks = 0; ks < 8; ++ks) qf[ks] = *(const bf16x8*)(qrow + 32 * ks); } while (0)
    ML_LOAD(0); ML_QLOAD(0);
    for (int ci = 0; ci < NCHUNK; ++ci) {
#pragma unroll
        for (int j = 0; j < 4; ++j) { const int idx = tid + 512 * j, rr = idx >> 5, c8 = (idx & 31) * 8; *(u32x4*)(Ks + rr * 264 + c8) = kreg[j]; }
        { float vf[8]; unpack8(vreg, vf); const float ws_ = wv_ * 0.0625f;
#pragma unroll
            for (int i = 0; i < 8; ++i) { VTs[(ve8 + i) * 72 + vs] = f2bf(vf[i]); VWTs[(ve8 + i) * 72 + vs] = f2bf(vf[i] * ws_); } }
        if (tid < 64) { sA[tid] = g4[0]; sM[tid] = g4[1]; sI[tid] = g4[2]; sE[tid] = g4[3]; VWTs[64 * 72 + tid] = f2bf(wtok * 0.0625f); }
        const float dec = decay;
        __syncthreads();
        const int cn = ci + 1 < NCHUNK ? ci + 1 : NCHUNK - 1;
        ML_LOAD(cn);
        {
            const int t = 16 * rg + fr; const float Mt = sM[t];
#pragma unroll
            for (int s2 = 0; s2 < 2; ++s2) { const int st = 2 * ch + s2; f32x4 acc = {0.f, 0.f, 0.f, 0.f};
#pragma unroll
                for (int ks = 0; ks < 8; ++ks) { const bf16x8 kf = *(const bf16x8*)(Ks + (16 * st + fr) * 264 + 32 * ks + 8 * kq); acc = mfma16(kf, qf[ks], acc); }
                float o[4];
#pragma unroll
                for (int i = 0; i < 4; ++i) { const int s = 16 * st + 4 * kq + i; o[i] = (s <= t) ? acc[i] * fexp(sA[s] - Mt) * 0.0625f : 0.f; }
                u32x2 w; w.x = cvt_pk_bf16(o[0], o[1]); w.y = cvt_pk_bf16(o[2], o[3]);
                *(u32x2*)(Ss + t * 72 + 16 * st + 4 * kq) = w; }
        }
#pragma unroll
        for (int j = 0; j < 2; ++j) { const int s0 = 8 * (sg + 4 * j); unsigned kt[8]; u32x4 lo, hi;
#pragma unroll
            for (int jj = 0; jj < 8; ++jj) kt[jj] = *(const unsigned*)(Ks + (s0 + jj) * 264 + 2 * dkp);
            lo.x = (kt[0] & 0xffffu) | (kt[1] << 16); lo.y = (kt[2] & 0xffffu) | (kt[3] << 16); lo.z = (kt[4] & 0xffffu) | (kt[5] << 16); lo.w = (kt[6] & 0xffffu) | (kt[7] << 16);
            hi.x = (kt[0] >> 16) | (kt[1] & 0xffff0000u); hi.y = (kt[2] >> 16) | (kt[3] & 0xffff0000u); hi.z = (kt[4] >> 16) | (kt[5] & 0xffff0000u); hi.w = (kt[6] >> 16) | (kt[7] & 0xffff0000u);
            *(u32x4*)(KTs + (2 * dkp) * 72 + s0) = lo; *(u32x4*)(KTs + (2 * dkp + 1) * 72 + s0) = hi; }
        __syncthreads();
        {
            f32x4 aN0 = {0.f, 0.f, 0.f, 0.f}, aN1 = aN0, aD = aN0;
#pragma unroll
            for (int ks = 0; ks < 8; ++ks) { const bf16x8 c0 = *(const bf16x8*)(CTs + (32 * ch + fr) * 264 + 32 * ks + 8 * kq), c1 = *(const bf16x8*)(CTs + (32 * ch + 16 + fr) * 264 + 32 * ks + 8 * kq),
                                                     c2 = *(const bf16x8*)(CTs + (64 + fr) * 264 + 32 * ks + 8 * kq);
                aN0 = mfma16(qf[ks], c0, aN0); aN1 = mfma16(qf[ks], c1, aN1); aD = mfma16(qf[ks], c2, aD); }
            ML_QLOAD(cn);
            float it4[4], en4[4];
#pragma unroll
            for (int i = 0; i < 4; ++i) { it4[i] = sI[16 * rg + 4 * kq + i]; en4[i] = sE[16 * rg + 4 * kq + i]; aN0[i] *= it4[i]; aN1[i] *= it4[i]; aD[i] *= it4[i]; }
#pragma unroll
            for (int ks = 0; ks < 2; ++ks) { const bf16x8 sf = *(const bf16x8*)(Ss + (16 * rg + fr) * 72 + 32 * ks + 8 * kq);
                const bf16x8 v0 = *(const bf16x8*)(VTs + (32 * ch + fr) * 72 + 32 * ks + 8 * kq), v1 = *(const bf16x8*)(VTs + (32 * ch + 16 + fr) * 72 + 32 * ks + 8 * kq), v2 = *(const bf16x8*)(VTs + (64 + fr) * 72 + 32 * ks + 8 * kq);
                aN0 = mfma16(sf, v0, aN0); aN1 = mfma16(sf, v1, aN1); aD = mfma16(sf, v2, aD); }
#pragma unroll
            for (int i = 0; i < 4; ++i) { const float den = __shfl(aD[i], lane & 48); const float rd = 1.0f / fmaxf(fabsf(den), en4[i]);
                const int row = seq_row(b, dir, ci * 64 + 16 * rg + 4 * kq + i);
                bf16_t* hp = HM + (size_t)row * BRW + hd * 256 + ep * 64 + 32 * ch + fr;
                hp[0] = f2bf(aN0[i] * rd); hp[16] = f2bf(aN1[i] * rd); }
        }
#pragma unroll
        for (int rt = 0; rt < 2; ++rt)
#pragma unroll
            for (int ct = 0; ct < 5; ++ct) { f32x4 cacc = Cacc[rt][ct] * dec;
#pragma unroll
                for (int ks = 0; ks < 2; ++ks) { const bf16x8 af = *(const bf16x8*)(KTs + (32 * wid + 16 * rt + fr) * 72 + 32 * ks + 8 * kq), bv = *(const bf16x8*)(VWTs + (16 * ct + fr) * 72 + 32 * ks + 8 * kq);
                    cacc = mfma16(af, bv, cacc); }
                Cacc[rt][ct] = cacc; }
        __syncthreads();
#pragma unroll
        for (int rt = 0; rt < 2; ++rt)
#pragma unroll
            for (int ct = 0; ct < 5; ++ct) { u32x2 w; w.x = cvt_pk_bf16(Cacc[rt][ct][0], Cacc[rt][ct][1]); w.y = cvt_pk_bf16(Cacc[rt][ct][2], Cacc[rt][ct][3]);
                *(u32x2*)(CTs + (16 * ct + fr) * 264 + 32 * wid + 16 * rt + 4 * kq) = w; }
    }
#undef ML_LOAD
#undef ML_QLOAD
    __syncthreads();
}

__device__ void phase_mix2(const Params& p, int l, unsigned char* smem) {
    bf16_t* Y = (bf16_t*)(p.ws + WS_Y);
#ifndef NO_MLSTM
    if ((int)blockIdx.x < 128) { const int x = blockIdx.x & 7, k = blockIdx.x >> 3; mlstm_item(p, ((x * 2 + (k >> 3)) << 3) | (k & 7), smem); }
#endif
#ifndef NO_ATT
    const int natt = 512 + (l == 0 ? 32 : 0);
    unsigned* ctr = (unsigned*)(p.ws + WS_BAR + 14336) + l * 64;
    volatile unsigned* sidx = (volatile unsigned*)(smem + LDS_BYTES - 32);
    for (;;) {
        __syncthreads();
        if (threadIdx.x == 0) *sidx = atomicAdd(ctr, 1u);
        __syncthreads();
        const int it = __builtin_amdgcn_readfirstlane((int)*sidx);
        if (it >= natt + (MROWS / 256) * 4) break;
        if (it >= natt) {
            SchedPool S; S.A = (const char*)(p.ws + WS_H); S.Bt = (const char*)(p.ws + WS_POOLW) + (size_t)l * 4 * 256 * 256 * 2; S.G = 1 << 20; S.c = it - natt; S.i0 = 0;
            EpiPool E; E.Y = Y;
            pg8::Gemm g; g.lda = BRW; g.ldb = 256; { int kk = 256; asm volatile("" : "+s"(kk)); g.K = kk; }
            pg8::gemm_phase(( LAS unsigned char*)smem, g, S, E);
            continue; }
        int b, head, qrow, krow, seq;
        if (it < 512) { const int qb = it & 15; head = (it >> 4) & 7; b = it >> 7; qrow = b * RPB + qb * 256; krow = b * RPB; seq = RPB; }
        else { const int i2 = it - 512; head = i2 & 7; b = i2 >> 3; qrow = b * RPB + TL; krow = qrow; seq = LC; }
        const int kvh = head >> 2;
        bf16_t* rowq = Y + (size_t)qrow * NPAD; const bf16_t* rowk = Y + (size_t)krow * NPAD;
        att::attn_dense_body(rowq + C_AQ + head * 128, p.ws + WS_K8 + (size_t)krow * 256 + kvh * 128, p.ws + WS_V8 + ((size_t)(b * 2 + kvh) * NCHUNK + (krow - b * RPB) / 64) * 8192, rowq + C_AZ + head * 128, seq, (char*)smem);
    }
#endif
    __syncthreads();
    __syncthreads();
}

__device__ void phase_mix3(const Params& p, int l) {
    const int tid = otid(), lane = tid & 63, wv = obid() * 8 + (tid >> 6), nwv = gridDim.x * 8;
    bf16_t* Y = (bf16_t*)(p.ws + WS_Y);
    const bf16_t* HM0 = (const bf16_t*)(p.ws + WS_HM); const bf16_t* HM1 = HM0 + (size_t)MROWS * BRW;
    const float* gain = p.m_gain + l * BRW;
    for (int row = wv; row < MROWS; row += nwv) {
        f32x4 v[4]; u32x2 ow[4], zw[4];
#pragma unroll
        for (int hd = 0; hd < 4; ++hd) { const size_t off = (size_t)row * BRW + hd * 256 + 4 * lane;
            { const u32x2 h0 = *(const u32x2*)(HM0 + off), h1 = *(const u32x2*)(HM1 + off);
              v[hd] = (f32x4){bflo(h0.x) + bflo(h1.x), bfhi(h0.x) + bfhi(h1.x), bflo(h0.y) + bflo(h1.y), bfhi(h0.y) + bfhi(h1.y)}; }
            ow[hd] = *(const u32x2*)(Y + (size_t)row * NPAD + C_MO + hd * 256 + 4 * lane); zw[hd] = *(const u32x2*)(Y + (size_t)row * NPAD + C_MZ + hd * 256 + 4 * lane); }
#pragma unroll
        for (int hd = 0; hd < 4; ++hd) {
            float ss = v[hd][0] * v[hd][0] + v[hd][1] * v[hd][1] + v[hd][2] * v[hd][2] + v[hd][3] * v[hd][3];
#pragma unroll
            for (int o = 32; o >= 1; o >>= 1) ss += __shfl_xor(ss, o);
            const float rstd = rsqrtf(ss * (1.0f / 256.0f) + EPS);
            const f32x4 g = *(const f32x4*)(gain + hd * 256 + 4 * lane);
            const float o0 = bflo(ow[hd].x), o1 = bfhi(ow[hd].x), o2 = bflo(ow[hd].y), o3 = bfhi(ow[hd].y), z0 = bflo(zw[hd].x), z1 = bfhi(zw[hd].x), z2 = bflo(zw[hd].y), z3 = bfhi(zw[hd].y);
            u32x2 w; w.x = cvt_pk_bf16(v[hd][0] * rstd * g[0] * o0 * z0, v[hd][1] * rstd * g[1] * o1 * z1); w.y = cvt_pk_bf16(v[hd][2] * rstd * g[2] * o2 * z2, v[hd][3] * rstd * g[3] * o3 * z3);
            *(u32x2*)(Y + (size_t)row * NPAD + C_MO + hd * 256 + 4 * lane) = w;
        }
    }
}

#define XB_TMO      128
#define XB_XCNT(j)  (256  + 64 * (j))
#define XB_XSUB(j)  (1280 + 64 * (j))
#define XB_XGEN(j)  (2304 + 64 * (j))
#define XB_TOP      3328
#define XB_TOPGEN   3392
#define XCD_BAR_WORDS 3456
#define XB_SPIN_CAP (1u << 18)
__device__ __forceinline__ unsigned xb_ld(unsigned* p)              { return __hip_atomic_load(p, __ATOMIC_RELAXED, __HIP_MEMORY_SCOPE_AGENT); }
__device__ __forceinline__ unsigned xb_add(unsigned* p, unsigned v) { return __hip_atomic_fetch_add(p, v, __ATOMIC_RELAXED, __HIP_MEMORY_SCOPE_AGENT); }
__device__ __forceinline__ unsigned xb_xcc_id() { return (unsigned)__builtin_amdgcn_s_getreg((3 << 11) | 20) & 0xFu; }
#define XB_SPIN(cond, bar) do { unsigned _sp = 0; while (cond) { __builtin_amdgcn_s_sleep(1); \
    if ((++_sp & 255u) == 0u) { if (xb_ld(&(bar)[XB_TMO])) break; if (_sp > XB_SPIN_CAP) { atomicAdd(&(bar)[XB_TMO], 1u); break; } } } } while (0)
struct XcdBarrier { unsigned* bar; unsigned x; volatile LAS unsigned* st; };
__device__ __forceinline__ XcdBarrier xcd_barrier_post(unsigned* bar, volatile LAS unsigned* st) {
    XcdBarrier b; b.bar = bar; b.x = xb_xcc_id(); b.st = st;
    if (threadIdx.x == 0) (void)xb_add(&bar[XB_XCNT(b.x)], 1u);
    return b;
}
__device__ __forceinline__ void xcd_barrier_complete(unsigned* bar, unsigned x, unsigned& nloc, unsigned& nx) {
    const unsigned G = gridDim.x * gridDim.y * gridDim.z;
    unsigned sum, cnt, mine, sp = 0u;
    for (;;) {
        sum = 0u; cnt = 0u; mine = 0u;
#pragma unroll
        for (unsigned j = 0; j < 16; ++j) { const unsigned c = xb_ld(&bar[XB_XCNT(j)]); sum += c; cnt += (c > 0u) ? 1u : 0u; mine = (j == x) ? c : mine; }
        if (sum == G) break;
        __builtin_amdgcn_s_sleep(1);
        if ((++sp & 255u) == 0u) { if (xb_ld(&bar[XB_TMO])) break; if (sp > XB_SPIN_CAP) { atomicAdd(&bar[XB_TMO], 1u); break; } }
    }
    nloc = mine > 0u ? mine : 1u; nx = cnt > 0u ? cnt : 1u;
}
__device__ __forceinline__ void xcd_barrier(const XcdBarrier& b) {
    asm volatile("s_waitcnt vmcnt(0)" ::: "memory");
    __syncthreads();
    if (threadIdx.x == 0) {
        unsigned* bar = b.bar;
        __builtin_amdgcn_s_waitcnt(0);
        unsigned nloc = b.st[0], nx = b.st[1];
        if (nloc == 0u) { xcd_barrier_complete(bar, b.x, nloc, nx); b.st[0] = nloc; b.st[1] = nx; }
        const unsigned old = xb_add(&bar[XB_XSUB(b.x)], 1u);
        const unsigned gen = old / nloc;
        if (old + 1u == (gen + 1u) * nloc) {
            __builtin_amdgcn_fence(__ATOMIC_RELEASE, "agent");
            asm volatile("s_waitcnt vmcnt(0)" ::: "memory");
            const unsigned og = xb_add(&bar[XB_TOP], 1u);
            const unsigned tg = og / nx;
            if (og + 1u == (tg + 1u) * nx) xb_add(&bar[XB_TOPGEN], 1u);
            else XB_SPIN(xb_ld(&bar[XB_TOPGEN]) == tg, bar);
            __builtin_amdgcn_fence(__ATOMIC_ACQUIRE, "agent");
            xb_add(&bar[XB_XGEN(b.x)], 1u);
            asm volatile("s_waitcnt vmcnt(0)" ::: "memory");
        } else {
            XB_SPIN(xb_ld(&bar[XB_XGEN(b.x)]) == gen, bar);
            __builtin_amdgcn_fence(__ATOMIC_ACQUIRE, "agent");
            asm volatile("s_waitcnt vmcnt(0)" ::: "memory");
        }
    }
    __syncthreads();
}

constexpr int NPHASE = 16;
__device__ void run_phase(const Params& p, int ph, unsigned char* smem, bool dost = true) {
#ifndef NO_PREP
    if (ph == 0) { phase_prep(p, smem); return; }
#endif
#ifndef NO_FINAL
    if (ph == NPHASE - 1) { phase_final(p); return; }
#endif
    const int l = (ph - 1) / 7, s = (ph - 1) % 7;
    bf16_t* Y = (bf16_t*)(p.ws + WS_Y);
    switch (s) {
#ifndef NO_NORM
    case 0: phase_norm(p, l); break;
#endif
#ifndef NO_GIN
    case 1: { EpiIn E; E.Y = Y; E.G32 = (float*)(p.ws + WS_G32); E.dost = dost;
              { SchedIn S; S.A = (const char*)(p.ws + WS_H); S.Bt = (const char*)(p.ws + WS_WIN) + (size_t)l * NPAD * DM * 2; S.G = gridDim.x; S.c = blockIdx.x; S.trim = (l == 1); S.part = 0;
                E.ps = 1.0f; pg8::Gemm g; g.lda = DM; g.ldb = DM; g.K = DM;
#ifndef T_NO_P0
                pg8::gemm_phase<EpiIn, SchedIn, false>((LAS unsigned char*)smem, g, S, E);
#endif
              }
              __syncthreads();
              { SchedIn S; S.A = (const char*)(p.ws + WS_H8); S.Bt = (const char*)(p.ws + WS_W8) + (size_t)l * NT8 * 256 * DM; S.G = gridDim.x; S.c = gridDim.x - 1 - blockIdx.x;     S.trim = (l == 1); S.part = 1;
                EpiGate8 E8; E8.Y = Y; pg8::Gemm g; g.lda = DM / 2; g.ldb = DM / 2; g.K = DM / 2;
#ifndef T_NO_P1
                pg8::gemm_phase<EpiGate8, SchedIn, true>((LAS unsigned char*)smem, g, S, E8);
#endif
              } } break;
#endif
#ifndef NO_MIX1
    case 2: phase_mix1(p, l, smem); break;
#endif
#ifndef NO_MIX2
    case 3: phase_mix2(p, l, smem); break;
#endif
#ifndef NO_MIX3
    case 4: phase_mix3(p, l); break;
#endif
#ifndef NO_MERGE
    case 5: { SchedMerge S; S.Y = (const char*)Y; S.Wbr = (const char*)(p.ws + WS_WBR) + (size_t)l * 4 * DM * BRW * 2; S.G = gridDim.x; S.c = blockIdx.x; S.nM = l == 0 ? 68 : 64;
              EpiMerge E; E.Y = Y; E.accb = (bf16_t*)(p.ws + WS_H);
              pg8::Gemm g; g.lda = NPAD; g.ldb = BRW; g.K = BRW;
              pg8::gemm_phase((LAS unsigned char*)smem, g, S, E);
              if (l == 0 && (int)blockIdx.x >= 32) { __syncthreads(); for (int u = blockIdx.x - 32; u < U_CONV1; u += gridDim.x - 32) conv_unit(p, 1, u, smem); } } break;
#endif
#ifndef NO_OUT
    case 6: { SchedOut S; S.A = (const char*)(p.ws + WS_H); S.Bt = (const char*)(p.ws + WS_WOUT) + (size_t)l * DM * DM * 2; S.G = gridDim.x; S.c = blockIdx.x; S.nM = l == 0 ? 68 : 64;
              EpiOut E; E.xin = p.x; E.ctxin = p.ctx; E.mod = (const float*)(p.ws + WS_MOD) + (size_t)l * 5 * 6144; E.X1 = (bf16_t*)(p.ws + WS_X1); E.first = (l == 0);
              pg8::Gemm g; g.lda = DM; g.ldb = DM; g.K = DM;
              pg8::gemm_phase((LAS unsigned char*)smem, g, S, E); } break;
#endif
    }
}

__global__ void __launch_bounds__(512, 2) hybrid_fwd(Params p) {
    extern __shared__ __attribute__((aligned(16))) unsigned char smem[];
    volatile LAS unsigned* st = (volatile LAS unsigned*)((LAS unsigned char*)smem + (LDS_BYTES - 16));
    if (threadIdx.x == 0) { st[0] = 0u; st[1] = 0u; }
    __syncthreads();
    const XcdBarrier xbar = xcd_barrier_post((unsigned*)(p.ws + WS_BAR), st);
    for (int ph = p.ph_lo; ph < p.ph_hi; ++ph) {
        int reps = 1;
#ifdef PROBE_REP_MASK
        if (ph > 0 && ph < NPHASE - 1 && ((PROBE_REP_MASK >> ((ph - 1) % 7)) & 1)) reps = 2;
        if (ph == 0 && (PROBE_REP_MASK & 128)) reps = 2;
#endif
        for (int r = 0; r < reps; ++r) { run_phase(p, ph, smem, r + 1 == reps || p.ph_hi > 1000); if (r + 1 < reps) xcd_barrier(xbar); }
        if (ph + 1 < p.ph_hi) { if (p.ph_hi > NPHASE) cg::this_grid().sync(); else xcd_barrier(xbar); }
#ifdef PROBE_EXTRA_SYNC
        if (ph + 1 < p.ph_hi) { for (int q = 0; q < PROBE_EXTRA_SYNC; ++q) cg::this_grid().sync(); }
#endif
    }
}


#ifdef DBG_STOP
__global__ void dbg_dump(Params p) {
    const bf16_t* Y = (const bf16_t*)(p.ws + WS_Y); const float* HM = (const float*)(p.ws + WS_HM); const bf16_t* H = (const bf16_t*)(p.ws + WS_H);
    for (size_t i = (size_t)blockIdx.x * blockDim.x + threadIdx.x; i < (size_t)NB * TL * DM; i += (size_t)gridDim.x * blockDim.x) {
        const size_t row = i / DM; const int c = (int)(i % DM);
        float s = 0.f;
#if DBG_WHAT & 1
        for (int j = 0; j < 11; ++j) { const int col = c + 2048 * j; if (col < 22016) s += bf2f(Y[row * NPAD + col]); }
#endif
#if DBG_WHAT & 2
        { const size_t k = i % ((size_t)MROWS * BRW); s += HM[k] + HM[k + (size_t)MROWS * BRW]; }
#endif
#if DBG_WHAT & 4
        s += bf2f(H[i]);
#endif
        p.out[i] = s;
    }
}
#endif
extern "C" void kernel_launch(void* const* d_in, const int* in_sizes, int n_in, void* d_out, int out_size, void* d_ws, size_t ws_size, hipStream_t stream) {
    static int grid = 0;
    if (grid == 0) {
        if (n_in != 18 || ws_size < WS_END) { fprintf(stderr, "kernel_launch: n_in %d ws %zu (need %zu)\n", n_in, ws_size, (size_t)WS_END); grid = -1; return; }
        if (hipFuncSetAttribute((const void*)hybrid_fwd, hipFuncAttributeMaxDynamicSharedMemorySize, LDS_BYTES) != hipSuccess) { fprintf(stderr, "kernel_launch: hipFuncSetAttribute failed\n"); grid = -1; return; }
        int dev = 0, cus = 0, per_cu = 0;
        hipGetDevice(&dev); hipDeviceGetAttribute(&cus, hipDeviceAttributeMultiprocessorCount, dev);
        hipOccupancyMaxActiveBlocksPerMultiprocessor(&per_cu, (const void*)hybrid_fwd, 512, LDS_BYTES);
        if (per_cu < 1) { fprintf(stderr, "kernel_launch: occupancy query says %d blocks per CU\n", per_cu); per_cu = 1; }
        (void)hipGetLastError();
        grid = cus;
    }
    if (grid < 0) return;
    Params p{};
    p.x = (const float*)d_in[0]; p.c = (const float*)d_in[1]; p.ctx = (const float*)d_in[2]; p.c_ctx = (const float*)d_in[3]; p.norm_gain = (const float*)d_in[4];
    p.w_mod = (const float*)d_in[5]; p.b_mod = (const float*)d_in[6]; p.w_in = (const float*)d_in[7]; p.q_gain = (const float*)d_in[8]; p.k_gain = (const float*)d_in[9];
    p.gate_bias = (const float*)d_in[10]; p.m_gain = (const float*)d_in[11]; p.conv_w = (const float*)d_in[12]; p.pool_w = (const float*)d_in[13]; p.pool_scale = (const float*)d_in[14];
    p.w_branch = (const float*)d_in[15]; p.w_out = (const float*)d_in[16]; p.final_gain = (const float*)d_in[17];
    p.out = (float*)d_out; p.ws = (unsigned char*)d_ws;
#ifdef DBG_STOP
    for (int ph = 0; ph < DBG_STOP; ++ph) { p.ph_lo = ph; p.ph_hi = ph + 1; hipLaunchKernelGGL(hybrid_fwd, dim3(grid), dim3(512), LDS_BYTES, stream, p); }
    hipLaunchKernelGGL(dbg_dump, dim3(2048), dim3(256), 0, stream, p);
#elif MK_PER_PHASE
    for (int ph = 0; ph < NPHASE; ++ph) {
        p.ph_lo = ph; p.ph_hi = ph + 1;
        hipLaunchKernelGGL(hybrid_fwd, dim3(grid), dim3(512), LDS_BYTES, stream, p);
    }
#else
    p.ph_lo = 0; p.ph_hi = NPHASE;
    if (hipMemsetAsync((char*)d_ws + WS_BAR, 0, 16384, stream) != hipSuccess) { fprintf(stderr, "kernel_launch: memset of barrier words failed\n"); return; }
    void* args[] = {&p};
    hipError_t e = hipLaunchCooperativeKernel((const void*)hybrid_fwd, dim3(grid), dim3(512), args, LDS_BYTES, stream);
    if (e != hipSuccess) fprintf(stderr, "cooperative launch failed: %s (grid %d)\n", hipGetErrorString(e), grid);
#endif
}
```
